# Optimizing an MI355X kernel written in HIP

```python
import math
import jax, jax.numpy as jnp
from jax import lax
import numpy as np

D_MODEL = 1024
BATCH = 2
SEQ = 8192
DEPTH = 4

CTX_LEN = 256
GRID_W = 64
EPS = 1e-6
NEG_INF = -1e30

NA_HEADS = 4
NA_HEAD_DIM = D_MODEL // 16
NA_WIDTH = NA_HEADS * NA_HEAD_DIM
NA_WIN_ROWS = 8
NA_WIN_COLS = 16

RG_WIDTH = D_MODEL // 2
RG_BLOCKS = 8
RG_BLOCK_W = RG_WIDTH // RG_BLOCKS
RG_CONV_W = 4
RG_CONV_LEFT = 2
RG_C = 8.0

DIFF_HEADS = 4
DIFF_HEAD_DIM = D_MODEL // 32
DIFF_V_DIM = 2 * DIFF_HEAD_DIM
DIFF_WIDTH = DIFF_HEADS * DIFF_V_DIM
Q_BLOCK = 128
ROPE_BASE = 10000.0

MIX_WIDTH = NA_WIDTH + RG_WIDTH + DIFF_WIDTH
IN_SPLIT_SIZES = (NA_WIDTH, NA_WIDTH, NA_WIDTH, RG_WIDTH, RG_WIDTH, DIFF_WIDTH, DIFF_WIDTH, DIFF_WIDTH)
IN_COLS = sum(IN_SPLIT_SIZES)
IN_SPLIT_POINTS = tuple(sum(IN_SPLIT_SIZES[:i + 1]) for i in range(len(IN_SPLIT_SIZES) - 1))

N_GROUPS = 4
EXP_PER_GROUP = 8
N_EXPERTS = N_GROUPS * EXP_PER_GROUP
MOE_TOP_K = 2
D_EXPERT = D_MODEL // 2
MOE_BLOCK = 128

kernel_name = 'hybrid_flow_natten_rglru_diffattn_hmoe'


def rmsnorm(x, g):
    xf = x.astype(jnp.float32)
    y = xf * lax.rsqrt(jnp.mean(xf * xf, axis=-1, keepdims=True) + EPS)
    return (y * g.astype(jnp.float32)).astype(x.dtype)


def axial_rope_tables(n):
    t = jnp.arange(n)
    row = (t // GRID_W).astype(jnp.float32)
    col = (t % GRID_W).astype(jnp.float32)
    half = DIFF_HEAD_DIM // 2
    inv_freq = ROPE_BASE ** (-jnp.arange(0, half, 2, dtype=jnp.float32) / half)
    ang_r = row[:, None] * inv_freq
    ang_c = col[:, None] * inv_freq
    return jnp.cos(ang_r), jnp.sin(ang_r), jnp.cos(ang_c), jnp.sin(ang_c)


def _rotate(x, cos, sin):
    cos = cos[:, None, None, :].astype(x.dtype)
    sin = sin[:, None, None, :].astype(x.dtype)
    x1, x2 = jnp.split(x, 2, axis=-1)
    return jnp.concatenate([x1 * cos - x2 * sin, x1 * sin + x2 * cos], axis=-1)


def apply_axial_rope(x, tables):
    cos_r, sin_r, cos_c, sin_c = tables
    half = x.shape[-1] // 2
    return jnp.concatenate([_rotate(x[..., :half], cos_r, sin_r),
                            _rotate(x[..., half:], cos_c, sin_c)], axis=-1)


def neighbourhood_attention(q, k, v, k_ctx, v_ctx, rpb):
    B, S, _ = q.shape
    rows = S // GRID_W
    wr = min(NA_WIN_ROWS, rows)
    n_loc = wr * GRID_W
    grid = lambda t: t.reshape(B, rows, GRID_W, NA_HEADS, NA_HEAD_DIM)
    qg, kg, vg = grid(q), grid(k), grid(v)
    r = jnp.arange(rows)
    row_idx = jnp.clip(r - wr // 2, 0, rows - wr)[:, None] + jnp.arange(wr)
    kb = kg[:, row_idx].reshape(B, rows, n_loc, NA_HEADS, NA_HEAD_DIM)
    vb = vg[:, row_idx].reshape(B, rows, n_loc, NA_HEADS, NA_HEAD_DIM)
    col = jnp.arange(GRID_W)
    col_start = jnp.clip(col - NA_WIN_COLS // 2, 0, GRID_W - NA_WIN_COLS)
    kcol = col[None, :]
    in_win = (kcol >= col_start[:, None]) & (kcol < col_start[:, None] + NA_WIN_COLS)
    dc = jnp.clip(kcol - col[:, None], 1 - NA_WIN_COLS, NA_WIN_COLS - 1)
    dr = row_idx - r[:, None]
    bias = rpb[:, dr[:, None, :, None] + (NA_WIN_ROWS - 1), dc[None, :, None, :] + (NA_WIN_COLS - 1)]
    bias = bias.reshape(NA_HEADS, rows, GRID_W, n_loc).astype(jnp.float32)
    mask = jnp.broadcast_to(in_win[:, None, :], (GRID_W, wr, GRID_W)).reshape(GRID_W, n_loc)
    scale = NA_HEAD_DIM ** -0.5
    s_loc = jnp.einsum('brqhd,brkhd->bhrqk', qg, kb).astype(jnp.float32) * scale
    s_loc = jnp.where(mask, s_loc + bias, NEG_INF)
    s_ctx = jnp.einsum('brqhd,bkhd->bhrqk', qg, k_ctx).astype(jnp.float32) * scale
    p = jax.nn.softmax(jnp.concatenate([s_loc, s_ctx], axis=-1), axis=-1).astype(v.dtype)
    o = (jnp.einsum('bhrqk,brkhd->brqhd', p[..., :n_loc], vb)
         + jnp.einsum('bhrqk,bkhd->brqhd', p[..., n_loc:], v_ctx))
    return o.reshape(B, S, NA_WIDTH)


def ctx_attention(q, k, v):
    s = jnp.einsum('bqhd,bkhd->bhqk', q, k).astype(jnp.float32) * (q.shape[-1] ** -0.5)
    p = jax.nn.softmax(s, axis=-1).astype(v.dtype)
    return jnp.einsum('bhqk,bkhd->bqhd', p, v)


def short_conv(x, w, b):
    T = x.shape[1]
    xp = jnp.pad(x, ((0, 0), (RG_CONV_LEFT, RG_CONV_W - 1 - RG_CONV_LEFT), (0, 0)))
    return sum(xp[:, j:j + T] * w[j] for j in range(RG_CONV_W)) + b


def rglru_coeffs(xcv, w_r, b_r, w_i, b_i, lam):
    B, T, C = xcv.shape
    xh = xcv.reshape(B, T, RG_BLOCKS, RG_BLOCK_W)
    r = jax.nn.sigmoid((jnp.einsum('btnc,ncd->btnd', xh, w_r).reshape(B, T, C) + b_r).astype(jnp.float32))
    i = jax.nn.sigmoid((jnp.einsum('btnc,ncd->btnd', xh, w_i).reshape(B, T, C) + b_i).astype(jnp.float32))
    log_a = -RG_C * r * jax.nn.softplus(-lam.astype(jnp.float32))
    a = jnp.exp(log_a)
    bx = jnp.sqrt(-jnp.expm1(2.0 * log_a)) * (i * xcv.astype(jnp.float32))
    return a, bx


def _scan_combine(left, right):
    a_l, b_l = left
    a_r, b_r = right
    return a_l * a_r, a_r * b_l + b_r


def linear_scan(a, bx, h0):
    a_cum, h = lax.associative_scan(_scan_combine, (a, bx), axis=1)
    return h + a_cum * h0[:, None, :]


def rglru_bidir(xr, conv_w, conv_b, w_r, b_r, w_i, b_i, lam, h0):
    xcv = short_conv(xr, conv_w, conv_b)
    a_f, bx_f = rglru_coeffs(xcv, w_r[0], b_r[0], w_i[0], b_i[0], lam[0])
    h_f = linear_scan(a_f, bx_f, h0[0])
    a_b, bx_b = rglru_coeffs(xcv, w_r[1], b_r[1], w_i[1], b_i[1], lam[1])
    h_b = linear_scan(a_b[:, ::-1], bx_b[:, ::-1], h0[1])[:, ::-1]
    return h_f, h_b


def diff_attend(q, k, v, lam):
    s = jnp.einsum('bqhcd,bkhcd->bhcqk', q, k).astype(jnp.float32) * (DIFF_HEAD_DIM ** -0.5)
    p = jax.nn.softmax(s, axis=-1)
    p_diff = (p[:, :, 0] - lam * p[:, :, 1]).astype(v.dtype)
    return jnp.einsum('bhqk,bkhe->bqhe', p_diff, v)


def diff_attention_latent(q, k, v, k_ctx, v_ctx, lam):
    B, S = q.shape[0], q.shape[1]
    k_all = jnp.concatenate([k, k_ctx], axis=1)
    v_all = jnp.concatenate([v, v_ctx], axis=1)
    n_blk = S // Q_BLOCK
    qb = jnp.moveaxis(q.reshape(B, n_blk, Q_BLOCK, DIFF_HEADS, 2, DIFF_HEAD_DIM), 1, 0)
    o = lax.map(lambda qi: diff_attend(qi, k_all, v_all, lam), qb)
    return jnp.moveaxis(o, 0, 1).reshape(B, S, DIFF_HEADS, DIFF_V_DIM)


def grouped_expert_ffn(h, expert_id, weight, w1, w3, w2):
    N, D = h.shape
    A = N * MOE_TOP_K
    e_flat = expert_id.reshape(A)
    tok_flat = jnp.repeat(jnp.arange(N, dtype=jnp.int32), MOE_TOP_K)
    order = jnp.argsort(e_flat)
    e_sorted = e_flat[order]
    tok_sorted = tok_flat[order]
    w_sorted = weight.reshape(A)[order]
    counts = jnp.bincount(e_flat, length=N_EXPERTS)
    padded = (counts + MOE_BLOCK - 1) // MOE_BLOCK * MOE_BLOCK
    pad_end = jnp.cumsum(padded)
    pad_start = pad_end - padded
    start = jnp.cumsum(counts) - counts
    dest = pad_start[e_sorted] + jnp.arange(A) - start[e_sorted]
    n_blocks = -(-A // MOE_BLOCK) + N_EXPERTS
    n_rows = n_blocks * MOE_BLOCK
    row_tok = jnp.full((n_rows,), N, dtype=jnp.int32).at[dest].set(tok_sorted)
    blk_expert = jnp.minimum(jnp.searchsorted(pad_end, jnp.arange(n_blocks) * MOE_BLOCK, side='right'),
                             N_EXPERTS - 1)
    h_pad = jnp.concatenate([h, jnp.zeros((1, D), h.dtype)], axis=0)
    xb = h_pad[row_tok].reshape(n_blocks, MOE_BLOCK, D)

    def expert_block(args):
        xi, e = args
        return (jax.nn.silu(xi @ w1[e]) * (xi @ w3[e])) @ w2[e]

    yb = lax.map(expert_block, (xb, blk_expert)).reshape(n_rows, D)
    contrib = yb[dest] * w_sorted[:, None].astype(yb.dtype)
    return jnp.zeros((N, D), h.dtype).at[tok_sorted].add(contrib)


def hierarchical_moe(h, w_g, b_g, w_e, b_e, w1, w3, w2):
    N = h.shape[0]
    g_prob = jax.nn.softmax((h @ w_g + b_g).astype(jnp.float32), axis=-1)
    g_top, g_idx = lax.top_k(g_prob, 1)
    e_logits = (h @ w_e + b_e).astype(jnp.float32).reshape(N, N_GROUPS, EXP_PER_GROUP)
    e_logits = jnp.take_along_axis(e_logits, g_idx[:, :, None], axis=1)[:, 0]
    e_top, e_idx = lax.top_k(jax.nn.softmax(e_logits, axis=-1), MOE_TOP_K)
    weight = g_top * e_top / jnp.sum(e_top, axis=-1, keepdims=True)
    expert_id = g_idx * EXP_PER_GROUP + e_idx
    return grouped_expert_ffn(h, expert_id, weight, w1, w3, w2)


def setup_inputs(seed: int = 0) -> dict:
    key = jax.random.key(seed)
    ks = jax.random.split(key, 28)
    f32 = jnp.float32
    D = D_MODEL
    nrm = lambda k, shape, s: jax.random.normal(k, shape, f32) * s
    u = jax.random.uniform(ks[17], (DEPTH, 2, RG_WIDTH), f32, 0.9, 0.999)
    a = u ** (1.0 / RG_C)
    return {
        'x': nrm(ks[0], (BATCH, SEQ, D), 1.0),
        'c': nrm(ks[1], (BATCH, D), 1.0),
        'ctx': nrm(ks[2], (BATCH, CTX_LEN, D), 1.0),
        'c_ctx': nrm(ks[3], (D,), 1.0),
        'w_ada': nrm(ks[4], (DEPTH, D, 6 * D), 0.5 * D ** -0.5),
        'b_ada': nrm(ks[5], (DEPTH, 6 * D), 0.02),
        'g_mix': 1.0 + nrm(ks[6], (DEPTH, D), 0.02),
        'g_ffn': 1.0 + nrm(ks[7], (DEPTH, D), 0.02),
        'w_in': nrm(ks[8], (DEPTH, D, IN_COLS), D ** -0.5),
        'w_out': nrm(ks[9], (DEPTH, MIX_WIDTH, D), MIX_WIDTH ** -0.5),
        'na_rpb': nrm(ks[10], (DEPTH, NA_HEADS, 2 * NA_WIN_ROWS - 1, 2 * NA_WIN_COLS - 1), 0.1),
        'rg_conv_w': nrm(ks[11], (DEPTH, RG_CONV_W, RG_WIDTH), RG_CONV_W ** -0.5),
        'rg_conv_b': nrm(ks[12], (DEPTH, RG_WIDTH), 0.02),
        'rg_w_r': nrm(ks[13], (DEPTH, 2, RG_BLOCKS, RG_BLOCK_W, RG_BLOCK_W), RG_BLOCK_W ** -0.5),
        'rg_b_r': nrm(ks[14], (DEPTH, 2, RG_WIDTH), 0.02),
        'rg_w_i': nrm(ks[15], (DEPTH, 2, RG_BLOCKS, RG_BLOCK_W, RG_BLOCK_W), RG_BLOCK_W ** -0.5),
        'rg_b_i': nrm(ks[16], (DEPTH, 2, RG_WIDTH), 0.02),
        'rg_lambda': jnp.log(a) - jnp.log1p(-a),
        'diff_lambda': nrm(ks[18], (DEPTH, 4, DIFF_HEAD_DIM), 0.1),
        'diff_subln_g': 1.0 + nrm(ks[19], (DEPTH, DIFF_V_DIM), 0.02),
        'router_w_group': nrm(ks[20], (DEPTH, D, N_GROUPS), D ** -0.5),
        'router_b_group': nrm(ks[21], (DEPTH, N_GROUPS), 0.01),
        'router_w_expert': nrm(ks[22], (DEPTH, D, N_EXPERTS), D ** -0.5),
        'router_b_expert': nrm(ks[23], (DEPTH, N_EXPERTS), 0.01),
        'moe_w1': nrm(ks[24], (DEPTH, N_EXPERTS, D, D_EXPERT), D ** -0.5),
        'moe_w3': nrm(ks[25], (DEPTH, N_EXPERTS, D, D_EXPERT), D ** -0.5),
        'moe_w2': nrm(ks[26], (DEPTH, N_EXPERTS, D_EXPERT, D), D_EXPERT ** -0.5),
        'g_final': 1.0 + nrm(ks[27], (D,), 0.02),
    }


def reference(x, c, ctx, c_ctx, w_ada, b_ada, g_mix, g_ffn, w_in, w_out, na_rpb,
              rg_conv_w, rg_conv_b, rg_w_r, rg_b_r, rg_w_i, rg_b_i, rg_lambda,
              diff_lambda, diff_subln_g, router_w_group, router_b_group,
              router_w_expert, router_b_expert, moe_w1, moe_w3, moe_w2, g_final):
    B, S, D = x.shape
    L = ctx.shape[1]
    rope = axial_rope_tables(S)
    s_c = jax.nn.silu(c)
    s_cc = jax.nn.silu(c_ctx)
    xl, xc = x, ctx
    for l in range(DEPTH):
        last = l == DEPTH - 1
        sh1, sc1, ga1, sh2, sc2, ga2 = [m[:, None, :] for m in jnp.split(s_c @ w_ada[l] + b_ada[l], 6, axis=-1)]
        csh1, csc1, cga1, csh2, csc2, cga2 = jnp.split(s_cc @ w_ada[l] + b_ada[l], 6)
        hl = rmsnorm(xl, g_mix[l]) * (1 + sc1) + sh1
        hc = rmsnorm(xc, g_mix[l]) * (1 + csc1) + csh1
        qa, ka, va, xr, gr, qd, kd, vd = jnp.split(hl @ w_in[l], IN_SPLIT_POINTS, axis=-1)
        qa_c, ka_c, va_c, xr_c, gr_c, qd_c, kd_c, vd_c = jnp.split(hc @ w_in[l], IN_SPLIT_POINTS, axis=-1)

        ka_c = ka_c.reshape(B, L, NA_HEADS, NA_HEAD_DIM)
        va_c = va_c.reshape(B, L, NA_HEADS, NA_HEAD_DIM)
        y_na = neighbourhood_attention(qa, ka, va, ka_c, va_c, na_rpb[l])

        rg_args = (rg_conv_w[l], rg_conv_b[l], rg_w_r[l], rg_b_r[l], rg_w_i[l], rg_b_i[l], rg_lambda[l])
        hf_c, hb_c = rglru_bidir(xr_c, *rg_args, jnp.zeros((2, B, RG_WIDTH), jnp.float32))
        hf, hb = rglru_bidir(xr, *rg_args, jnp.stack([hf_c[:, -1], hb_c[:, 0]]))
        y_rg = (hf + hb).astype(xr.dtype) * jax.nn.gelu(gr)

        lam_init = 0.8 - 0.6 * math.exp(-0.3 * l)
        lvec = diff_lambda[l].astype(jnp.float32)
        lam = jnp.exp(jnp.sum(lvec[0] * lvec[1])) - jnp.exp(jnp.sum(lvec[2] * lvec[3])) + lam_init
        qd_h = apply_axial_rope(qd.reshape(B, S, DIFF_HEADS, 2, DIFF_HEAD_DIM), rope)
        kd_h = apply_axial_rope(kd.reshape(B, S, DIFF_HEADS, 2, DIFF_HEAD_DIM), rope)
        vd_h = vd.reshape(B, S, DIFF_HEADS, DIFF_V_DIM)
        kd_c = kd_c.reshape(B, L, DIFF_HEADS, 2, DIFF_HEAD_DIM)
        vd_c = vd_c.reshape(B, L, DIFF_HEADS, DIFF_V_DIM)
        y_diff = diff_attention_latent(qd_h, kd_h, vd_h, kd_c, vd_c, lam)
        y_diff = (rmsnorm(y_diff, diff_subln_g[l]) * (1 - lam_init)).reshape(B, S, DIFF_WIDTH)

        xl = xl + ga1 * (jnp.concatenate([y_na, y_rg, y_diff], axis=-1) @ w_out[l])
        hl2 = rmsnorm(xl, g_ffn[l]) * (1 + sc2) + sh2
        moe_args = (router_w_group[l], router_b_group[l], router_w_expert[l], router_b_expert[l],
                    moe_w1[l], moe_w3[l], moe_w2[l])
        if last:
            xl = xl + ga2 * hierarchical_moe(hl2.reshape(B * S, D), *moe_args).reshape(B, S, D)
        else:
            y_na_c = ctx_attention(qa_c.reshape(B, L, NA_HEADS, NA_HEAD_DIM), ka_c, va_c).reshape(B, L, NA_WIDTH)
            y_rg_c = (hf_c + hb_c).astype(xr_c.dtype) * jax.nn.gelu(gr_c)
            y_diff_c = diff_attend(qd_c.reshape(B, L, DIFF_HEADS, 2, DIFF_HEAD_DIM), kd_c, vd_c, lam)
            y_diff_c = (rmsnorm(y_diff_c, diff_subln_g[l]) * (1 - lam_init)).reshape(B, L, DIFF_WIDTH)
            xc = xc + cga1 * (jnp.concatenate([y_na_c, y_rg_c, y_diff_c], axis=-1) @ w_out[l])
            hc2 = rmsnorm(xc, g_ffn[l]) * (1 + csc2) + csh2
            y = hierarchical_moe(jnp.concatenate([hl2.reshape(B * S, D), hc2.reshape(B * L, D)], axis=0), *moe_args)
            xl = xl + ga2 * y[:B * S].reshape(B, S, D)
            xc = xc + cga2 * y[B * S:].reshape(B, L, D)
    return rmsnorm(xl, g_final)
```

```cpp
#include <hip/hip_runtime.h>
#include <hip/hip_cooperative_groups.h>
#include <cstdio>
#include <cstdint>
namespace cg = cooperative_groups;

#define LAS __attribute__((address_space(3)))
typedef _Float16 h16;
typedef h16 h16x8 __attribute__((ext_vector_type(8)));
typedef h16 h16x4 __attribute__((ext_vector_type(4)));
typedef h16 h16x2 __attribute__((ext_vector_type(2)));
typedef float f32x2 __attribute__((ext_vector_type(2)));
typedef float f32x4 __attribute__((ext_vector_type(4)));
typedef float f32x16 __attribute__((ext_vector_type(16)));
typedef unsigned u32x2 __attribute__((ext_vector_type(2)));
typedef unsigned u32x4 __attribute__((ext_vector_type(4)));

#define PROBE_REPEAT -1
#define REP(n) for (int rep_ = 0; rep_ < ((PROBE_REPEAT == (n)) ? 2 : 1); ++rep_)
#define DUMMY(n) ((PROBE_REPEAT == (n)) && rep_ == 0)
constexpr int D = 1024, NBATCH = 2, SEQ = 8192, CTX = 256, DEPTH = 4;
constexpr int NLAT = NBATCH * SEQ, NCTX = NBATCH * CTX, NROW = NLAT + NCTX;
constexpr int KEYS = SEQ + CTX;
constexpr int INC = 2560;
constexpr int NEXP = 32, DEXP = 512;
constexpr int NWAVES = 8, NTHREADS = 512;
constexpr float EPS = 1e-6f;
constexpr float LOG2E = 1.4426950408889634f;

constexpr size_t MiB = 1u << 20;
constexpr size_t WS_CTL = 0, CTL_ZERO_BYTES = 1 * MiB;
constexpr int CW_BAR = 4096;
constexpr int CW_CNT = 1024;
constexpr size_t WS_MOD = 1 * MiB;
constexpr size_t WS_LAM = 1 * MiB + 512 * 1024;
constexpr size_t WS_ROPE = 1 * MiB + 768 * 1024;
constexpr int CW_KMAX = 2048;
constexpr size_t WS_AGG = 2 * MiB;
constexpr size_t WS_ASG = 5 * MiB;
constexpr size_t WS_EW = 6 * MiB;
constexpr size_t WS_WIN = 8 * MiB;
constexpr size_t WS_WOUT = 28 * MiB;
constexpr size_t WS_RGW = 36 * MiB;
constexpr size_t WS_W1 = 40 * MiB;
constexpr size_t WS_W3 = 168 * MiB;
constexpr size_t WS_W2 = 296 * MiB;
constexpr size_t WS_XL = 424 * MiB;
constexpr size_t WS_HL = 490 * MiB;
constexpr size_t WS_QA = 523 * MiB;
constexpr size_t WS_KA = 532 * MiB;
constexpr size_t WS_VAT = 541 * MiB;
constexpr size_t WS_QD = 550 * MiB;
constexpr size_t WS_KD = 559 * MiB;
constexpr size_t WS_VDT = 568 * MiB;
constexpr size_t WS_XR = 577 * MiB;
constexpr size_t WS_GG = 594 * MiB;
constexpr size_t WS_RGA = 611 * MiB;
constexpr size_t WS_MIX = 743 * MiB;
constexpr size_t WS_XG = 776 * MiB;
constexpr size_t WS_ACT = 858 * MiB;
constexpr size_t WS_YB = 899 * MiB;
constexpr size_t WS_END = 981 * MiB;
constexpr int CW_POOL = 3000;
constexpr int CW_TMAP = 8192;
constexpr int CW_OWNER = 20480;
constexpr int MAXTILES = 164;
constexpr int CW_D5 = 21504;
constexpr int CW_RLIST = 65536;
constexpr int CW_D7 = 22528;

constexpr int LDS_BYTES = 147456;
constexpr int MISC_OFF = LDS_BYTES - 1024;

struct Params {
    const float* in[28];
    float* out;
    unsigned char* ws;
};
typedef __attribute__((address_space(4))) const Params* KP;
enum { I_X = 0, I_C, I_CTX, I_CCTX, I_WADA, I_BADA, I_GMIX, I_GFFN, I_WIN, I_WOUT, I_RPB, I_CONVW, I_CONVB, I_RGWR, I_RGBR, I_RGWI, I_RGBI, I_RGLAM,
       I_DLAM, I_DSUBG, I_RWG, I_RBG, I_RWE, I_RBE, I_W1, I_W3, I_W2, I_GFINAL };

__device__ __forceinline__ unsigned pkh(float a, float b) { h16x2 v = {(h16)a, (h16)b}; return __builtin_bit_cast(unsigned, v); }
__device__ __forceinline__ float wave_sum(float v) {
#pragma unroll
    for (int o = 1; o < 64; o <<= 1) v += __shfl_xor(v, o);
    return v;
}
__device__ __forceinline__ float xhalf_max(float m) { auto rr = __builtin_amdgcn_permlane32_swap(__float_as_uint(m), __float_as_uint(m), false, false); return fmaxf(__uint_as_float(rr[0]), __uint_as_float(rr[1])); }
__device__ __forceinline__ float xhalf_sum(float m) { auto rr = __builtin_amdgcn_permlane32_swap(__float_as_uint(m), __float_as_uint(m), false, false); return __uint_as_float(rr[0]) + __uint_as_float(rr[1]); }
__device__ __forceinline__ float fexp_(float x) { return __builtin_amdgcn_exp2f(x * LOG2E); }
__device__ __forceinline__ float frcp_(float x) { return __builtin_amdgcn_rcpf(x); }
__device__ __forceinline__ float sigmoidf_(float x) { return frcp_(1.f + fexp_(-x)); }
__device__ __forceinline__ float gelu_tanh(float x) { const float u = 0.7978845608028654f * (x + 0.044715f * x * x * x); return x * frcp_(1.f + fexp_(-2.f * u)); }
__device__ __forceinline__ int crow(int r, int hi) { return (r & 3) + 8 * (r >> 2) + 4 * hi; }
#define LDS_WAIT() asm volatile("s_waitcnt lgkmcnt(0)" ::: "memory")
__device__ __forceinline__ void lds_barrier() { asm volatile("s_waitcnt lgkmcnt(0)\n\ts_barrier" ::: "memory"); }
__device__ __forceinline__ int tid_now() { int t = threadIdx.x; asm volatile("" : "+v"(t)); return t; }

#define XB_TMO      128
#define XB_XCNT(j)  (256  + 64 * (j))
#define XB_XSUB(j)  (1280 + 64 * (j))
#define XB_XGEN(j)  (2304 + 64 * (j))
#define XB_TOP      3328
#define XB_TOPGEN   3392
#define XB_SPIN_CAP (1u << 22)
__device__ __forceinline__ unsigned xb_ld(unsigned* p)              { return __hip_atomic_load(p, __ATOMIC_RELAXED, __HIP_MEMORY_SCOPE_AGENT); }
__device__ __forceinline__ unsigned xb_add(unsigned* p, unsigned v) { return __hip_atomic_fetch_add(p, v, __ATOMIC_RELAXED, __HIP_MEMORY_SCOPE_AGENT); }
__device__ __forceinline__ unsigned xb_xcc_id() { return (unsigned)__builtin_amdgcn_s_getreg((3 << 11) | 20) & 0xFu; }
#define XB_SPIN(cond, bar) do { unsigned _sp = 0; while (cond) { __builtin_amdgcn_s_sleep(1); \
    if ((++_sp & 255u) == 0u) { if (xb_ld(&(bar)[XB_TMO])) break; if (_sp > XB_SPIN_CAP) { atomicAdd(&(bar)[XB_TMO], 1u); break; } } } } while (0)
struct XcdBarrier { unsigned* bar; unsigned x; volatile LAS unsigned* st; };
__device__ __forceinline__ XcdBarrier xcd_barrier_post(unsigned* bar, volatile LAS unsigned* st) {
    XcdBarrier b; b.bar = bar; b.x = xb_xcc_id(); b.st = st;
    if (threadIdx.x == 0) (void)xb_add(&bar[XB_XCNT(b.x)], 1u);
    return b;
}
__device__ __forceinline__ void xcd_barrier_complete(unsigned* bar, unsigned x, unsigned& nloc, unsigned& nx) {
    const unsigned G = gridDim.x * gridDim.y * gridDim.z;
    unsigned sum, cnt, mine, sp = 0u;
    for (;;) {
        sum = 0u; cnt = 0u; mine = 0u;
#pragma unroll 1
        for (unsigned j = 0; j < 16; ++j) { const unsigned c = xb_ld(&bar[XB_XCNT(j)]); sum += c; cnt += (c > 0u) ? 1u : 0u; mine = (j == x) ? c : mine; }
        if (sum == G) break;
        __builtin_amdgcn_s_sleep(1);
        if ((++sp & 255u) == 0u) { if (xb_ld(&bar[XB_TMO])) break; if (sp > XB_SPIN_CAP) { atomicAdd(&bar[XB_TMO], 1u); break; } }
    }
    nloc = mine > 0u ? mine : 1u; nx = cnt > 0u ? cnt : 1u;
}
__device__ __forceinline__ void xcd_barrier(const XcdBarrier& b) {
    asm volatile("s_waitcnt vmcnt(0)" ::: "memory");
    __syncthreads();
    if (threadIdx.x == 0) {
        unsigned* bar = b.bar;
        __builtin_amdgcn_s_waitcnt(0);
        const unsigned nloc = b.st[0], nx = b.st[1];
        const unsigned old = xb_add(&bar[XB_XSUB(b.x)], 1u);
        const unsigned gen = old / nloc;
        if (old + 1u == (gen + 1u) * nloc) {
            __builtin_amdgcn_fence(__ATOMIC_RELEASE, "agent");
            asm volatile("s_waitcnt vmcnt(0)" ::: "memory");
            const unsigned og = xb_add(&bar[XB_TOP], 1u);
            const unsigned tg = og / nx;
            if (og + 1u == (tg + 1u) * nx) xb_add(&bar[XB_TOPGEN], 1u);
            else XB_SPIN(xb_ld(&bar[XB_TOPGEN]) == tg, bar);
            __builtin_amdgcn_fence(__ATOMIC_ACQUIRE, "agent");
            xb_add(&bar[XB_XGEN(b.x)], 1u);
            asm volatile("s_waitcnt vmcnt(0)" ::: "memory");
        } else {
            XB_SPIN(xb_ld(&bar[XB_XGEN(b.x)]) == gen, bar);
            __builtin_amdgcn_fence(__ATOMIC_ACQUIRE, "agent");
            asm volatile("s_waitcnt vmcnt(0)" ::: "memory");
        }
    }
    __syncthreads();
}

__device__ __forceinline__ void unit_publish(unsigned* ctr) {
    asm volatile("s_waitcnt vmcnt(0)" ::: "memory");
    __builtin_amdgcn_s_barrier();
    if (threadIdx.x == 0) { __builtin_amdgcn_fence(__ATOMIC_RELEASE, "agent"); asm volatile("s_waitcnt vmcnt(0)" ::: "memory"); __hip_atomic_fetch_add(ctr, 1u, __ATOMIC_RELAXED, __HIP_MEMORY_SCOPE_AGENT); }
}
__device__ __forceinline__ void unit_wait(const unsigned* ctr, unsigned need) {
    if (threadIdx.x < 64) {
        unsigned spins = 0;
        while ((unsigned)__builtin_amdgcn_readfirstlane(__hip_atomic_load(ctr, __ATOMIC_RELAXED, __HIP_MEMORY_SCOPE_AGENT)) < need) { __builtin_amdgcn_s_sleep(2); if (++spins > (1u << 24)) break; }
        __builtin_amdgcn_fence(__ATOMIC_ACQUIRE, "agent");
        asm volatile("s_waitcnt vmcnt(0)" ::: "memory");
    }
    asm volatile("" ::: "memory"); __builtin_amdgcn_s_barrier(); asm volatile("" ::: "memory");
}

namespace pg8 {
constexpr int BM = 256, BK = 64, HALF = 128, HTB = HALF * BK * 2, STAGE_BYTES = 8 * HTB, NXCD = 8, WGM = 8;
__device__ __forceinline__ int lds_byte(int r, int c) { const int st = (r >> 4) * 2 + (c >> 5), rr = r & 15, cc = c & 31, ob = rr * 64 + cc * 2; return st * 1024 + (ob ^ (((ob >> 9) & 1) << 5)); }
__device__ __forceinline__ void stage_rc(int b, int& R, int& C) { const int st = b / 1024, sb = b % 1024, swz = sb ^ (((sb >> 9) & 1) << 5); R = (st >> 1) * 16 + swz / 64; C = (st & 1) * 32 + (swz % 64) / 2; }
__device__ __forceinline__ int perm32(int rho) { const int n = rho >> 4, i = rho & 15; return 8 * (i >> 2) + 4 * n + (i & 3); }

struct Unit { const char* A0; const char* A1; const char* B0; const char* B1; int pm, pn; };

struct DenseSched {
    const char* A; const char* Bt; int K, nM, nN, nwg, G, c; unsigned* done_ctr;
    __device__ __forceinline__ void init(const void* A_, const void* Bt_, int M, int N, int K_, int G_, int c_, unsigned* done_ = nullptr) { A = (const char*)A_; Bt = (const char*)Bt_; K = K_; nM = M / BM; nN = N / BM; nwg = nM * nN; G = G_; c = c_; done_ctr = done_; }
    __device__ __forceinline__ void a_ready(const Unit&) const {}
    __device__ __forceinline__ void done(const Unit& u) const { if (done_ctr) unit_publish(done_ctr + u.pm); }
    __device__ __forceinline__ bool next(int i, Unit& u) const {
        const long L = (long)i * G + c; if (L >= nwg) return false;
        int wgid = (int)L; { const int q = nwg / NXCD, r = nwg % NXCD, xcd = wgid % NXCD, off = wgid / NXCD; wgid = (xcd < r ? xcd * (q + 1) : r * (q + 1) + (xcd - r) * q) + off; }
        const int nig = WGM * nN, gid = wgid / nig, fm = gid * WGM, gsz = (nM - fm) < WGM ? (nM - fm) : WGM;
        u.pm = fm + ((wgid % nig) % gsz); u.pn = (wgid % nig) / gsz;
        const size_t hstep = (size_t)HALF * K * 2;
        u.A0 = A + (size_t)u.pm * 2 * hstep; u.A1 = u.A0 + hstep; u.B0 = Bt + (size_t)u.pn * 2 * hstep; u.B1 = u.B0 + hstep;
        return true;
    }
};

template <class Epi, class Sched, bool GATHER = false>
__device__ __forceinline__ void gemm_phase(LAS unsigned char* lds, const int K, const Sched& S, const Epi& E, const char* gbase = nullptr) {
    const int tid = tid_now(), wid = __builtin_amdgcn_readfirstlane(tid >> 6), lane = tid & 63, wr = wid >> 2, wc = wid & 3, fr = lane & 15, fq = lane >> 4;
    const int nt = K / BK;
    unsigned voffA[2], voffB[2];
#pragma unroll
    for (int i = 0; i < 2; ++i) { int R, C; stage_rc(tid * 16 + i * 8192, R, C); const int Rb = (R & ~31) + perm32(R & 31);
        voffA[i] = (unsigned)(R * K + C) * 2u; voffB[i] = (unsigned)(Rb * K + C) * 2u; }
    const size_t kstep = (size_t)(BK * 2);
    const unsigned ldsw = (unsigned)wid * 1024u;
    unsigned cv0[2] = {0u, 0u}, cv1[2] = {0u, 0u}, nv0[2] = {0u, 0u}, nv1[2] = {0u, 0u};
#define PG8_GOFF(v0_, v1_, listp) do { const int* rl_ = (const int*)(listp); _Pragma("unroll") for (int i_ = 0; i_ < 2; ++i_) { int R_, C_; stage_rc(tid * 16 + i_ * 8192, R_, C_); \
        v0_[i_] = (unsigned)rl_[R_] * (unsigned)(K * 2) + (unsigned)(C_ * 2); v1_[i_] = (unsigned)rl_[128 + R_] * (unsigned)(K * 2) + (unsigned)(C_ * 2); } } while (0)
#define PG8_STAGE2(bufoff, gb, va, vb, sel) do { _Pragma("unroll") for (int _i = 0; _i < 2; ++_i) \
        __builtin_amdgcn_global_load_lds((const unsigned*)((const char*)(gb) + ((sel) ? (vb)[_i] : (va)[_i])), (LAS unsigned*)(lds + (bufoff) + ldsw + _i * 8192), 16, 0, 0); } while (0)
    const int aoff = lds_byte(wr * 64 + fr, fq * 8), boff = lds_byte(wc * 32 + fr, fq * 8);
#define PG8_SA(b, h) (((b) * 2 + (h)) * HTB)
#define PG8_SB(b, h) ((4 + (b) * 2 + (h)) * HTB)
#define PG8_STAGE(bufoff, gbase, voff) do { _Pragma("unroll") for (int _i = 0; _i < 2; ++_i) \
        __builtin_amdgcn_global_load_lds((const unsigned*)((const char*)(gbase) + (voff)[_i]), (LAS unsigned*)(lds + (bufoff) + ldsw + _i * 8192), 16, 0, 0); } while (0)
#define PG8_LDA(dst, b, h) do { _Pragma("unroll") for (int m = 0; m < 4; ++m) _Pragma("unroll") for (int k = 0; k < 2; ++k) dst[m][k] = *(const LAS h16x8*)(lds + PG8_SA(b, h) + aoff + m * 2048 + k * 1024); } while (0)
#define PG8_LDB(dst, b, h) do { _Pragma("unroll") for (int n = 0; n < 2; ++n) _Pragma("unroll") for (int k = 0; k < 2; ++k) dst[n][k] = *(const LAS h16x8*)(lds + PG8_SB(b, h) + boff + n * 2048 + k * 1024); } while (0)
#define PG8_MMA(ai, bj, At, Bt) do { __builtin_amdgcn_s_setprio(1); _Pragma("unroll") for (int m = 0; m < 4; ++m) _Pragma("unroll") for (int n = 0; n < 2; ++n) _Pragma("unroll") for (int k = 0; k < 2; ++k) \
        acc[ai][bj][m][n] = __builtin_amdgcn_mfma_f32_16x16x32_f16(Bt[n][k], At[m][k], acc[ai][bj][m][n], 0, 0, 0); __builtin_amdgcn_s_setprio(0); } while (0)
#define PG8_WAIT_V(n) asm volatile("s_waitcnt vmcnt(" #n ")" ::: "memory")
#define PG8_WAIT_L(n) asm volatile("s_waitcnt lgkmcnt(" #n ")" ::: "memory")
#define PG8_BAR __builtin_amdgcn_s_barrier()
#define PG8_SCHED __builtin_amdgcn_sched_barrier(0)
    Unit cur, nxt; int ui = 0;
    if (!S.next(0, cur)) return;
    f32x4 acc[2][2][4][2];
#pragma unroll
    for (int a = 0; a < 2; ++a)
#pragma unroll
        for (int b = 0; b < 2; ++b)
#pragma unroll
            for (int m = 0; m < 4; ++m)
#pragma unroll
                for (int n = 0; n < 2; ++n) acc[a][b][m][n] = (f32x4){0.f, 0.f, 0.f, 0.f};
    h16x8 At[4][2], B0[2][2], B1[2][2];
    const char* cA0 = cur.A0; const char* cA1 = cur.A1; const char* cB0 = cur.B0; const char* cB1 = cur.B1;
    S.a_ready(cur);
    if constexpr (GATHER) { PG8_GOFF(cv0, cv1, cur.A0); }
    PG8_STAGE(PG8_SB(0, 0), cB0, voffB); PG8_STAGE(PG8_SB(0, 1), cB1, voffB);
    if constexpr (GATHER) { PG8_STAGE2(PG8_SA(0, 0), gbase, cv0, cv0, false); PG8_STAGE2(PG8_SA(0, 1), gbase, cv1, cv1, false); }
    else { PG8_STAGE(PG8_SA(0, 0), cA0, voffA); PG8_STAGE(PG8_SA(0, 1), cA1, voffA); }
    if (wr == 1) PG8_BAR;
    PG8_WAIT_V(2); PG8_BAR;
    PG8_STAGE(PG8_SB(1, 0), cB0 + kstep, voffB);
    if constexpr (GATHER) { PG8_STAGE2(PG8_SA(1, 0), gbase + kstep, cv0, cv0, false); } else { PG8_STAGE(PG8_SA(1, 0), cA0 + kstep, voffA); }
    PG8_STAGE(PG8_SB(1, 1), cB1 + kstep, voffB);
    PG8_WAIT_V(6); PG8_BAR;
    for (;;) {
        const bool has_next = S.next(ui + 1, nxt);
        const char* nA0 = has_next ? nxt.A0 : cA0; const char* nA1 = has_next ? nxt.A1 : cA1;
        const char* nB0 = has_next ? nxt.B0 : cB0; const char* nB1 = has_next ? nxt.B1 : cB1;
        for (int t = 0; t < nt; t += 2) {
            const bool last = (t == nt - 2);
            if (last && has_next) S.a_ready(nxt);
            if constexpr (GATHER) { if (last) { if (has_next) { PG8_GOFF(nv0, nv1, nxt.A0); } else { nv0[0] = cv0[0]; nv0[1] = cv0[1]; nv1[0] = cv1[0]; nv1[1] = cv1[1]; } } }
            const char* g1 = gbase + (size_t)(t + 1) * kstep; const char* g2 = gbase + (last ? (size_t)0 : (size_t)(t + 2) * kstep); const char* g3 = g2 + kstep;
            const char* a1_1 = cA1 + (size_t)(t + 1) * kstep;
            const char* a2_0 = last ? nA0 : cA0 + (size_t)(t + 2) * kstep; const char* a2_1 = last ? nA1 : cA1 + (size_t)(t + 2) * kstep;
            const char* b2_0 = last ? nB0 : cB0 + (size_t)(t + 2) * kstep; const char* b2_1 = last ? nB1 : cB1 + (size_t)(t + 2) * kstep;
            const char* a3_0 = a2_0 + kstep; const char* b3_0 = b2_0 + kstep; const char* b3_1 = b2_1 + kstep;
            PG8_LDB(B0, 0, 0); PG8_LDB(B1, 0, 1); PG8_SCHED; PG8_LDA(At, 0, 0); if constexpr (GATHER) { PG8_STAGE2(PG8_SA(1, 1), g1, cv1, cv1, false); } else { PG8_STAGE(PG8_SA(1, 1), a1_1, voffA); }
            PG8_WAIT_V(8); PG8_WAIT_L(0); PG8_BAR; PG8_MMA(0, 0, At, B0); PG8_MMA(0, 1, At, B1); PG8_BAR; PG8_SCHED;
            PG8_LDA(At, 0, 1); PG8_STAGE(PG8_SB(0, 0), b2_0, voffB); PG8_STAGE(PG8_SB(0, 1), b2_1, voffB); if constexpr (GATHER) { PG8_STAGE2(PG8_SA(0, 0), g2, cv0, nv0, last); } else { PG8_STAGE(PG8_SA(0, 0), a2_0, voffA); }
            PG8_WAIT_V(8); PG8_WAIT_L(0); PG8_BAR; PG8_MMA(1, 0, At, B0); PG8_MMA(1, 1, At, B1); PG8_BAR; PG8_SCHED;
            PG8_LDB(B0, 1, 0); PG8_LDB(B1, 1, 1); PG8_SCHED; PG8_LDA(At, 1, 0); if constexpr (GATHER) { PG8_STAGE2(PG8_SA(0, 1), g2, cv1, nv1, last); } else { PG8_STAGE(PG8_SA(0, 1), a2_1, voffA); }
            PG8_WAIT_V(8); PG8_WAIT_L(0); PG8_BAR; PG8_MMA(0, 0, At, B0); PG8_MMA(0, 1, At, B1); PG8_BAR; PG8_SCHED;
            PG8_LDA(At, 1, 1); PG8_STAGE(PG8_SB(1, 0), b3_0, voffB); PG8_STAGE(PG8_SB(1, 1), b3_1, voffB); if constexpr (GATHER) { PG8_STAGE2(PG8_SA(1, 0), g3, cv0, nv0, last); } else { PG8_STAGE(PG8_SA(1, 0), a3_0, voffA); }
            PG8_WAIT_V(8); PG8_WAIT_L(0); PG8_BAR; PG8_MMA(1, 0, At, B0); PG8_MMA(1, 1, At, B1); PG8_BAR; PG8_SCHED;
        }
        if (wr == 0) PG8_BAR;
        E(acc, cur, wr, wc, fr, fq);
        S.done(cur);
        if (!has_next) break;
#pragma unroll
        for (int a = 0; a < 2; ++a)
#pragma unroll
            for (int b = 0; b < 2; ++b)
#pragma unroll
                for (int m = 0; m < 4; ++m)
#pragma unroll
                    for (int n = 0; n < 2; ++n) acc[a][b][m][n] = (f32x4){0.f, 0.f, 0.f, 0.f};
        cur = nxt; cA0 = nA0; cA1 = nA1; cB0 = nB0; cB1 = nB1; ++ui;
        if constexpr (GATHER) { cv0[0] = nv0[0]; cv0[1] = nv0[1]; cv1[0] = nv1[0]; cv1[1] = nv1[1]; }
        if (wr == 1) PG8_BAR;
    }
    PG8_WAIT_V(0);
    PG8_BAR;
#undef PG8_SA
#undef PG8_SB
#undef PG8_STAGE
#undef PG8_STAGE2
#undef PG8_GOFF
#undef PG8_LDA
#undef PG8_LDB
#undef PG8_MMA
#undef PG8_WAIT_V
#undef PG8_WAIT_L
#undef PG8_BAR
#undef PG8_SCHED
}
}
using pg8::Unit;
typedef f32x4 AccT[2][2][4][2];

struct EpiInProj {
    h16 *qa, *ka, *vat, *xr, *gg, *qd, *kd, *vdt; const f32x2* rope; unsigned* kmax; LAS unsigned char* scr;
    __device__ __forceinline__ void operator()(const AccT& acc, const Unit& u, int wr, int wc, int fr, int fq) const {
        const int pn = u.pn;
        const bool isctx = (u.pm >= NLAT / 256);
        const float QSA = 0.125f * LOG2E, QSD = 0.17677669529663687f * LOG2E;
        float kn2[2] = {0.f, 0.f};
        if (pn == 2 || pn == 9) {
            h16* const vbase = (pn == 2 ? vat : vdt);
            LAS unsigned char* const sw = scr + (wr * 4 + wc) * 1536;
            const int lane = fq * 16 + fr;
#pragma unroll
            for (int ai = 0; ai < 2; ++ai)
#pragma unroll
                for (int m = 0; m < 4; ++m) {
                    const int row0 = u.pm * 256 + ai * 128 + wr * 64 + m * 16;
                    int b, key0;
                    if (isctx) { const int c = row0 - NLAT; b = c >> 8; key0 = SEQ + (c & 255); } else { b = row0 >> 13; key0 = row0 & (SEQ - 1); }
#pragma unroll
                    for (int bj = 0; bj < 2; ++bj) {
#pragma unroll
                        for (int j = 0; j < 8; ++j) *(LAS h16*)(sw + (fq * 8 + j) * 48 + fr * 2) = (h16)acc[ai][bj][m][j >> 2][j & 3];
                        asm volatile("s_waitcnt lgkmcnt(0)" ::: "memory");
                        const u32x4 w = *(const LAS u32x4*)(sw + (lane >> 1) * 48 + (lane & 1) * 16);
                        asm volatile("s_waitcnt lgkmcnt(0)" ::: "memory");
                        *(u32x4*)(vbase + ((size_t)(b * 256 + bj * 128 + wc * 32 + (lane >> 1))) * KEYS + key0 + (lane & 1) * 8) = w;
                    }
                }
            return;
        }
#pragma unroll
        for (int ai = 0; ai < 2; ++ai)
#pragma unroll
            for (int m = 0; m < 4; ++m) {
                const int row = u.pm * 256 + ai * 128 + wr * 64 + m * 16 + fr;
                int b, key, t;
                if (isctx) { const int c = row - NLAT; b = c >> 8; t = c & 255; key = SEQ + t; } else { b = row >> 13; t = row & (SEQ - 1); key = t; }
#pragma unroll
                for (int bj = 0; bj < 2; ++bj) {
                    const int col = bj * 128 + wc * 32 + 8 * fq;
                    float v[8];
#pragma unroll
                    for (int j = 0; j < 4; ++j) { v[j] = acc[ai][bj][m][0][j]; v[4 + j] = acc[ai][bj][m][1][j]; }
                    if (pn == 7 || pn == 8) {
                        float pr[8];
#pragma unroll
                        for (int j = 0; j < 8; ++j) pr[j] = __shfl_xor(v[j], 16);
                        if (!isctx) {
                            const int pos = (fq < 2) ? (t >> 6) : (t & 63);
                            const f32x2* tb = rope + pos * 8;
#pragma unroll
                            for (int j = 0; j < 8; ++j) { const f32x2 cs = tb[j]; const float sn = (fq & 1) ? cs.y : -cs.y; v[j] = v[j] * cs.x + pr[j] * sn; }
                        }
                        if (pn == 8) { float ss = 0.f;
#pragma unroll
                            for (int j = 0; j < 8; ++j) ss += v[j] * v[j];
                            kn2[bj] = fmaxf(kn2[bj], ss); }
                    }
                    {
                        h16* dst; float sc = 1.f;
                        if (pn == 0) { dst = qa + (size_t)row * 256 + col; sc = QSA; }
                        else if (pn == 1) { dst = ka + ((size_t)(b * KEYS + key)) * 256 + col; }
                        else if (pn == 3 || pn == 4) { dst = xr + (size_t)row * 512 + (pn - 3) * 256 + col; }
                        else if (pn == 5 || pn == 6) { dst = gg + (size_t)row * 512 + (pn - 5) * 256 + col;
#pragma unroll
                            for (int j = 0; j < 8; ++j) v[j] = gelu_tanh(v[j]); }
                        else if (pn == 7) { dst = qd + (size_t)row * 256 + col; sc = QSD; }
                        else { dst = kd + ((size_t)(b * KEYS + key)) * 256 + col; }
                        u32x4 w; w.x = pkh(v[0] * sc, v[1] * sc); w.y = pkh(v[2] * sc, v[3] * sc); w.z = pkh(v[4] * sc, v[5] * sc); w.w = pkh(v[6] * sc, v[7] * sc);
                        *(u32x4*)dst = w;
                    }
                }
            }
        if (pn == 8) {
            const int b = isctx ? (u.pm - NLAT / 256) : (u.pm >> 5);
#pragma unroll
            for (int bj = 0; bj < 2; ++bj) {
                float ss = kn2[bj]; ss += __shfl_xor(ss, 16); ss += __shfl_xor(ss, 32);
#pragma unroll
                for (int o = 1; o < 16; o <<= 1) ss = fmaxf(ss, __shfl_xor(ss, o));
                if ((fr | fq) == 0) atomicMax(kmax + (b * 4 + 2 * bj + (wc >> 1)) * 2 + (wc & 1), __float_as_uint(ss));
            }
        }
    }
};

struct EpiOutProj {
    float* xl; const float* mod; float* xo;
    __device__ __forceinline__ void operator()(const AccT& acc, const Unit& u, int wr, int wc, int fr, int fq) const {
        const int vsel = (u.pm >= NLAT / 256) ? 2 : (u.pm >= NLAT / 512 ? 1 : 0);
        const float* ga = mod + vsel * 6144 + 2 * 1024;
#pragma unroll
        for (int bj = 0; bj < 2; ++bj) {
            const int col = u.pn * 256 + bj * 128 + wc * 32 + 8 * fq;
            const f32x4 g0 = *(const f32x4*)(ga + col), g1 = *(const f32x4*)(ga + col + 4);
#pragma unroll
            for (int ai = 0; ai < 2; ++ai)
#pragma unroll
                for (int m = 0; m < 4; ++m) {
                    const int row = u.pm * 256 + ai * 128 + wr * 64 + m * 16 + fr;
                    const float* p = xl + (size_t)row * D + col; float* q = xo + (size_t)row * D + col;
                    f32x4 x0 = *(const f32x4*)p, x1 = *(const f32x4*)(p + 4);
                    x0 += g0 * acc[ai][bj][m][0]; x1 += g1 * acc[ai][bj][m][1];
                    *(f32x4*)q = x0; *(f32x4*)(q + 4) = x1;
                }
        }
    }
};

struct MoeSched1 {
    const char* xg; const char* w1t; const char* w3t; const unsigned* tmap; volatile LAS int* tab; int ntiles, G, c; unsigned* done7;
    __device__ __forceinline__ void a_ready(const Unit&) const {}
    __device__ __forceinline__ void done(const Unit& u) const { unit_publish(done7 + u.pm); }
    __device__ __forceinline__ bool next(int i, Unit& u) const {
        const int L = i * G + c; if (L >= ntiles * 4) return false;
        const int Ts = L >> 2, pn = L & 3; int e = 0;
        for (int j = 1; j < NEXP; ++j) e += (tab[j] <= Ts) ? 1 : 0;
        e = __builtin_amdgcn_readfirstlane(e);
        const int T = __builtin_amdgcn_readfirstlane((int)tmap[e * 72 + (Ts - tab[e])] - 1);
        u.pm = T; u.pn = pn;
        u.A0 = xg + (size_t)T * 256 * 4; u.A1 = u.A0;
        const size_t wo = ((size_t)e * DEXP + (size_t)pn * 128) * 2048;
        u.B0 = w1t + wo; u.B1 = w3t + wo;
        return true;
    }
};
struct MoeSched2 {
    const char* act; const char* w2t; const unsigned* tmap; volatile LAS int* tab; int ntiles, G, c; const unsigned* done7; int i0;
    __device__ __forceinline__ void a_ready(const Unit& u) const { unit_wait(done7 + u.pm, 4u); }
    __device__ __forceinline__ void done(const Unit&) const {}
    __device__ __forceinline__ bool next(int i, Unit& u) const {
        const int L = (i + i0) * G + c - ntiles * 4; if (L >= ntiles * 4) return false;
        const int Ts = L >> 2, pn = L & 3; int e = 0;
        for (int j = 1; j < NEXP; ++j) e += (tab[j] <= Ts) ? 1 : 0;
        e = __builtin_amdgcn_readfirstlane(e);
        const int T = __builtin_amdgcn_readfirstlane((int)tmap[e * 72 + (Ts - tab[e])] - 1);
        u.pm = T; u.pn = pn;
        u.A0 = act + (size_t)T * 256 * 1024; u.A1 = u.A0 + (size_t)128 * 1024;
        u.B0 = w2t + ((size_t)e * D + (size_t)pn * 256) * 1024; u.B1 = u.B0 + (size_t)128 * 1024;
        return true;
    }
};
struct EpiMoe1 {
    h16* act;
    __device__ __forceinline__ void operator()(const AccT& acc, const Unit& u, int wr, int wc, int fr, int fq) const {
#pragma unroll
        for (int ai = 0; ai < 2; ++ai)
#pragma unroll
            for (int m = 0; m < 4; ++m) {
                const int row = u.pm * 256 + ai * 128 + wr * 64 + m * 16 + fr;
                float v[8];
#pragma unroll
                for (int n = 0; n < 2; ++n)
#pragma unroll
                    for (int j = 0; j < 4; ++j) { const float a = acc[ai][0][m][n][j], b = acc[ai][1][m][n][j]; v[4 * n + j] = a * frcp_(1.f + fexp_(-a)) * b; }
                u32x4 w; w.x = pkh(v[0], v[1]); w.y = pkh(v[2], v[3]); w.z = pkh(v[4], v[5]); w.w = pkh(v[6], v[7]);
                *(u32x4*)(act + (size_t)row * DEXP + u.pn * 128 + wc * 32 + 8 * fq) = w;
            }
    }
};
struct EpiMoe2 {
    h16* yb;
    __device__ __forceinline__ void operator()(const AccT& acc, const Unit& u, int wr, int wc, int fr, int fq) const {
#pragma unroll
        for (int ai = 0; ai < 2; ++ai)
#pragma unroll
            for (int m = 0; m < 4; ++m) {
                const int row = u.pm * 256 + ai * 128 + wr * 64 + m * 16 + fr;
#pragma unroll
                for (int bj = 0; bj < 2; ++bj) {
                    const f32x4 v0 = acc[ai][bj][m][0], v1 = acc[ai][bj][m][1];
                    u32x4 w; w.x = pkh(v0[0], v0[1]); w.y = pkh(v0[2], v0[3]); w.z = pkh(v1[0], v1[1]); w.w = pkh(v1[2], v1[3]);
                    *(u32x4*)(yb + (size_t)row * D + u.pn * 256 + bj * 128 + wc * 32 + 8 * fq) = w;
                }
            }
    }
};

__device__ __forceinline__ void p0_transpose_item(const float* W, int K, int N, h16* WT, LAS h16* scr, int item, int lane) {
    const int nblk = N / 64, kb = item / nblk, nb = item % nblk, k0 = 64 * kb, n0 = 64 * nb;
    const float* src = W + (size_t)k0 * N + n0 + lane;
#pragma unroll 32
    for (int i = 0; i < 64; ++i) scr[i * 66 + lane] = (h16)src[(size_t)i * N];
    LDS_WAIT(); asm volatile("" ::: "memory");
    const int c = lane & 7;
#pragma unroll
    for (int j = 0; j < 8; ++j) { const int n = (lane >> 3) + 8 * j; const LAS h16* s = scr + (8 * c) * 66 + n;
        h16x8 o;
#pragma unroll
        for (int t = 0; t < 8; ++t) o[t] = s[t * 66];
        *(h16x8*)(WT + (size_t)(n0 + n) * K + k0 + 8 * c) = o; }
    LDS_WAIT(); asm volatile("" ::: "memory");
}

__device__ __forceinline__ void phase_p0(KP p, LAS unsigned char* lds, int vcu, int G) {
    const int tid = tid_now(), lane = tid & 63, wave = __builtin_amdgcn_readfirstlane(tid >> 6);
    unsigned char* ws = p->ws;
    LAS float* sc = (LAS float*)lds;
    LAS float* red = (LAS float*)(lds + 12288);
    for (int i = tid; i < 3 * 1024; i += NTHREADS) { const float x = (i < 2048) ? p->in[I_C][i] : p->in[I_CCTX][i - 2048]; sc[i] = x / (1.f + __expf(-x)); }
    __syncthreads();
    float* mod = (float*)(ws + WS_MOD);
    for (int it = blockIdx.x; it < DEPTH * 96; it += G) {
        const int l = it / 96, nb = it % 96, n = nb * 64 + lane;
        const float* W = p->in[I_WADA] + (size_t)l * D * 6144 + n;
        float a0 = 0.f, a1 = 0.f, a2 = 0.f;
#pragma unroll 32
        for (int k = wave * 128; k < wave * 128 + 128; ++k) { const float w = W[(size_t)k * 6144]; a0 += sc[k] * w; a1 += sc[1024 + k] * w; a2 += sc[2048 + k] * w; }
        red[(wave * 3 + 0) * 64 + lane] = a0; red[(wave * 3 + 1) * 64 + lane] = a1; red[(wave * 3 + 2) * 64 + lane] = a2;
        __syncthreads();
        if (tid < 192) { const int v = tid >> 6, ln = tid & 63; float s = p->in[I_BADA][l * 6144 + nb * 64 + ln];
#pragma unroll
            for (int w = 0; w < 8; ++w) s += red[(w * 3 + v) * 64 + ln];
            mod[((size_t)l * 3 + v) * 6144 + nb * 64 + ln] = s; }
        __syncthreads();
    }
    if (blockIdx.x == 0) {
        f32x2* tab = (f32x2*)(ws + WS_ROPE);
        for (int i = tid; i < 128 * 8; i += NTHREADS) { const int pos = i >> 3, j = i & 7; const float f = powf(10000.f, -(float)j / 8.f); const float ang = (float)pos * f; tab[i] = (f32x2){cosf(ang), sinf(ang)}; }
        if (tid < DEPTH) { const float* lv = p->in[I_DLAM] + tid * 128; float s1 = 0.f, s2 = 0.f;
            for (int j = 0; j < 32; ++j) { s1 += lv[j] * lv[32 + j]; s2 += lv[64 + j] * lv[96 + j]; }
            ((float*)(ws + WS_LAM))[tid] = expf(s1) - expf(s2) + (0.8f - 0.6f * expf(-0.3f * (float)tid)); }
    }
    LAS h16* scr = (LAS h16*)(lds + 32768 + wave * 8448);
    const int gw = vcu * NWAVES + wave, NGW = G * NWAVES;
    constexpr int N_IN = DEPTH * 16 * 40, N_OUT = DEPTH * 16 * 16, N_E = DEPTH * NEXP * 128, N_RG = DEPTH * 2 * 8;
    constexpr int NITEMS = N_IN + N_OUT + 3 * N_E + 2 * N_RG;
    for (int it = gw; it < NITEMS; it += NGW) {
        int r = it;
        if (r < N_IN) { const int l = r / 640; p0_transpose_item(p->in[I_WIN] + (size_t)l * D * INC, D, INC, (h16*)(ws + WS_WIN) + (size_t)l * INC * D, scr, r % 640, lane); continue; } r -= N_IN;
        if (r < N_OUT) { const int l = r / 256; p0_transpose_item(p->in[I_WOUT] + (size_t)l * D * D, D, D, (h16*)(ws + WS_WOUT) + (size_t)l * D * D, scr, r % 256, lane); continue; } r -= N_OUT;
        if (r < N_E) { const int mi = r / 128; p0_transpose_item(p->in[I_W1] + (size_t)mi * D * DEXP, D, DEXP, (h16*)(ws + WS_W1) + (size_t)mi * D * DEXP, scr, r % 128, lane); continue; } r -= N_E;
        if (r < N_E) { const int mi = r / 128; p0_transpose_item(p->in[I_W3] + (size_t)mi * D * DEXP, D, DEXP, (h16*)(ws + WS_W3) + (size_t)mi * D * DEXP, scr, r % 128, lane); continue; } r -= N_E;
        if (r < N_E) { const int mi = r / 128; p0_transpose_item(p->in[I_W2] + (size_t)mi * D * DEXP, DEXP, D, (h16*)(ws + WS_W2) + (size_t)mi * D * DEXP, scr, r % 128, lane); continue; } r -= N_E;
        {
            const int gate = r / N_RG; r %= N_RG; const int mi = r; const int ldir = mi >> 3, nb = mi & 7;
            const float* src = p->in[gate ? I_RGWI : I_RGWR] + (size_t)mi * 4096;
            h16* dst = (h16*)(ws + WS_RGW) + ((size_t)(ldir * 2 + gate) * 8 + nb) * 4096;
            p0_transpose_item(src, 64, 64, dst, scr, 0, lane);
        }
    }
}

__device__ __forceinline__ void phase_norm1(KP p, int l, int mode, volatile LAS int* tab, int vcu, int G, bool dummy) {
    const int tid = tid_now(); const int lane = tid & 63, wave = __builtin_amdgcn_readfirstlane(tid >> 6);
    unsigned char* ws = p->ws;
    float* xl = (float*)(ws + WS_XL); h16* hl = (h16*)(ws + (dummy ? WS_ACT : WS_HL)); float* xlo = dummy ? (float*)(ws + WS_XG) : xl;
    const float* mod = (const float*)(ws + WS_MOD);
    const int* asg = (const int*)(ws + WS_ASG); const float* ew = (const float*)(ws + WS_EW);
    const h16* yb = (const h16*)(ws + WS_YB);
    const int nrows = (mode == 2) ? NLAT : NROW;
    const int prev_rows = (l == DEPTH) ? NLAT : NROW;
    const int gw = vcu * NWAVES + wave, NGW = G * NWAVES;
    for (int row = gw; row < nrows; row += NGW) {
        const int v = (row < NLAT) ? (row >> 13) : 2;
        f32x4 x[4];
        if (mode == 0) {
            const float* src = (row < NLAT) ? p->in[I_X] + (size_t)row * D : p->in[I_CTX] + (size_t)(row - NLAT) * D;
#pragma unroll
            for (int j = 0; j < 4; ++j) x[j] = *(const f32x4*)(src + 4 * lane + 256 * j);
        } else {
            const float* src = xl + (size_t)row * D;
#pragma unroll
            for (int j = 0; j < 4; ++j) x[j] = *(const f32x4*)(src + 4 * lane + 256 * j);
            if (row < prev_rows) {
                const int a0 = asg[row * 2], a1 = asg[row * 2 + 1];
                const float w0 = ew[row * 2], w1 = ew[row * 2 + 1];
                const size_t s0 = (size_t)a0, s1 = (size_t)a1;
                const float* ga = mod + ((size_t)(l - 1) * 3 + v) * 6144 + 5 * 1024;
#pragma unroll
                for (int j = 0; j < 4; ++j) {
                    const int c = 4 * lane + 256 * j;
                    const h16x4 y0 = *(const h16x4*)(yb + s0 * D + c), y1 = *(const h16x4*)(yb + s1 * D + c);
                    const f32x4 g = *(const f32x4*)(ga + c);
#pragma unroll
                    for (int e = 0; e < 4; ++e) x[j][e] += g[e] * (w0 * (float)y0[e] + w1 * (float)y1[e]);
                }
            }
        }
        if (mode != 2) {
            float* dst = xlo + (size_t)row * D;
#pragma unroll
            for (int j = 0; j < 4; ++j) *(f32x4*)(dst + 4 * lane + 256 * j) = x[j];
        }
        float ss = 0.f;
#pragma unroll
        for (int j = 0; j < 4; ++j) ss += x[j][0] * x[j][0] + x[j][1] * x[j][1] + x[j][2] * x[j][2] + x[j][3] * x[j][3];
        const float rstd = rsqrtf(wave_sum(ss) * (1.f / D) + EPS);
        if (mode == 2) {
            const float* g = p->in[I_GFINAL]; float* o = p->out + (size_t)row * D;
#pragma unroll
            for (int j = 0; j < 4; ++j) { const int c = 4 * lane + 256 * j; const f32x4 gv = *(const f32x4*)(g + c); *(f32x4*)(o + c) = x[j] * rstd * gv; }
        } else {
            const float* g = p->in[I_GMIX] + l * D; const float* sh = mod + ((size_t)l * 3 + v) * 6144; const float* scl = sh + 1024;
            h16* o = hl + (size_t)row * D;
#pragma unroll
            for (int j = 0; j < 4; ++j) { const int c = 4 * lane + 256 * j; const f32x4 gv = *(const f32x4*)(g + c), sv = *(const f32x4*)(scl + c), hv = *(const f32x4*)(sh + c);
                const f32x4 y = x[j] * rstd * gv * (1.f + sv) + hv;
                u32x2 w; w.x = pkh(y[0], y[1]); w.y = pkh(y[2], y[3]); *(u32x2*)(o + c) = w; }
        }
    }
}

#define SM_THR 6.0f
#define SOFTMAX_TILE(s, m, l, oA, oB, pfa, pfb) do { \
    float mx_ = fmaxf(fmaxf(s[0], s[1]), s[2]); \
    _Pragma("unroll") for (int r_ = 3; r_ < 15; r_ += 2) mx_ = fmaxf(fmaxf(mx_, s[r_]), s[r_ + 1]); \
    mx_ = fmaxf(mx_, s[15]); mx_ = xhalf_max(mx_); \
    if (__any(mx_ > m + SM_THR)) { const float dl_ = (mx_ > m + SM_THR) ? (mx_ - m) : 0.f; m += dl_; \
        const float al_ = __builtin_amdgcn_exp2f(-dl_); l *= al_; oA *= al_; oB *= al_; } \
    _Pragma("unroll") for (int r_ = 0; r_ < 16; ++r_) s[r_] = __builtin_amdgcn_exp2f(s[r_] - m); \
    { float sm_ = 0.f; _Pragma("unroll") for (int r_ = 0; r_ < 16; ++r_) sm_ += s[r_]; l += sm_; } \
    _Pragma("unroll") for (int j_ = 0; j_ < 8; ++j_) { pfa[j_] = (h16)s[j_]; pfb[j_] = (h16)s[8 + j_]; } \
} while (0)

__device__ __forceinline__ int pi32(int r) { return (r & 19) | (((r >> 3) & 1) << 2) | (((r >> 2) & 1) << 3); }

constexpr int DA_STAGE = 18432;
__device__ __forceinline__ unsigned pkrtz(float a, float b) { return __builtin_bit_cast(unsigned, __builtin_amdgcn_cvt_pkrtz(a, b)); }
__device__ __forceinline__ void da_exp_pack(f32x16& s, float& l, h16x8& pa, h16x8& pb) {
#pragma unroll
    for (int r = 0; r < 16; ++r) s[r] = __builtin_amdgcn_exp2f(s[r]);
    u32x4 wa, wb;
    wa.x = pkrtz(s[0], s[1]); wa.y = pkrtz(s[2], s[3]); wa.z = pkrtz(s[4], s[5]); wa.w = pkrtz(s[6], s[7]);
    wb.x = pkrtz(s[8], s[9]); wb.y = pkrtz(s[10], s[11]); wb.z = pkrtz(s[12], s[13]); wb.w = pkrtz(s[14], s[15]);
    const h16x2 one2 = {(h16)1.f, (h16)1.f};
    float sm = l;
#pragma unroll
    for (int j = 0; j < 4; ++j) { sm = __builtin_amdgcn_fdot2(__builtin_bit_cast(h16x2, wa[j]), one2, sm, false); sm = __builtin_amdgcn_fdot2(__builtin_bit_cast(h16x2, wb[j]), one2, sm, false); }
    l = sm;
    pa = __builtin_bit_cast(h16x8, wa); pb = __builtin_bit_cast(h16x8, wb);
}
__device__ __forceinline__ void diff_unit(KP p, int l, int b, int h, int qrow0, int kt0, int nkt, LAS unsigned char* lds) {
    const int tid = tid_now(), lane = tid & 63, wid = __builtin_amdgcn_readfirstlane(tid >> 6), q32 = lane & 31, hi = lane >> 5;
    unsigned char* ws = p->ws;
    const h16* Qd = (const h16*)(ws + WS_QD); const h16* Kd = (const h16*)(ws + WS_KD); const h16* VdT = (const h16*)(ws + WS_VDT);
    h16* mix = (h16*)(ws + WS_MIX);
    const int qrow = qrow0 + wid * 32 + q32;
    h16x8 qf00, qf01, qf10, qf11;
    {
        const h16* qp = Qd + (size_t)qrow * 256 + h * 64 + hi * 8;
        qf00 = *(const h16x8*)(qp); qf01 = *(const h16x8*)(qp + 16); qf10 = *(const h16x8*)(qp + 32); qf11 = *(const h16x8*)(qp + 48);
    }
    const h16x8 zero8 = {0, 0, 0, 0, 0, 0, 0, 0};
    f32x16 negm0, negm1;
    {
        const float* km = (const float*)((const unsigned*)(ws + WS_CTL) + CW_KMAX + l * 16) + (b * 4 + h) * 2;
        float q0 = 0.f, q1 = 0.f;
#pragma unroll
        for (int j = 0; j < 8; ++j) { q0 += (float)qf00[j] * (float)qf00[j] + (float)qf01[j] * (float)qf01[j]; q1 += (float)qf10[j] * (float)qf10[j] + (float)qf11[j] * (float)qf11[j]; }
        q0 = xhalf_sum(q0); q1 = xhalf_sum(q1);
        const float m0 = sqrtf(q0 * km[0]) * 1.004f + 0.01f - 10.f, m1 = sqrtf(q1 * km[1]) * 1.004f + 0.01f - 10.f;
#pragma unroll
        for (int r = 0; r < 16; ++r) { negm0[r] = -m0; negm1[r] = -m1; }
    }
    const int srow = tid >> 3, sch = tid & 7;
    const h16* kg = Kd + ((size_t)(b * KEYS + kt0 * 64 + srow)) * 256 + h * 64 + sch * 8;
    const h16* vg = VdT + ((size_t)((b * 4 + h) * 64 + srow)) * KEYS + kt0 * 64 + sch * 8;
    const int sto = srow * 144 + sch * 16;
    const int koff = pi32(q32) * 144 + hi * 16, voff = 9216 + q32 * 144 + hi * 16;
    float l0 = 0.f, l1 = 0.f;
    f32x16 o00 = {}, o01 = {}, o10 = {}, o11 = {};
#define DA_MF(a_, b_, c_) __builtin_amdgcn_mfma_f32_32x32x16_f16(a_, b_, c_, 0, 0, 0)
#define DA_KLOAD(addr) do { const LAS unsigned char* kb_ = (addr); kf0a = *(const LAS h16x8*)(kb_); kf0b = *(const LAS h16x8*)(kb_ + 32); kf1a = *(const LAS h16x8*)(kb_ + 64); kf1b = *(const LAS h16x8*)(kb_ + 96); } while (0)
#define DA_VLOAD(addr) do { const LAS unsigned char* vb_ = (addr); v00 = *(const LAS h16x8*)(vb_); v10 = *(const LAS h16x8*)(vb_ + 4608); v01 = *(const LAS h16x8*)(vb_ + 32); v11 = *(const LAS h16x8*)(vb_ + 4608 + 32); } while (0)
#define DA_STEP(PP0a, PP0b, PP1a, PP1b, PN0a, PN0b, PN1a, PN1b, vaddr, kaddr) do { \
        o00 = DA_MF(v00, PP0a, o00); o10 = DA_MF(v00, PP1a, o10); o01 = DA_MF(v10, PP0a, o01); o11 = DA_MF(v10, PP1a, o11); \
        o00 = DA_MF(v01, PP0b, o00); o10 = DA_MF(v01, PP1b, o10); o01 = DA_MF(v11, PP0b, o01); o11 = DA_MF(v11, PP1b, o11); \
        da_exp_pack(s0, l0, PN0a, PN0b); \
        s0 = DA_MF(kf0a, qf00, negm0); s0 = DA_MF(kf0b, qf01, s0); \
        da_exp_pack(s1, l1, PN1a, PN1b); \
        s1 = DA_MF(kf1a, qf10, negm1); s1 = DA_MF(kf1b, qf11, s1); \
        DA_VLOAD(vaddr); DA_KLOAD(kaddr); \
    } while (0)
    __syncthreads();
    u32x4 kreg = *(const u32x4*)kg, vreg = *(const u32x4*)vg;
    *(LAS u32x4*)(lds + sto) = kreg; *(LAS u32x4*)(lds + 9216 + sto) = vreg;
    kreg = *(const u32x4*)(kg + (size_t)64 * 256); vreg = *(const u32x4*)(vg + 64);
    *(LAS u32x4*)(lds + DA_STAGE + sto) = kreg; *(LAS u32x4*)(lds + DA_STAGE + 9216 + sto) = vreg;
    if (nkt > 2) { kreg = *(const u32x4*)(kg + (size_t)2 * 64 * 256); vreg = *(const u32x4*)(vg + 2 * 64); }
    __syncthreads();
    f32x16 s0, s1;
    h16x8 kf0a, kf0b, kf1a, kf1b, v00, v10, v01, v11;
    h16x8 pa0a = zero8, pa0b = zero8, pa1a = zero8, pa1b = zero8, pb0a = zero8, pb0b = zero8, pb1a = zero8, pb1b = zero8;
    DA_KLOAD(lds + koff);
    s0 = DA_MF(kf0a, qf00, negm0); s0 = DA_MF(kf0b, qf01, s0);
    s1 = DA_MF(kf1a, qf10, negm1); s1 = DA_MF(kf1b, qf11, s1);
    DA_KLOAD(lds + koff + 4608);
    DA_VLOAD(lds + voff);
    int cur = 0, nxt = DA_STAGE, wrs = 2 * DA_STAGE;
    for (int t = 0; t < nkt; ++t) {
        if (t + 2 < nkt) { *(LAS u32x4*)(lds + wrs + sto) = kreg; *(LAS u32x4*)(lds + wrs + 9216 + sto) = vreg; }
        if (t + 3 < nkt) { kreg = *(const u32x4*)(kg + (size_t)(t + 3) * 64 * 256); vreg = *(const u32x4*)(vg + (size_t)(t + 3) * 64); }
        const int pf = (t + 1 < nkt) ? nxt : cur;
        DA_STEP(pb0a, pb0b, pb1a, pb1b, pa0a, pa0b, pa1a, pa1b, lds + cur + voff, lds + pf + koff);
        DA_STEP(pa0a, pa0b, pa1a, pa1b, pb0a, pb0b, pb1a, pb1b, lds + cur + voff + 64, lds + pf + koff + 4608);
        { const int tmp = cur; cur = nxt; nxt = wrs; wrs = tmp; }
        __syncthreads();
    }
    o00 = DA_MF(v00, pb0a, o00); o10 = DA_MF(v00, pb1a, o10); o01 = DA_MF(v10, pb0a, o01); o11 = DA_MF(v10, pb1a, o11);
    o00 = DA_MF(v01, pb0b, o00); o10 = DA_MF(v01, pb1b, o10); o01 = DA_MF(v11, pb0b, o01); o11 = DA_MF(v11, pb1b, o11);
#undef DA_MF
#undef DA_KLOAD
#undef DA_VLOAD
#undef DA_STEP
    const float lam = ((const float*)(ws + WS_LAM))[l];
    const float lam_init = 0.8f - 0.6f * expf(-0.3f * (float)l);
    const float r0 = 1.f / xhalf_sum(l0), r1 = lam / xhalf_sum(l1);
    f32x16 y0 = o00 * r0 - o10 * r1, y1 = o01 * r0 - o11 * r1;
    float ss = 0.f;
#pragma unroll
    for (int r = 0; r < 16; ++r) ss += y0[r] * y0[r] + y1[r] * y1[r];
    ss = xhalf_sum(ss);
    const float sc = rsqrtf(ss * (1.f / 64.f) + EPS) * (1.f - lam_init);
    const float* g = p->in[I_DSUBG] + l * 64;
    h16* dst = mix + (size_t)qrow * D + 768 + h * 64;
#pragma unroll
    for (int r4 = 0; r4 < 4; ++r4) {
        const int e0 = 8 * r4 + 4 * hi;
        const f32x4 g0 = *(const f32x4*)(g + e0), g1 = *(const f32x4*)(g + 32 + e0);
        u32x2 w0, w1;
        w0.x = pkh(y0[4 * r4] * sc * g0[0], y0[4 * r4 + 1] * sc * g0[1]); w0.y = pkh(y0[4 * r4 + 2] * sc * g0[2], y0[4 * r4 + 3] * sc * g0[3]);
        w1.x = pkh(y1[4 * r4] * sc * g1[0], y1[4 * r4 + 1] * sc * g1[1]); w1.y = pkh(y1[4 * r4 + 2] * sc * g1[2], y1[4 * r4 + 3] * sc * g1[3]);
        *(u32x2*)(dst + e0) = w0; *(u32x2*)(dst + 32 + e0) = w1;
    }
}

constexpr int NA_K = 0, NA_V = 33792, NA_BIAS = 33792 + 36864;
__device__ __forceinline__ void na_unit(KP p, int l, int b, int gr, bool isctx, LAS unsigned char* lds) {
    const int tid = tid_now(), lane = tid & 63, wid = __builtin_amdgcn_readfirstlane(tid >> 6), q32 = lane & 31, hi = lane >> 5;
    const int h = wid >> 1, qt = wid & 1;
    unsigned char* ws = p->ws;
    const h16* qa = (const h16*)(ws + WS_QA); const h16* Ka = (const h16*)(ws + WS_KA); const h16* VaT = (const h16*)(ws + WS_VAT);
    h16* mix = (h16*)(ws + WS_MIX);
    const int qrow = isctx ? (NLAT + b * CTX + gr * 64 + qt * 32 + q32) : (b * SEQ + gr * 64 + qt * 32 + q32);
    h16x8 qf[4];
#pragma unroll
    for (int ks = 0; ks < 4; ++ks) qf[ks] = *(const h16x8*)(qa + (size_t)qrow * 256 + h * 64 + ks * 16 + hi * 8);
    const int nloc = isctx ? 0 : 8, ntile = nloc + 4;
    int kr0 = gr - 4; kr0 = kr0 < 0 ? 0 : (kr0 > 120 ? 120 : kr0);
    LAS float* bias = (LAS float*)(lds + NA_BIAS);
    __syncthreads();
    if (!isctx) { const float* rp = p->in[I_RPB] + (size_t)l * 4 * 15 * 31; for (int i = tid; i < 4 * 15 * 31; i += NTHREADS) bias[i] = rp[i] * LOG2E; }
    const int koff = NA_K + pi32(q32) * 528 + h * 128 + hi * 16;
    const int voff = NA_V + (h * 64 + q32) * 144 + hi * 16;
    const int cq = qt * 32 + q32; int cs = cq - 8; cs = cs < 0 ? 0 : (cs > 48 ? 48 : cs);
    float m = 0.f, ls = 0.f; f32x16 o0 = {}, o1 = {};
    u32x4 kpre[4], vpre[4];
#define NA_LOAD(t_) do { const int key0_ = ((t_) < nloc) ? (kr0 + (t_)) * 64 : SEQ + ((t_) - nloc) * 64; \
        _Pragma("unroll") for (int i = 0; i < 4; ++i) { const int id = tid + 512 * i; \
            kpre[i] = *(const u32x4*)(Ka + ((size_t)(b * KEYS + key0_ + (id >> 5))) * 256 + (id & 31) * 8); \
            vpre[i] = *(const u32x4*)(VaT + ((size_t)(b * 256 + (id >> 3))) * KEYS + key0_ + (id & 7) * 8); } } while (0)
    NA_LOAD(0);
    for (int t = 0; t < ntile; ++t) {
        __syncthreads();
#pragma unroll
        for (int i = 0; i < 4; ++i) { const int id = tid + 512 * i;
            *(LAS u32x4*)(lds + NA_K + (id >> 5) * 528 + (id & 31) * 16) = kpre[i];
            *(LAS u32x4*)(lds + NA_V + (id >> 3) * 144 + (id & 7) * 16) = vpre[i]; }
        __syncthreads();
        if (t + 1 < ntile) NA_LOAD(t + 1);
#pragma unroll
        for (int th = 0; th < 2; ++th) {
            f32x16 s = {};
#pragma unroll
            for (int ks = 0; ks < 4; ++ks) { const h16x8 kf = *(const LAS h16x8*)(lds + koff + th * 32 * 528 + ks * 32); s = __builtin_amdgcn_mfma_f32_32x32x16_f16(kf, qf[ks], s, 0, 0, 0); }
            if (t < nloc) {
                const int dr = kr0 + t - gr;
                const LAS float* brow = bias + (h * 15 + dr + 7) * 31 + 15 - cq;
#pragma unroll
                for (int r = 0; r < 16; ++r) { const int kc = 32 * th + 16 * (r >> 3) + 8 * hi + (r & 7);
                    const bool ok = (kc >= cs) && (kc < cs + 16); const int kcc = ok ? kc : cq; s[r] = ok ? s[r] + brow[kcc] : -INFINITY; }
            }
            h16x8 pa, pb;
            SOFTMAX_TILE(s, m, ls, o0, o1, pa, pb);
            const h16x8 v00 = *(const LAS h16x8*)(lds + voff + th * 64), v10 = *(const LAS h16x8*)(lds + voff + 32 * 144 + th * 64);
            const h16x8 v01 = *(const LAS h16x8*)(lds + voff + th * 64 + 32), v11 = *(const LAS h16x8*)(lds + voff + 32 * 144 + th * 64 + 32);
            o0 = __builtin_amdgcn_mfma_f32_32x32x16_f16(v00, pa, o0, 0, 0, 0); o1 = __builtin_amdgcn_mfma_f32_32x32x16_f16(v10, pa, o1, 0, 0, 0);
            o0 = __builtin_amdgcn_mfma_f32_32x32x16_f16(v01, pb, o0, 0, 0, 0); o1 = __builtin_amdgcn_mfma_f32_32x32x16_f16(v11, pb, o1, 0, 0, 0);
        }
    }
    const float rl = 1.f / xhalf_sum(ls);
    h16* dst = mix + (size_t)qrow * D + h * 64;
#pragma unroll
    for (int r4 = 0; r4 < 4; ++r4) {
        const int e0 = 8 * r4 + 4 * hi; u32x2 w0, w1;
        w0.x = pkh(o0[4 * r4] * rl, o0[4 * r4 + 1] * rl); w0.y = pkh(o0[4 * r4 + 2] * rl, o0[4 * r4 + 3] * rl);
        w1.x = pkh(o1[4 * r4] * rl, o1[4 * r4 + 1] * rl); w1.y = pkh(o1[4 * r4 + 2] * rl, o1[4 * r4 + 3] * rl);
        *(u32x2*)(dst + e0) = w0; *(u32x2*)(dst + 32 + e0) = w1;
    }
}

constexpr int RG_X32 = 0, RG_X16 = 16384, RG_W = 25600, RG_AB = 62464, RG_SEG = 128000;
__device__ __forceinline__ void rg_load_x(h16x8 (&xv)[4], const h16* xr, int q, int tid, bool valid) {
    const int RT = q >> 3, nb = q & 7;
    const int r = tid >> 3, ch = nb * 64 + (tid & 7) * 8;
    const bool isctx = RT >= 256; const int j = isctx ? ((RT - 256) & 3) : (RT & 127); const int seqlen = isctx ? CTX : SEQ;
#pragma unroll
    for (int tap = 0; tap < 4; ++tap) {
        const int t = j * 64 + r + tap - 2;
        if (valid && t >= 0 && t < seqlen) xv[tap] = *(const h16x8*)(xr + (size_t)(RT * 64 + r + tap - 2) * 512 + ch);
        else xv[tap] = (h16x8){0, 0, 0, 0, 0, 0, 0, 0};
    }
}
__device__ __forceinline__ void rg_gate_block(KP p, int l, int q0, int qstride, int qend, LAS unsigned char* lds, const int mode) {
    const int tid = tid_now(), lane = tid & 63, wid = __builtin_amdgcn_readfirstlane(tid >> 6), q32 = lane & 31, hi = lane >> 5;
    unsigned char* ws = p->ws;
    const h16* xr = (const h16*)(ws + WS_XR);
    float* agg = (float*)(ws + WS_AGG);
    const h16* gg = (const h16*)(ws + WS_GG); h16* mix = (h16*)(ws + WS_MIX);
    LAS float* x32 = (LAS float*)(lds + RG_X32); LAS h16* x16 = (LAS h16*)(lds + RG_X16); LAS h16* Wl = (LAS h16*)(lds + RG_W); LAS float* ab = (LAS float*)(lds + RG_AB); LAS float* seg = (LAS float*)(lds + RG_SEG);
    LAS float* carryL = (LAS float*)(lds + RG_SEG + 4096);
    if (q0 >= qend) return;
    const int nb0 = q0 & 7;
    const bool skip_ctx_out = (l == DEPTH - 1);
    h16x8 xv[4];
    rg_load_x(xv, xr, q0, tid, true);
    if (mode == 1 && tid < 256) {
        const int dir = tid >> 7, b = (tid >> 6) & 1, chl = tid & 63;
        const float* ag = agg + ((((size_t)dir * 2 + b) * 132) * 512 + nb0 * 64 + chl) * 2;
        float h = 0.f;
#pragma unroll 1
        for (int c0 = 0; c0 < 132; c0 += 33) {
            f32x2 v[33];
#pragma unroll
            for (int i = 0; i < 33; ++i) v[i] = *(const f32x2*)(ag + (size_t)(c0 + i) * 1024);
#pragma unroll
            for (int i = 0; i < 33; ++i) {
                const int c = c0 + i;
                int RT; if (dir == 0) RT = (c < 4) ? 256 + 4 * b + c : 128 * b + (c - 4); else RT = (c < 4) ? 256 + 4 * b + (3 - c) : 128 * b + 127 - (c - 4);
                const int dq = RT * 8 + nb0 - q0;
                if (dq >= 0 && (dq % qstride) == 0 && dq / qstride < 12) carryL[((dq / qstride) * 2 + dir) * 64 + chl] = h;
                h = v[i].x * h + v[i].y;
            }
        }
    }
    int cur_nb = -1;
    float cwr[4][8], cbr[8]; float g_br, g_bi, g_sp;
#define RG_LOAD_CONSTS(nb_) do { \
        const int ch_ = (nb_) * 64 + (tid & 7) * 8; const float* cw_ = p->in[I_CONVW] + (size_t)l * 4 * 512 + ch_; const float* cb_ = p->in[I_CONVB] + l * 512 + ch_; \
        _Pragma("unroll") for (int e = 0; e < 8; ++e) { cbr[e] = cb_[e]; _Pragma("unroll") for (int tap = 0; tap < 4; ++tap) cwr[tap][e] = cw_[tap * 512 + e]; } \
        const int dir_ = wid >> 2, chg_ = (nb_) * 64 + ((wid >> 1) & 1) * 32 + q32; \
        g_br = p->in[I_RGBR][(l * 2 + dir_) * 512 + chg_]; g_bi = p->in[I_RGBI][(l * 2 + dir_) * 512 + chg_]; \
        const float lamv_ = p->in[I_RGLAM][(l * 2 + dir_) * 512 + chg_]; g_sp = (lamv_ > 15.f) ? __expf(-lamv_) : log1pf(__expf(-lamv_)); } while (0)
    RG_LOAD_CONSTS(nb0);
    int const_nb = nb0;
    __syncthreads();
    int kt = 0;
    for (int q = q0; q < qend; q += qstride, ++kt) {
        const int RT = q >> 3, nb = q & 7;
        const int row0 = RT * 64;
        const bool isctx = RT >= 256; int b, j;
        if (isctx) { const int qq = RT - 256; b = qq >> 2; j = qq & 3; } else { b = RT >> 7; j = RT & 127; }
        h16x8 ggv;
        {
            const int r = tid >> 3, c8 = (tid & 7) * 8, ch = nb * 64 + c8;
            if (mode == 1) ggv = *(const h16x8*)(gg + (size_t)(row0 + r) * 512 + ch);
            if (nb != const_nb) { RG_LOAD_CONSTS(nb); const_nb = nb; }
            float accv[8];
#pragma unroll
            for (int e = 0; e < 8; ++e) accv[e] = cbr[e];
#pragma unroll
            for (int tap = 0; tap < 4; ++tap)
#pragma unroll
                for (int e = 0; e < 8; ++e) accv[e] += (float)xv[tap][e] * cwr[tap][e];
            *(LAS f32x4*)(x32 + r * 64 + c8) = (f32x4){accv[0], accv[1], accv[2], accv[3]}; *(LAS f32x4*)(x32 + r * 64 + c8 + 4) = (f32x4){accv[4], accv[5], accv[6], accv[7]};
            { u32x4 w; w.x = pkh(accv[0], accv[1]); w.y = pkh(accv[2], accv[3]); w.z = pkh(accv[4], accv[5]); w.w = pkh(accv[6], accv[7]); *(LAS u32x4*)(x16 + r * 72 + c8) = w; }
            if (nb != cur_nb) {
                const h16* wsrc = (const h16*)(ws + WS_RGW);
#pragma unroll
                for (int i = 0; i < 4; ++i) { const int id = tid + 512 * i; const int n = id >> 3, kc = id & 7; const int dg = n >> 6, nn = n & 63;
                    *(LAS u32x4*)(Wl + n * 72 + kc * 8) = *(const u32x4*)(wsrc + (((size_t)(l * 4 + dg) * 8 + nb) * 64 + nn) * 64 + kc * 8); }
                cur_nb = nb;
            }
        }
        lds_barrier();
        rg_load_x(xv, xr, q + qstride, tid, q + qstride < qend);
        {
            const int mt = wid & 1, g = wid >> 1, dir = g >> 1, ch2 = g & 1;
            f32x16 cr = {}, ci = {};
#pragma unroll
            for (int ks = 0; ks < 4; ++ks) {
                const h16x8 af = *(const LAS h16x8*)(x16 + (mt * 32 + q32) * 72 + ks * 16 + hi * 8);
                const h16x8 br = *(const LAS h16x8*)(Wl + (dir * 128 + ch2 * 32 + q32) * 72 + ks * 16 + hi * 8);
                const h16x8 bi = *(const LAS h16x8*)(Wl + (dir * 128 + 64 + ch2 * 32 + q32) * 72 + ks * 16 + hi * 8);
                cr = __builtin_amdgcn_mfma_f32_32x32x16_f16(af, br, cr, 0, 0, 0);
                ci = __builtin_amdgcn_mfma_f32_32x32x16_f16(af, bi, ci, 0, 0, 0);
            }
            const int chl = ch2 * 32 + q32;
            const float b_r = g_br, b_i = g_bi, sp = g_sp;
#pragma unroll
            for (int r = 0; r < 16; ++r) {
                const int tr = mt * 32 + crow(r, hi);
                const float rg = sigmoidf_(cr[r] + b_r), ig = sigmoidf_(ci[r] + b_i);
                const float la = -8.f * rg * sp;
                const float a = fexp_(la);
                const float x2 = 2.f * la;
                float om;
                if (x2 > -0.3f) om = -x2 * (1.f + x2 * (0.5f + x2 * (0.16666667f + x2 * (0.041666668f + x2 * (0.0083333338f + x2 * 0.0013888889f))))); else om = 1.f - fexp_(x2);
                const float bx = __builtin_amdgcn_sqrtf(om) * ig * x32[tr * 64 + chl];
                ab[((dir * 2 + 0) * 64 + tr) * 64 + chl] = a; ab[((dir * 2 + 1) * 64 + tr) * 64 + chl] = bx;
            }
        }
        lds_barrier();
        if (mode == 0) {
            {
                const int sg = tid >> 7, dir = (tid >> 6) & 1, chl = tid & 63; float A = 1.f, H = 0.f;
                const LAS float* pa = ab + (dir * 2 + 0) * 4096 + sg * 16 * 64 + chl; const LAS float* pb = ab + (dir * 2 + 1) * 4096 + sg * 16 * 64 + chl;
                if (dir == 0) {
#pragma unroll
                    for (int r = 0; r < 16; ++r) { const float a = pa[r * 64]; H = a * H + pb[r * 64]; A *= a; }
                } else {
#pragma unroll
                    for (int r = 15; r >= 0; --r) { const float a = pa[r * 64]; H = a * H + pb[r * 64]; A *= a; }
                }
                seg[((dir * 4 + sg) * 64 + chl) * 2] = A; seg[((dir * 4 + sg) * 64 + chl) * 2 + 1] = H;
            }
            lds_barrier();
            if (tid < 128) {
                const int dir = tid >> 6, chl = tid & 63; float A = 1.f, H = 0.f;
#pragma unroll
                for (int i = 0; i < 4; ++i) { const int sg = dir ? 3 - i : i; const float a = seg[((dir * 4 + sg) * 64 + chl) * 2], hh = seg[((dir * 4 + sg) * 64 + chl) * 2 + 1]; H = a * H + hh; A *= a; }
                int c;
                if (dir == 0) c = isctx ? j : 4 + j; else c = isctx ? 3 - j : 4 + 127 - j;
                float* dst = agg + ((((size_t)dir * 2 + b) * 132 + c) * 512 + nb * 64 + chl) * 2;
                dst[0] = A; dst[1] = H;
            }
        } else {
            if (tid < 128) {
                const int dir = tid >> 6, chl = tid & 63;
                float h = carryL[(kt * 2 + dir) * 64 + chl];
                LAS float* pa = ab + (dir * 2 + 0) * 4096 + chl; LAS float* pb = ab + (dir * 2 + 1) * 4096 + chl;
#pragma unroll 1
                for (int g0 = 0; g0 < 64; g0 += 16) {
                    const int r0 = dir ? 48 - g0 : g0;
                    float av[16], bv[16];
#pragma unroll
                    for (int i = 0; i < 16; ++i) { av[i] = pa[(r0 + i) * 64]; bv[i] = pb[(r0 + i) * 64]; }
                    if (dir == 0) {
#pragma unroll
                        for (int i = 0; i < 16; ++i) { h = av[i] * h + bv[i]; bv[i] = h; }
                    } else {
#pragma unroll
                        for (int i = 15; i >= 0; --i) { h = av[i] * h + bv[i]; bv[i] = h; }
                    }
#pragma unroll
                    for (int i = 0; i < 16; ++i) pb[(r0 + i) * 64] = bv[i];
                }
            }
            lds_barrier();
            if (!(isctx && skip_ctx_out)) {
                const int r = tid >> 3, c8 = (tid & 7) * 8;
                const LAS float* hf = ab + (0 * 2 + 1) * 4096 + r * 64 + c8; const LAS float* hb = ab + (1 * 2 + 1) * 4096 + r * 64 + c8;
                u32x4 w;
                w.x = pkh((hf[0] + hb[0]) * (float)ggv[0], (hf[1] + hb[1]) * (float)ggv[1]); w.y = pkh((hf[2] + hb[2]) * (float)ggv[2], (hf[3] + hb[3]) * (float)ggv[3]);
                w.z = pkh((hf[4] + hb[4]) * (float)ggv[4], (hf[5] + hb[5]) * (float)ggv[5]); w.w = pkh((hf[6] + hb[6]) * (float)ggv[6], (hf[7] + hb[7]) * (float)ggv[7]);
                *(u32x4*)(mix + (size_t)(row0 + r) * D + 256 + nb * 64 + c8) = w;
            }
        }
    }
}

__device__ __forceinline__ void phase_mix(KP p, int l, LAS unsigned char* lds, int G) {
    const bool last = (l == DEPTH - 1);
    const int n_dc = last ? 0 : 8, n_nc = last ? 0 : 8;
    const int U0 = 256, U1 = U0 + n_dc, U2 = U1 + 256, U3 = U2 + n_nc, U4 = U3 + 264 * 8;
    int u = blockIdx.x;
    for (; u < U3; u += G) {
        if (u < U0) { const int bh = u >> 5, qb = u & 31; REP(30) diff_unit(p, l, bh >> 2, bh & 3, (bh >> 2) * SEQ + qb * 256, 0, 132, lds); }
        else if (u < U1) { const int bh = u - U0; diff_unit(p, l, bh >> 2, bh & 3, NLAT + (bh >> 2) * CTX, 128, 4, lds); }
        else if (u < U2) { const int q = u - U1; REP(31) na_unit(p, l, q >> 7, q & 127, false, lds); }
        else { const int q = u - U2; na_unit(p, l, q >> 2, q & 3, true, lds); }
    }
    REP(32) rg_gate_block(p, l, u - U3, G, U4 - U3, lds, 0);
}

__device__ __forceinline__ void phase_scan(KP p, int l, LAS unsigned char* lds, int G) {
    const bool last = (l == DEPTH - 1);
    const int U3 = 256 + (last ? 0 : 8) + 256 + (last ? 0 : 8);
    int u = blockIdx.x; while (u < U3) u += G;
    rg_gate_block(p, l, u - U3, G, 264 * 8, lds, 1);
}

__device__ __forceinline__ void phase_route(KP p, int l, LAS unsigned char* lds, int vcu, int G, bool dummy) {
    const int tid = tid_now(), lane = tid & 63, wave = __builtin_amdgcn_readfirstlane(tid >> 6);
    unsigned char* ws = p->ws;
    const float* xl = (const float*)(ws + WS_XL); h16* xg = (h16*)(ws + (dummy ? WS_YB : WS_XG));
    const float* mod = (const float*)(ws + WS_MOD);
    int* asg = (int*)(ws + (dummy ? 7 * MiB : WS_ASG)); float* ew = (float*)(ws + (dummy ? 7 * MiB + 512 * 1024 : WS_EW));
    unsigned* cnt = (unsigned*)(ws + WS_CTL) + CW_CNT + l * 32 + (dummy ? 512 : 0);
    unsigned* pool = (unsigned*)(ws + WS_CTL) + CW_POOL + l + (dummy ? 8 : 0); unsigned* tmap = (unsigned*)(ws + WS_CTL) + (dummy ? 32768 : CW_TMAP) + l * 32 * 72; unsigned* owner = (unsigned*)(ws + WS_CTL) + (dummy ? 45000 : CW_OWNER) + l * 192;
    const int nrows = (l == DEPTH - 1) ? NLAT : NROW;
    LAS h16* xh = (LAS h16*)lds; LAS h16* xlo = (LAS h16*)(lds + 33024); LAS float* part = (LAS float*)(lds + 66048); LAS float* logit = (LAS float*)(lds + 90624);
    const float* wg = p->in[I_RWG] + (size_t)l * D * 4; const float* we = p->in[I_RWE] + (size_t)l * D * 32;
    const float* g = p->in[I_GFFN] + l * D;
    const int c16 = lane & 15, kq = lane >> 4;
    h16x8 bh[4][3], bl[4][3];
#pragma unroll
    for (int ks = 0; ks < 4; ++ks)
#pragma unroll
        for (int nt = 0; nt < 3; ++nt) {
            const int n = nt * 16 + c16;
#pragma unroll
            for (int j = 0; j < 8; ++j) {
                const int k = wave * 128 + ks * 32 + kq * 8 + j;
                float w = (n < 32) ? we[(size_t)k * 32 + n] : ((n < 36) ? wg[(size_t)k * 4 + (n - 32)] : 0.f);
                w *= 64.f; const h16 hh = (h16)w; bh[ks][nt][j] = hh; bl[ks][nt][j] = (h16)(w - (float)hh);
            }
        }
    LAS int* r_e = (LAS int*)(lds + 93184);
    LAS int* r_rk = r_e + 80;
    LAS float* r_w = (LAS float*)(r_rk + 80);
    LAS int* hist = (LAS int*)(r_w + 160);
    LAS int* baseL = hist + 32;
    LAS int* slotL = baseL + 32;
    h16* hl = (h16*)(ws + WS_HL);
    int* rlist = (int*)((unsigned*)(ws + WS_CTL) + CW_RLIST + l * (MAXTILES * 256));
    if (tid < 32) hist[tid] = 0;
    const int ngroups = nrows / 16;
    int nloc = 0;
    const unsigned* done5 = (const unsigned*)(ws + WS_CTL) + CW_D5 + l * 128;
    const int nskip = (l == DEPTH - 1) ? 0 : ((NROW / 256) * (D / 256) - G);
    const int rG = G - (nskip > 0 ? nskip : 0), ridx = (int)blockIdx.x - (nskip > 0 ? nskip : 0);
    if (ridx < 0) return;
    for (int grp = ridx, kk = 0; grp < ngroups; grp += rG, ++kk) {
        __syncthreads();
        unit_wait(done5 + (grp >> 4), 4u);
#pragma unroll
        for (int rr = 0; rr < 2; ++rr) {
            const int lr = wave * 2 + rr, row = grp * 16 + lr; const int v = (row < NLAT) ? (row >> 13) : 2;
            const float* src = xl + (size_t)row * D; f32x4 x[4]; float ss = 0.f;
#pragma unroll
            for (int j = 0; j < 4; ++j) { x[j] = *(const f32x4*)(src + 4 * lane + 256 * j); ss += x[j][0] * x[j][0] + x[j][1] * x[j][1] + x[j][2] * x[j][2] + x[j][3] * x[j][3]; }
            const float rstd = rsqrtf(wave_sum(ss) * (1.f / D) + EPS);
            const float* sh = mod + ((size_t)l * 3 + v) * 6144 + 3 * 1024; const float* scl = sh + 1024;
            h16* o = hl + (size_t)row * D;
#pragma unroll
            for (int j = 0; j < 4; ++j) { const int c = 4 * lane + 256 * j; const f32x4 gv = *(const f32x4*)(g + c), sv = *(const f32x4*)(scl + c), hv = *(const f32x4*)(sh + c);
                const f32x4 y = x[j] * rstd * gv * (1.f + sv) + hv;
                h16x4 yh, yl;
#pragma unroll
                for (int e = 0; e < 4; ++e) { yh[e] = (h16)y[e]; yl[e] = (h16)(y[e] - (float)yh[e]); }
                *(LAS h16x4*)(xh + lr * 1032 + c) = yh; *(LAS h16x4*)(xlo + lr * 1032 + c) = yl; *(h16x4*)(o + c) = yh; }
        }
        __syncthreads();
        {
            f32x4 acc[3] = {{0.f, 0.f, 0.f, 0.f}, {0.f, 0.f, 0.f, 0.f}, {0.f, 0.f, 0.f, 0.f}};
#pragma unroll
            for (int ks = 0; ks < 4; ++ks) {
                const int ko = c16 * 1032 + wave * 128 + ks * 32 + kq * 8;
                const h16x8 ah = *(const LAS h16x8*)(xh + ko), al = *(const LAS h16x8*)(xlo + ko);
#pragma unroll
                for (int nt = 0; nt < 3; ++nt) {
                    acc[nt] = __builtin_amdgcn_mfma_f32_16x16x32_f16(ah, bh[ks][nt], acc[nt], 0, 0, 0);
                    acc[nt] = __builtin_amdgcn_mfma_f32_16x16x32_f16(ah, bl[ks][nt], acc[nt], 0, 0, 0);
                    acc[nt] = __builtin_amdgcn_mfma_f32_16x16x32_f16(al, bh[ks][nt], acc[nt], 0, 0, 0);
                }
            }
#pragma unroll
            for (int nt = 0; nt < 3; ++nt)
#pragma unroll
                for (int r = 0; r < 4; ++r) part[(wave * 16 + kq * 4 + r) * 48 + nt * 16 + c16] = acc[nt][r];
        }
        __syncthreads();
        for (int i = tid; i < 16 * 36; i += NTHREADS) { const int r = i / 36, o = i % 36; const int n = (o < 4) ? 32 + o : o - 4;
            float sacc = 0.f;
#pragma unroll
            for (int w = 0; w < 8; ++w) sacc += part[(w * 16 + r) * 48 + n];
            logit[i] = sacc * (1.f / 64.f) + ((o < 4) ? p->in[I_RBG][l * 4 + o] : p->in[I_RBE][l * 32 + o - 4]); }
        __syncthreads();
        if (tid < 16) {
            const LAS float* lg = logit + tid * 36;
            int gi = 0; float gm = lg[0];
#pragma unroll
            for (int i = 1; i < 4; ++i) if (lg[i] > gm) { gm = lg[i]; gi = i; }
            float gs = 0.f;
#pragma unroll
            for (int i = 0; i < 4; ++i) gs += __expf(lg[i] - gm);
            const float gtop = 1.f / gs;
            const LAS float* el = lg + 4 + gi * 8;
            int i1 = 0; float m1 = el[0];
#pragma unroll
            for (int i = 1; i < 8; ++i) if (el[i] > m1) { m1 = el[i]; i1 = i; }
            int i2 = -1; float m2 = -INFINITY;
#pragma unroll
            for (int i = 0; i < 8; ++i) if (i != i1 && el[i] > m2) { m2 = el[i]; i2 = i; }
            const float e2 = __expf(m2 - m1); const float inv = 1.f / (1.f + e2);
            const int ea = gi * 8 + i1, eb = gi * 8 + i2;
            const int ra = atomicAdd((int*)(hist + ea), 1), rb = atomicAdd((int*)(hist + eb), 1);
            const int lr = kk * 16 + tid;
            r_e[lr] = ea | (eb << 8); r_rk[lr] = ra | (rb << 16); r_w[lr * 2] = gtop * inv; r_w[lr * 2 + 1] = gtop * e2 * inv;
        }
        nloc = kk * 16 + 16;
    }
    __syncthreads();
    if (tid < 32) {
        const int n = hist[tid]; int base = 0;
        if (n > 0) {
            base = (int)atomicAdd(&cnt[tid], (unsigned)n);
            const int j0 = base >> 8, j1 = (base + n - 1) >> 8;
            if ((base & 255) == 0) { const unsigned t = atomicAdd(pool, 1u); __hip_atomic_store(owner + t, (unsigned)tid, __ATOMIC_RELAXED, __HIP_MEMORY_SCOPE_AGENT); __hip_atomic_store(tmap + tid * 72 + j0, t + 1u, __ATOMIC_RELAXED, __HIP_MEMORY_SCOPE_AGENT); }
            if (j1 != j0) { const unsigned t = atomicAdd(pool, 1u); __hip_atomic_store(owner + t, (unsigned)tid, __ATOMIC_RELAXED, __HIP_MEMORY_SCOPE_AGENT); __hip_atomic_store(tmap + tid * 72 + j1, t + 1u, __ATOMIC_RELAXED, __HIP_MEMORY_SCOPE_AGENT); }
        }
        baseL[tid] = base;
    }
    __syncthreads();
    if (tid < nloc) {
        const int lr = tid, grp = ridx + (lr >> 4) * rG, row = grp * 16 + (lr & 15);
        const int ee = r_e[lr], rk = r_rk[lr]; const int ea = ee & 255, eb = ee >> 8;
        const unsigned pa = (unsigned)(baseL[ea] + (rk & 0xffff)), pb = (unsigned)(baseL[eb] + (rk >> 16));
        unsigned* tma = tmap + ea * 72 + (pa >> 8); unsigned* tmb = tmap + eb * 72 + (pb >> 8);
        unsigned ta = 0u, tb = 0u, spin = 0u;
        while (ta == 0u || tb == 0u) {
            if (ta == 0u) ta = __hip_atomic_load(tma, __ATOMIC_RELAXED, __HIP_MEMORY_SCOPE_AGENT);
            if (tb == 0u) tb = __hip_atomic_load(tmb, __ATOMIC_RELAXED, __HIP_MEMORY_SCOPE_AGENT);
            if (++spin > (1u << 22)) break;
        }
        const int sa_ = (int)((ta - 1u) * 256u + (pa & 255u)), sb_ = (int)((tb - 1u) * 256u + (pb & 255u));
        asg[row * 2] = sa_; asg[row * 2 + 1] = sb_;
        ew[row * 2] = r_w[lr * 2]; ew[row * 2 + 1] = r_w[lr * 2 + 1];
        rlist[sa_] = row; rlist[sb_] = row;
    }
}

__device__ __forceinline__ void moe_table(KP p, int l, volatile LAS int* tab) {
    __syncthreads();
    if (tid_now() == 0) {
        const unsigned* cnt = (const unsigned*)(p->ws + WS_CTL) + CW_CNT + l * 32; int s = 0;
        for (int e = 0; e < NEXP; ++e) { tab[e] = s; s += (int)((__hip_atomic_load(cnt + e, __ATOMIC_RELAXED, __HIP_MEMORY_SCOPE_AGENT) + 255u) >> 8); }
        tab[NEXP] = s;
    }
    __syncthreads();
}

__global__ void __launch_bounds__(NTHREADS, 2) fwd_kernel(Params p_) {
    KP p = (KP)__builtin_amdgcn_kernarg_segment_ptr();
#define RELOAD_P() asm volatile("" : "+s"(p))
    extern __shared__ __attribute__((aligned(16))) unsigned char lds_raw[];
    LAS unsigned char* lds = (LAS unsigned char*)lds_raw;
    volatile LAS unsigned* MISC = (volatile LAS unsigned*)(lds + MISC_OFF);
    volatile LAS int* tab = (volatile LAS int*)(lds + MISC_OFF + 64);
    const int tid = threadIdx.x;
    const int G = gridDim.x; const int bx = blockIdx.x; const int vcu = (G % 8 == 0) ? (bx % 8) * (G / 8) + bx / 8 : bx;
    unsigned char* ws = p->ws;
    for (int u = tid; u < 256; u += NTHREADS) MISC[u] = 0u;
    __syncthreads();
    {
        XcdBarrier b0 = xcd_barrier_post((unsigned*)(ws + WS_CTL) + CW_BAR, MISC);
        cg::this_grid().sync();
        if (tid == 0) { unsigned nloc, nx; xcd_barrier_complete(b0.bar, b0.x, nloc, nx); MISC[0] = nloc; MISC[1] = nx; }
        __syncthreads();
    }
#define GRID_BAR() do { GRID_BAR1(); if (PROBE_REPEAT == 99) GRID_BAR1(); } while (0)
#define GRID_BAR1() do { RELOAD_P(); { unsigned char* w_ = p->ws; XcdBarrier b_; b_.bar = (unsigned*)(w_ + WS_CTL) + CW_BAR; b_.x = xb_xcc_id(); b_.st = MISC; xcd_barrier(b_); } \
    RELOAD_P(); ws = p->ws; } while (0)
#ifdef ONLY_PHASE
#define PH(n) (ONLY_PHASE == (n))
#else
#define PH(n) 1
#endif

    REP(0) if (PH(0)) phase_p0(p, lds, vcu, G);
    GRID_BAR();
#pragma unroll 1
    for (int l = 0; l < DEPTH; ++l) {
        const bool last = (l == DEPTH - 1);
        REP(1) if (PH(1)) phase_norm1(p, l, l == 0 ? 0 : 1, tab, vcu, G, DUMMY(1));
        GRID_BAR();
        REP(2) if (PH(2)) {
            pg8::DenseSched S; S.init(ws + WS_HL, ws + WS_WIN + (size_t)l * INC * D * 2, NROW, INC, D, G, bx);
            EpiInProj E{(h16*)(ws + WS_QA), (h16*)(ws + WS_KA), (h16*)(ws + WS_VAT), (h16*)(ws + WS_XR), (h16*)(ws + WS_GG), (h16*)(ws + WS_QD), (h16*)(ws + WS_KD), (h16*)(ws + WS_VDT), (const f32x2*)(ws + WS_ROPE), (unsigned*)(ws + WS_CTL) + CW_KMAX + l * 16, lds + 131072};
            pg8::gemm_phase<EpiInProj, pg8::DenseSched>(lds, D, S, E);
        }
        GRID_BAR();
        if (PH(3)) phase_mix(p, l, lds, G);
        GRID_BAR();
        REP(4) if (PH(4)) phase_scan(p, l, lds, G);
        GRID_BAR();
        REP(5) if (PH(5)) {
            pg8::DenseSched S; S.init(ws + WS_MIX, ws + WS_WOUT + (size_t)l * D * D * 2, last ? NLAT : NROW, D, D, G, bx, (unsigned*)(ws + WS_CTL) + CW_D5 + l * 128);
            EpiOutProj E{(float*)(ws + WS_XL), (const float*)(ws + WS_MOD) + (size_t)l * 3 * 6144, (float*)(ws + (DUMMY(5) ? WS_XG : WS_XL))};
            pg8::gemm_phase<EpiOutProj, pg8::DenseSched>(lds, D, S, E);
        }
        REP(6) if (PH(6)) phase_route(p, l, lds, vcu, G, DUMMY(6));
        GRID_BAR();
        moe_table(p, l, tab);
        REP(8) if (PH(8)) {
            MoeSched1 S{(const char*)((const unsigned*)(ws + WS_CTL) + CW_RLIST + l * (MAXTILES * 256)), (const char*)(ws + WS_W1 + (size_t)l * NEXP * DEXP * D * 2), (const char*)(ws + WS_W3 + (size_t)l * NEXP * DEXP * D * 2), (const unsigned*)(ws + WS_CTL) + CW_TMAP + l * 32 * 72, tab, tab[NEXP], G, vcu, (unsigned*)(ws + WS_CTL) + CW_D7 + l * 192};
            EpiMoe1 E{(h16*)(ws + WS_ACT)};
            pg8::gemm_phase<EpiMoe1, MoeSched1, true>(lds, D, S, E, (const char*)(ws + WS_HL));
        }
        REP(9) if (PH(9)) {
            MoeSched2 S{(const char*)(ws + WS_ACT), (const char*)(ws + WS_W2 + (size_t)l * NEXP * DEXP * D * 2), (const unsigned*)(ws + WS_CTL) + CW_TMAP + l * 32 * 72, tab, tab[NEXP], G, vcu, (const unsigned*)(ws + WS_CTL) + CW_D7 + l * 192, 0};
            { const int n7 = tab[NEXP] * 4; S.i0 = (n7 > vcu) ? (n7 - vcu + G - 1) / G : 0; }
            EpiMoe2 E{(h16*)(ws + WS_YB)};
            pg8::gemm_phase<EpiMoe2, MoeSched2>(lds, DEXP, S, E);
        }
        GRID_BAR();
    }
    if (PH(10)) phase_norm1(p, DEPTH, 2, tab, vcu, G, false);
}

extern "C" void kernel_launch(void* const* d_in, const int* in_sizes, int n_in, void* d_out, int out_size, void* d_ws, size_t ws_size, hipStream_t stream) {
    static int grid = 0;
    if (grid == 0) {
        if (n_in != 28 || out_size != NLAT * D || ws_size < WS_END) { fprintf(stderr, "kernel_launch: unexpected shapes (n_in %d out %d ws %zu)\n", n_in, out_size, ws_size); grid = -1; return; }
        int dev = 0, cus = 0, per_cu = 0;
        if (hipGetDevice(&dev) != hipSuccess || hipDeviceGetAttribute(&cus, hipDeviceAttributeMultiprocessorCount, dev) != hipSuccess) { grid = -1; return; }
        if (hipFuncSetAttribute((const void*)fwd_kernel, hipFuncAttributeMaxDynamicSharedMemorySize, LDS_BYTES) != hipSuccess) { fprintf(stderr, "kernel_launch: hipFuncSetAttribute failed\n"); grid = -1; return; }
        if (hipOccupancyMaxActiveBlocksPerMultiprocessor(&per_cu, (const void*)fwd_kernel, NTHREADS, LDS_BYTES) != hipSuccess || per_cu < 1) { fprintf(stderr, "kernel_launch: occupancy query says %d blocks per CU\n", per_cu); (void)hipGetLastError(); grid = -1; return; }
        grid = cus;
    }
    if (grid < 0) return;
    (void)hipMemsetAsync((char*)d_ws + WS_CTL, 0, CTL_ZERO_BYTES, stream);
    Params p{};
    for (int i = 0; i < 28; ++i) p.in[i] = (const float*)d_in[i];
    p.out = (float*)d_out; p.ws = (unsigned char*)d_ws;
    void* args[] = {&p};
    hipError_t e = hipLaunchCooperativeKernel((const void*)fwd_kernel, dim3(grid), dim3(NTHREADS), args, LDS_BYTES, stream);
    if (e != hipSuccess) fprintf(stderr, "kernel_launch: cooperative launch failed: %s (grid %d)\n", hipGetErrorString(e), grid);
}
```

```cpp
#include <hip/hip_runtime.h>
#include <hip/hip_cooperative_groups.h>
#include <cstdio>
#include <cstdint>
namespace cg = cooperative_groups;

#define LAS __attribute__((address_space(3)))
typedef _Float16 h16;
typedef h16 h16x8 __attribute__((ext_vector_type(8)));
typedef h16 h16x4 __attribute__((ext_vector_type(4)));
typedef h16 h16x2 __attribute__((ext_vector_type(2)));
typedef float f32x2 __attribute__((ext_vector_type(2)));
typedef float f32x4 __attribute__((ext_vector_type(4)));
typedef float f32x16 __attribute__((ext_vector_type(16)));
typedef unsigned u32x2 __attribute__((ext_vector_type(2)));
typedef unsigned u32x4 __attribute__((ext_vector_type(4)));

#define PROBE_REPEAT -1
#define PROBE_STAMP -1
#define REP(n) for (int rep_ = 0; rep_ < ((PROBE_REPEAT == (n)) ? 2 : 1); ++rep_)
#define DUMMY(n) ((PROBE_REPEAT == (n)) && rep_ == 0)
constexpr int D = 1024, NBATCH = 2, SEQ = 8192, CTX = 256, DEPTH = 4;
constexpr int NLAT = NBATCH * SEQ, NCTX = NBATCH * CTX, NROW = NLAT + NCTX;
constexpr int KEYS = SEQ + CTX;
constexpr int INC = 2560;
constexpr int NEXP = 32, DEXP = 512;
constexpr int NWAVES = 8, NTHREADS = 512;
constexpr float EPS = 1e-6f;
constexpr float LOG2E = 1.4426950408889634f;

constexpr size_t MiB = 1u << 20;
constexpr size_t WS_CTL = 0, CTL_ZERO_BYTES = 1 * MiB;
constexpr int CW_BAR = 4096;
constexpr int CW_CNT = 1024;
constexpr size_t WS_MOD = 1 * MiB;
constexpr size_t WS_LAM = 1 * MiB + 512 * 1024;
constexpr size_t WS_ROPE = 1 * MiB + 768 * 1024;
constexpr int CW_KMAX = 2048;
constexpr size_t WS_AGG = 2 * MiB;
constexpr size_t WS_ASG = 5 * MiB;
constexpr size_t WS_EW = 6 * MiB;
constexpr size_t WS_WIN = 8 * MiB;
constexpr size_t WS_WOUT = 28 * MiB;
constexpr size_t WS_RGW = 36 * MiB;
constexpr size_t WS_W1 = 40 * MiB;
constexpr size_t WS_W3 = 168 * MiB;
constexpr size_t WS_W2 = 296 * MiB;
constexpr size_t WS_XL = 424 * MiB;
constexpr size_t WS_HL = 490 * MiB;
constexpr size_t WS_QA = 523 * MiB;
constexpr size_t WS_KA = 532 * MiB;
constexpr size_t WS_VAT = 541 * MiB;
constexpr size_t WS_QD = 550 * MiB;
constexpr size_t WS_KD = 559 * MiB;
constexpr size_t WS_VDT = 568 * MiB;
constexpr size_t WS_XR = 577 * MiB;
constexpr size_t WS_GG = 594 * MiB;
constexpr size_t WS_RGA = 611 * MiB;
constexpr size_t WS_MIX = 743 * MiB;
constexpr size_t WS_XG = 776 * MiB;
constexpr size_t WS_ACT = 858 * MiB;
constexpr size_t WS_YB = 899 * MiB;
constexpr size_t WS_END = 981 * MiB;
constexpr int CW_POOL = 3000;
constexpr int CW_TMAP = 8192;
constexpr int CW_OWNER = 20480;
constexpr int MAXTILES = 164;
constexpr int CW_D5 = 21504;
constexpr int CW_RLIST = 65536;
constexpr int CW_D7 = 22528;

constexpr int LDS_BYTES = 147456;
constexpr int MISC_OFF = LDS_BYTES - 1024;

struct Params {
    const float* in[28];
    float* out;
    unsigned char* ws;
};
typedef __attribute__((address_space(4))) const Params* KP;
enum { I_X = 0, I_C, I_CTX, I_CCTX, I_WADA, I_BADA, I_GMIX, I_GFFN, I_WIN, I_WOUT, I_RPB, I_CONVW, I_CONVB, I_RGWR, I_RGBR, I_RGWI, I_RGBI, I_RGLAM,
       I_DLAM, I_DSUBG, I_RWG, I_RBG, I_RWE, I_RBE, I_W1, I_W3, I_W2, I_GFINAL };

__device__ __forceinline__ unsigned pkh(float a, float b) { h16x2 v = {(h16)a, (h16)b}; return __builtin_bit_cast(unsigned, v); }
__device__ __forceinline__ float wave_sum(float v) {
#pragma unroll
    for (int o = 1; o < 64; o <<= 1) v += __shfl_xor(v, o);
    return v;
}
__device__ __forceinline__ float xhalf_max(float m) { auto rr = __builtin_amdgcn_permlane32_swap(__float_as_uint(m), __float_as_uint(m), false, false); return fmaxf(__uint_as_float(rr[0]), __uint_as_float(rr[1])); }
__device__ __forceinline__ float xhalf_sum(float m) { auto rr = __builtin_amdgcn_permlane32_swap(__float_as_uint(m), __float_as_uint(m), false, false); return __uint_as_float(rr[0]) + __uint_as_float(rr[1]); }
__device__ __forceinline__ float fexp_(float x) { return __builtin_amdgcn_exp2f(x * LOG2E); }
__device__ __forceinline__ float frcp_(float x) { return __builtin_amdgcn_rcpf(x); }
__device__ __forceinline__ float sigmoidf_(float x) { return frcp_(1.f + fexp_(-x)); }
__device__ __forceinline__ float gelu_tanh(float x) { const float u = 0.7978845608028654f * (x + 0.044715f * x * x * x); return x * frcp_(1.f + fexp_(-2.f * u)); }
__device__ __forceinline__ int crow(int r, int hi) { return (r & 3) + 8 * (r >> 2) + 4 * hi; }
#define LDS_WAIT() asm volatile("s_waitcnt lgkmcnt(0)" ::: "memory")
__device__ __forceinline__ void lds_barrier() { asm volatile("s_waitcnt lgkmcnt(0)\n\ts_barrier" ::: "memory"); }
__device__ __forceinline__ int tid_now() { int t = threadIdx.x; asm volatile("" : "+v"(t)); return t; }

#define XB_TMO      128
#define XB_XCNT(j)  (256  + 64 * (j))
#define XB_XSUB(j)  (1280 + 64 * (j))
#define XB_XGEN(j)  (2304 + 64 * (j))
#define XB_TOP      3328
#define XB_TOPGEN   3392
#define XB_SPIN_CAP (1u << 22)
__device__ __forceinline__ unsigned xb_ld(unsigned* p)              { return __hip_atomic_load(p, __ATOMIC_RELAXED, __HIP_MEMORY_SCOPE_AGENT); }
__device__ __forceinline__ unsigned xb_add(unsigned* p, unsigned v) { return __hip_atomic_fetch_add(p, v, __ATOMIC_RELAXED, __HIP_MEMORY_SCOPE_AGENT); }
__device__ __forceinline__ unsigned xb_xcc_id() { return (unsigned)__builtin_amdgcn_s_getreg((3 << 11) | 20) & 0xFu; }
#define XB_SPIN(cond, bar) do { unsigned _sp = 0; while (cond) { __builtin_amdgcn_s_sleep(1); \
    if ((++_sp & 255u) == 0u) { if (xb_ld(&(bar)[XB_TMO])) break; if (_sp > XB_SPIN_CAP) { atomicAdd(&(bar)[XB_TMO], 1u); break; } } } } while (0)
struct XcdBarrier { unsigned* bar; unsigned x; volatile LAS unsigned* st; };
__device__ __forceinline__ XcdBarrier xcd_barrier_post(unsigned* bar, volatile LAS unsigned* st) {
    XcdBarrier b; b.bar = bar; b.x = xb_xcc_id(); b.st = st;
    if (threadIdx.x == 0) (void)xb_add(&bar[XB_XCNT(b.x)], 1u);
    return b;
}
__device__ __forceinline__ void xcd_barrier_complete(unsigned* bar, unsigned x, unsigned& nloc, unsigned& nx) {
    const unsigned G = gridDim.x * gridDim.y * gridDim.z;
    unsigned sum, cnt, mine, sp = 0u;
    for (;;) {
        sum = 0u; cnt = 0u; mine = 0u;
#pragma unroll 1
        for (unsigned j = 0; j < 16; ++j) { const unsigned c = xb_ld(&bar[XB_XCNT(j)]); sum += c; cnt += (c > 0u) ? 1u : 0u; mine = (j == x) ? c : mine; }
        if (sum == G) break;
        __builtin_amdgcn_s_sleep(1);
        if ((++sp & 255u) == 0u) { if (xb_ld(&bar[XB_TMO])) break; if (sp > XB_SPIN_CAP) { atomicAdd(&bar[XB_TMO], 1u); break; } }
    }
    nloc = mine > 0u ? mine : 1u; nx = cnt > 0u ? cnt : 1u;
}
__device__ __forceinline__ void xcd_barrier(const XcdBarrier& b) {
    asm volatile("s_waitcnt vmcnt(0)" ::: "memory");
    __syncthreads();
    if (threadIdx.x == 0) {
        unsigned* bar = b.bar;
        __builtin_amdgcn_s_waitcnt(0);
        const unsigned nloc = b.st[0], nx = b.st[1];
        const unsigned old = xb_add(&bar[XB_XSUB(b.x)], 1u);
        const unsigned gen = old / nloc;
        if (old + 1u == (gen + 1u) * nloc) {
            __builtin_amdgcn_fence(__ATOMIC_RELEASE, "agent");
            asm volatile("s_waitcnt vmcnt(0)" ::: "memory");
            const unsigned og = xb_add(&bar[XB_TOP], 1u);
            const unsigned tg = og / nx;
            if (og + 1u == (tg + 1u) * nx) xb_add(&bar[XB_TOPGEN], 1u);
            else XB_SPIN(xb_ld(&bar[XB_TOPGEN]) == tg, bar);
            __builtin_amdgcn_fence(__ATOMIC_ACQUIRE, "agent");
            xb_add(&bar[XB_XGEN(b.x)], 1u);
            asm volatile("s_waitcnt vmcnt(0)" ::: "memory");
        } else {
            XB_SPIN(xb_ld(&bar[XB_XGEN(b.x)]) == gen, bar);
            __builtin_amdgcn_fence(__ATOMIC_ACQUIRE, "agent");
            asm volatile("s_waitcnt vmcnt(0)" ::: "memory");
        }
    }
    __syncthreads();
}

__device__ __forceinline__ void unit_publish(unsigned* ctr) {
    asm volatile("s_waitcnt vmcnt(0)" ::: "memory");
    __builtin_amdgcn_s_barrier();
    if (threadIdx.x == 0) { __builtin_amdgcn_fence(__ATOMIC_RELEASE, "agent"); asm volatile("s_waitcnt vmcnt(0)" ::: "memory"); __hip_atomic_fetch_add(ctr, 1u, __ATOMIC_RELAXED, __HIP_MEMORY_SCOPE_AGENT); }
}
__device__ __forceinline__ void unit_wait(const unsigned* ctr, unsigned need) {
    if (threadIdx.x < 64) {
        unsigned spins = 0;
        while ((unsigned)__builtin_amdgcn_readfirstlane(__hip_atomic_load(ctr, __ATOMIC_RELAXED, __HIP_MEMORY_SCOPE_AGENT)) < need) { __builtin_amdgcn_s_sleep(2); if (++spins > (1u << 24)) break; }
        __builtin_amdgcn_fence(__ATOMIC_ACQUIRE, "agent");
        asm volatile("s_waitcnt vmcnt(0)" ::: "memory");
    }
    asm volatile("" ::: "memory"); __builtin_amdgcn_s_barrier(); asm volatile("" ::: "memory");
}

namespace pg8 {
constexpr int BM = 256, BK = 64, HALF = 128, HTB = HALF * BK * 2, STAGE_BYTES = 8 * HTB, NXCD = 8, WGM = 8;
__device__ __forceinline__ int lds_byte(int r, int c) { const int st = (r >> 4) * 2 + (c >> 5), rr = r & 15, cc = c & 31, ob = rr * 64 + cc * 2; return st * 1024 + (ob ^ (((ob >> 9) & 1) << 5)); }
__device__ __forceinline__ void stage_rc(int b, int& R, int& C) { const int st = b / 1024, sb = b % 1024, swz = sb ^ (((sb >> 9) & 1) << 5); R = (st >> 1) * 16 + swz / 64; C = (st & 1) * 32 + (swz % 64) / 2; }
__device__ __forceinline__ int perm32(int rho) { const int n = rho >> 4, i = rho & 15; return 8 * (i >> 2) + 4 * n + (i & 3); }

struct Unit { const char* A0; const char* A1; const char* B0; const char* B1; int pm, pn; };

struct DenseSched {
    const char* A; const char* Bt; int K, nM, nN, nwg, G, c; unsigned* done_ctr;
    __device__ __forceinline__ void init(const void* A_, const void* Bt_, int M, int N, int K_, int G_, int c_, unsigned* done_ = nullptr) { A = (const char*)A_; Bt = (const char*)Bt_; K = K_; nM = M / BM; nN = N / BM; nwg = nM * nN; G = G_; c = c_; done_ctr = done_; }
    __device__ __forceinline__ void a_ready(const Unit&) const {}
    __device__ __forceinline__ void done(const Unit& u) const { if (done_ctr) unit_publish(done_ctr + u.pm); }
    __device__ __forceinline__ bool next(int i, Unit& u) const {
        const long L = (long)i * G + c; if (L >= nwg) return false;
        int wgid = (int)L; { const int q = nwg / NXCD, r = nwg % NXCD, xcd = wgid % NXCD, off = wgid / NXCD; wgid = (xcd < r ? xcd * (q + 1) : r * (q + 1) + (xcd - r) * q) + off; }
        const int nig = WGM * nN, gid = wgid / nig, fm = gid * WGM, gsz = (nM - fm) < WGM ? (nM - fm) : WGM;
        u.pm = fm + ((wgid % nig) % gsz); u.pn = (wgid % nig) / gsz;
        const size_t hstep = (size_t)HALF * K * 2;
        u.A0 = A + (size_t)u.pm * 2 * hstep; u.A1 = u.A0 + hstep; u.B0 = Bt + (size_t)u.pn * 2 * hstep; u.B1 = u.B0 + hstep;
        return true;
    }
};

template <class Epi, class Sched, bool GATHER = false>
__device__ __forceinline__ void gemm_phase(LAS unsigned char* lds, const int K, const Sched& S, const Epi& E, const char* gbase = nullptr, const int pitch_ = 0) {
    const int pitch = pitch_ ? pitch_ : K;
    const int tid = tid_now(), wid = __builtin_amdgcn_readfirstlane(tid >> 6), lane = tid & 63, wr = wid >> 2, wc = wid & 3, fr = lane & 15, fq = lane >> 4;
    const int nt = K / BK;
    unsigned voffA[2], voffB[2];
#pragma unroll
    for (int i = 0; i < 2; ++i) { int R, C; stage_rc(tid * 16 + i * 8192, R, C); const int Rb = (R & ~31) + perm32(R & 31);
        voffA[i] = (unsigned)(R * pitch + C) * 2u; voffB[i] = (unsigned)(Rb * pitch + C) * 2u; }
    const size_t kstep = (size_t)(BK * 2);
    const unsigned ldsw = (unsigned)wid * 1024u;
    unsigned cv0[2] = {0u, 0u}, cv1[2] = {0u, 0u}, nv0[2] = {0u, 0u}, nv1[2] = {0u, 0u};
#define PG8_GOFF(v0_, v1_, listp) do { const int* rl_ = (const int*)(listp); _Pragma("unroll") for (int i_ = 0; i_ < 2; ++i_) { int R_, C_; stage_rc(tid * 16 + i_ * 8192, R_, C_); \
        v0_[i_] = (unsigned)rl_[R_] * (unsigned)(K * 2) + (unsigned)(C_ * 2); v1_[i_] = (unsigned)rl_[128 + R_] * (unsigned)(K * 2) + (unsigned)(C_ * 2); } } while (0)
#define PG8_STAGE2(bufoff, gb, va, vb, sel) do { _Pragma("unroll") for (int _i = 0; _i < 2; ++_i) \
        __builtin_amdgcn_global_load_lds((const unsigned*)((const char*)(gb) + ((sel) ? (vb)[_i] : (va)[_i])), (LAS unsigned*)(lds + (bufoff) + ldsw + _i * 8192), 16, 0, 0); } while (0)
    const int aoff = lds_byte(wr * 64 + fr, fq * 8), boff = lds_byte(wc * 32 + fr, fq * 8);
#define PG8_SA(b, h) (((b) * 2 + (h)) * HTB)
#define PG8_SB(b, h) ((4 + (b) * 2 + (h)) * HTB)
#define PG8_STAGE(bufoff, gbase, voff) do { _Pragma("unroll") for (int _i = 0; _i < 2; ++_i) \
        __builtin_amdgcn_global_load_lds((const unsigned*)((const char*)(gbase) + (voff)[_i]), (LAS unsigned*)(lds + (bufoff) + ldsw + _i * 8192), 16, 0, 0); } while (0)
#define PG8_LDA(dst, b, h) do { _Pragma("unroll") for (int m = 0; m < 4; ++m) _Pragma("unroll") for (int k = 0; k < 2; ++k) dst[m][k] = *(const LAS h16x8*)(lds + PG8_SA(b, h) + aoff + m * 2048 + k * 1024); } while (0)
#define PG8_LDB(dst, b, h) do { _Pragma("unroll") for (int n = 0; n < 2; ++n) _Pragma("unroll") for (int k = 0; k < 2; ++k) dst[n][k] = *(const LAS h16x8*)(lds + PG8_SB(b, h) + boff + n * 2048 + k * 1024); } while (0)
#define PG8_MMA(ai, bj, At, Bt) do { __builtin_amdgcn_s_setprio(1); _Pragma("unroll") for (int m = 0; m < 4; ++m) _Pragma("unroll") for (int n = 0; n < 2; ++n) _Pragma("unroll") for (int k = 0; k < 2; ++k) \
        acc[ai][bj][m][n] = __builtin_amdgcn_mfma_f32_16x16x32_f16(Bt[n][k], At[m][k], acc[ai][bj][m][n], 0, 0, 0); __builtin_amdgcn_s_setprio(0); } while (0)
#define PG8_WAIT_V(n) asm volatile("s_waitcnt vmcnt(" #n ")" ::: "memory")
#define PG8_WAIT_L(n) asm volatile("s_waitcnt lgkmcnt(" #n ")" ::: "memory")
#define PG8_BAR __builtin_amdgcn_s_barrier()
#define PG8_SCHED __builtin_amdgcn_sched_barrier(0)
    Unit cur, nxt; int ui = 0;
    if (!S.next(0, cur)) return;
    f32x4 acc[2][2][4][2];
#pragma unroll
    for (int a = 0; a < 2; ++a)
#pragma unroll
        for (int b = 0; b < 2; ++b)
#pragma unroll
            for (int m = 0; m < 4; ++m)
#pragma unroll
                for (int n = 0; n < 2; ++n) acc[a][b][m][n] = (f32x4){0.f, 0.f, 0.f, 0.f};
    h16x8 At[4][2], B0[2][2], B1[2][2];
    const char* cA0 = cur.A0; const char* cA1 = cur.A1; const char* cB0 = cur.B0; const char* cB1 = cur.B1;
    S.a_ready(cur);
    if constexpr (GATHER) { PG8_GOFF(cv0, cv1, cur.A0); }
    PG8_STAGE(PG8_SB(0, 0), cB0, voffB); PG8_STAGE(PG8_SB(0, 1), cB1, voffB);
    if constexpr (GATHER) { PG8_STAGE2(PG8_SA(0, 0), gbase, cv0, cv0, false); PG8_STAGE2(PG8_SA(0, 1), gbase, cv1, cv1, false); }
    else { PG8_STAGE(PG8_SA(0, 0), cA0, voffA); PG8_STAGE(PG8_SA(0, 1), cA1, voffA); }
    if (wr == 1) PG8_BAR;
    PG8_WAIT_V(2); PG8_BAR;
    PG8_STAGE(PG8_SB(1, 0), cB0 + kstep, voffB);
    if constexpr (GATHER) { PG8_STAGE2(PG8_SA(1, 0), gbase + kstep, cv0, cv0, false); } else { PG8_STAGE(PG8_SA(1, 0), cA0 + kstep, voffA); }
    PG8_STAGE(PG8_SB(1, 1), cB1 + kstep, voffB);
    PG8_WAIT_V(6); PG8_BAR;
    for (;;) {
        const bool has_next = S.next(ui + 1, nxt);
        const char* nA0 = has_next ? nxt.A0 : cA0; const char* nA1 = has_next ? nxt.A1 : cA1;
        const char* nB0 = has_next ? nxt.B0 : cB0; const char* nB1 = has_next ? nxt.B1 : cB1;
        for (int t = 0; t < nt; t += 2) {
            const bool last = (t == nt - 2);
            if (last && has_next) S.a_ready(nxt);
            if constexpr (GATHER) { if (last) { if (has_next) { PG8_GOFF(nv0, nv1, nxt.A0); } else { nv0[0] = cv0[0]; nv0[1] = cv0[1]; nv1[0] = cv1[0]; nv1[1] = cv1[1]; } } }
            const char* g1 = gbase + (size_t)(t + 1) * kstep; const char* g2 = gbase + (last ? (size_t)0 : (size_t)(t + 2) * kstep); const char* g3 = g2 + kstep;
            const char* a1_1 = cA1 + (size_t)(t + 1) * kstep;
            const char* a2_0 = last ? nA0 : cA0 + (size_t)(t + 2) * kstep; const char* a2_1 = last ? nA1 : cA1 + (size_t)(t + 2) * kstep;
            const char* b2_0 = last ? nB0 : cB0 + (size_t)(t + 2) * kstep; const char* b2_1 = last ? nB1 : cB1 + (size_t)(t + 2) * kstep;
            const char* a3_0 = a2_0 + kstep; const char* b3_0 = b2_0 + kstep; const char* b3_1 = b2_1 + kstep;
            PG8_LDB(B0, 0, 0); PG8_LDB(B1, 0, 1); PG8_SCHED; PG8_LDA(At, 0, 0); if constexpr (GATHER) { PG8_STAGE2(PG8_SA(1, 1), g1, cv1, cv1, false); } else { PG8_STAGE(PG8_SA(1, 1), a1_1, voffA); }
            PG8_WAIT_V(8); PG8_WAIT_L(0); PG8_BAR; PG8_MMA(0, 0, At, B0); PG8_MMA(0, 1, At, B1); PG8_BAR; PG8_SCHED;
            PG8_LDA(At, 0, 1); PG8_STAGE(PG8_SB(0, 0), b2_0, voffB); PG8_STAGE(PG8_SB(0, 1), b2_1, voffB); if constexpr (GATHER) { PG8_STAGE2(PG8_SA(0, 0), g2, cv0, nv0, last); } else { PG8_STAGE(PG8_SA(0, 0), a2_0, voffA); }
            PG8_WAIT_V(8); PG8_WAIT_L(0); PG8_BAR; PG8_MMA(1, 0, At, B0); PG8_MMA(1, 1, At, B1); PG8_BAR; PG8_SCHED;
            PG8_LDB(B0, 1, 0); PG8_LDB(B1, 1, 1); PG8_SCHED; PG8_LDA(At, 1, 0); if constexpr (GATHER) { PG8_STAGE2(PG8_SA(0, 1), g2, cv1, nv1, last); } else { PG8_STAGE(PG8_SA(0, 1), a2_1, voffA); }
            PG8_WAIT_V(8); PG8_WAIT_L(0); PG8_BAR; PG8_MMA(0, 0, At, B0); PG8_MMA(0, 1, At, B1); PG8_BAR; PG8_SCHED;
            PG8_LDA(At, 1, 1); PG8_STAGE(PG8_SB(1, 0), b3_0, voffB); PG8_STAGE(PG8_SB(1, 1), b3_1, voffB); if constexpr (GATHER) { PG8_STAGE2(PG8_SA(1, 0), g3, cv0, nv0, last); } else { PG8_STAGE(PG8_SA(1, 0), a3_0, voffA); }
            PG8_WAIT_V(8); PG8_WAIT_L(0); PG8_BAR; PG8_MMA(1, 0, At, B0); PG8_MMA(1, 1, At, B1); PG8_BAR; PG8_SCHED;
        }
        if (wr == 0) PG8_BAR;
        E(acc, cur, wr, wc, fr, fq);
        S.done(cur);
        if (!has_next) break;
#pragma unroll
        for (int a = 0; a < 2; ++a)
#pragma unroll
            for (int b = 0; b < 2; ++b)
#pragma unroll
                for (int m = 0; m < 4; ++m)
#pragma unroll
                    for (int n = 0; n < 2; ++n) acc[a][b][m][n] = (f32x4){0.f, 0.f, 0.f, 0.f};
        cur = nxt; cA0 = nA0; cA1 = nA1; cB0 = nB0; cB1 = nB1; ++ui;
        if constexpr (GATHER) { cv0[0] = nv0[0]; cv0[1] = nv0[1]; cv1[0] = nv1[0]; cv1[1] = nv1[1]; }
        if (wr == 1) PG8_BAR;
    }
    PG8_WAIT_V(0);
    PG8_BAR;
#undef PG8_SA
#undef PG8_SB
#undef PG8_STAGE
#undef PG8_STAGE2
#undef PG8_GOFF
#undef PG8_LDA
#undef PG8_LDB
#undef PG8_MMA
#undef PG8_WAIT_V
#undef PG8_WAIT_L
#undef PG8_BAR
#undef PG8_SCHED
}
}
using pg8::Unit;
typedef f32x4 AccT[2][2][4][2];

struct EpiInProj {
    h16 *qa, *ka, *vat, *xr, *gg, *qd, *kd, *vdt; const f32x2* rope; unsigned* kmax; LAS unsigned char* scr;
    __device__ __forceinline__ void operator()(const AccT& acc, const Unit& u, int wr, int wc, int fr, int fq) const {
        const int pn = u.pn;
        const bool isctx = (u.pm >= NLAT / 256);
        const float QSA = 0.125f * LOG2E, QSD = 0.17677669529663687f * LOG2E;
        float kn2[2] = {0.f, 0.f};
        if (pn == 2 || pn == 9) {
            h16* const vbase = (pn == 2 ? vat : vdt);
            LAS unsigned char* const sw = scr + (wr * 4 + wc) * 1536;
            const int lane = fq * 16 + fr;
#pragma unroll
            for (int ai = 0; ai < 2; ++ai)
#pragma unroll
                for (int m = 0; m < 4; ++m) {
                    const int row0 = u.pm * 256 + ai * 128 + wr * 64 + m * 16;
                    int b, key0;
                    if (isctx) { const int c = row0 - NLAT; b = c >> 8; key0 = SEQ + (c & 255); } else { b = row0 >> 13; key0 = row0 & (SEQ - 1); }
#pragma unroll
                    for (int bj = 0; bj < 2; ++bj) {
#pragma unroll
                        for (int j = 0; j < 8; ++j) *(LAS h16*)(sw + (fq * 8 + j) * 48 + fr * 2) = (h16)acc[ai][bj][m][j >> 2][j & 3];
                        asm volatile("s_waitcnt lgkmcnt(0)" ::: "memory");
                        const u32x4 w = *(const LAS u32x4*)(sw + (lane >> 1) * 48 + (lane & 1) * 16);
                        asm volatile("s_waitcnt lgkmcnt(0)" ::: "memory");
                        *(u32x4*)(vbase + ((size_t)(b * 256 + bj * 128 + wc * 32 + (lane >> 1))) * KEYS + key0 + (lane & 1) * 8) = w;
                    }
                }
            return;
        }
#pragma unroll
        for (int ai = 0; ai < 2; ++ai)
#pragma unroll
            for (int m = 0; m < 4; ++m) {
                const int row = u.pm * 256 + ai * 128 + wr * 64 + m * 16 + fr;
                int b, key, t;
                if (isctx) { const int c = row - NLAT; b = c >> 8; t = c & 255; key = SEQ + t; } else { b = row >> 13; t = row & (SEQ - 1); key = t; }
#pragma unroll
                for (int bj = 0; bj < 2; ++bj) {
                    const int col = bj * 128 + wc * 32 + 8 * fq;
                    float v[8];
#pragma unroll
                    for (int j = 0; j < 4; ++j) { v[j] = acc[ai][bj][m][0][j]; v[4 + j] = acc[ai][bj][m][1][j]; }
                    if (pn == 7 || pn == 8) {
                        float pr[8];
#pragma unroll
                        for (int j = 0; j < 8; ++j) pr[j] = __shfl_xor(v[j], 16);
                        if (!isctx) {
                            const int pos = (fq < 2) ? (t >> 6) : (t & 63);
                            const f32x2* tb = rope + pos * 8;
#pragma unroll
                            for (int j = 0; j < 8; ++j) { const f32x2 cs = tb[j]; const float sn = (fq & 1) ? cs.y : -cs.y; v[j] = v[j] * cs.x + pr[j] * sn; }
                        }
                        if (pn == 8) { float ss = 0.f;
#pragma unroll
                            for (int j = 0; j < 8; ++j) ss += v[j] * v[j];
                            kn2[bj] = fmaxf(kn2[bj], ss); }
                    }
                    {
                        h16* dst; float sc = 1.f;
                        if (pn == 0) { dst = qa + (size_t)row * 256 + col; sc = QSA; }
                        else if (pn == 1) { dst = ka + ((size_t)(b * KEYS + key)) * 256 + col; }
                        else if (pn == 3 || pn == 4) { dst = xr + (size_t)row * 512 + (pn - 3) * 256 + col; }
                        else if (pn == 5 || pn == 6) { dst = gg + (size_t)row * 512 + (pn - 5) * 256 + col;
#pragma unroll
                            for (int j = 0; j < 8; ++j) v[j] = gelu_tanh(v[j]); }
                        else if (pn == 7) { dst = qd + (size_t)row * 256 + col; sc = QSD; }
                        else { dst = kd + ((size_t)(b * KEYS + key)) * 256 + col; }
                        u32x4 w; w.x = pkh(v[0] * sc, v[1] * sc); w.y = pkh(v[2] * sc, v[3] * sc); w.z = pkh(v[4] * sc, v[5] * sc); w.w = pkh(v[6] * sc, v[7] * sc);
                        *(u32x4*)dst = w;
                    }
                }
            }
        if (pn == 8) {
            const int b = isctx ? (u.pm - NLAT / 256) : (u.pm >> 5);
#pragma unroll
            for (int bj = 0; bj < 2; ++bj) {
                float ss = kn2[bj]; ss += __shfl_xor(ss, 16); ss += __shfl_xor(ss, 32);
#pragma unroll
                for (int o = 1; o < 16; o <<= 1) ss = fmaxf(ss, __shfl_xor(ss, o));
                if ((fr | fq) == 0) atomicMax(kmax + (b * 4 + 2 * bj + (wc >> 1)) * 2 + (wc & 1), __float_as_uint(ss));
            }
        }
    }
};

struct EpiOutProj {
    float* xl; const float* mod; float* xo;
    __device__ __forceinline__ void operator()(const AccT& acc, const Unit& u, int wr, int wc, int fr, int fq) const {
        const int vsel = (u.pm >= NLAT / 256) ? 2 : (u.pm >= NLAT / 512 ? 1 : 0);
        const float* ga = mod + vsel * 6144 + 2 * 1024;
#pragma unroll
        for (int bj = 0; bj < 2; ++bj) {
            const int col = u.pn * 256 + bj * 128 + wc * 32 + 8 * fq;
            const f32x4 g0 = *(const f32x4*)(ga + col), g1 = *(const f32x4*)(ga + col + 4);
#pragma unroll
            for (int ai = 0; ai < 2; ++ai)
#pragma unroll
                for (int m = 0; m < 4; ++m) {
                    const int row = u.pm * 256 + ai * 128 + wr * 64 + m * 16 + fr;
                    const float* p = xl + (size_t)row * D + col; float* q = xo + (size_t)row * D + col;
                    f32x4 x0 = *(const f32x4*)p, x1 = *(const f32x4*)(p + 4);
                    x0 += g0 * acc[ai][bj][m][0]; x1 += g1 * acc[ai][bj][m][1];
                    *(f32x4*)q = x0; *(f32x4*)(q + 4) = x1;
                }
        }
    }
};

struct CtxSplitSched {
    const char* mix; const char* wt; int q; unsigned* done_ctr;
    __device__ __forceinline__ void a_ready(const Unit&) const {}
    __device__ __forceinline__ void done(const Unit& u) const { unit_publish(done_ctr + u.pm); }
    __device__ __forceinline__ bool next(int i, Unit& u) const {
        if (i != 0 || q < 0) return false;
        const int pm = NLAT / 256 + (q >> 4), pn = (q >> 2) & 3, kq = q & 3;
        u.pm = pm; u.pn = pn | (kq << 8);
        u.A0 = mix + (size_t)pm * 256 * 2048 + kq * 512; u.A1 = u.A0 + (size_t)128 * 2048;
        u.B0 = wt + (size_t)pn * 256 * 2048 + kq * 512; u.B1 = u.B0 + (size_t)128 * 2048;
        return true;
    }
};
struct EpiOutPart {
    float* part; const float* mod;
    __device__ __forceinline__ void operator()(const AccT& acc, const Unit& u, int wr, int wc, int fr, int fq) const {
        const int pn = u.pn & 255, kq = u.pn >> 8;
        const float* ga = mod + 2 * 6144 + 2 * 1024;
#pragma unroll
        for (int bj = 0; bj < 2; ++bj) {
            const int col = pn * 256 + bj * 128 + wc * 32 + 8 * fq;
            const f32x4 g0 = *(const f32x4*)(ga + col), g1 = *(const f32x4*)(ga + col + 4);
#pragma unroll
            for (int ai = 0; ai < 2; ++ai)
#pragma unroll
                for (int m = 0; m < 4; ++m) {
                    const int crow_ = (u.pm - NLAT / 256) * 256 + ai * 128 + wr * 64 + m * 16 + fr;
                    float* q_ = part + ((size_t)kq * NCTX + crow_) * D + col;
                    *(f32x4*)q_ = g0 * acc[ai][bj][m][0]; *(f32x4*)(q_ + 4) = g1 * acc[ai][bj][m][1];
                }
        }
    }
};

struct MoeSched1 {
    const char* xg; const char* w1t; const char* w3t; const unsigned* tmap; volatile LAS int* tab; int ntiles, G, c; unsigned* done7;
    __device__ __forceinline__ void a_ready(const Unit&) const {}
    __device__ __forceinline__ void done(const Unit& u) const { unit_publish(done7 + u.pm); }
    __device__ __forceinline__ bool next(int i, Unit& u) const {
        const int L = i * G + c; if (L >= ntiles * 4) return false;
        const int Ts = L >> 2, pn = L & 3; int e = 0;
        for (int j = 1; j < NEXP; ++j) e += (tab[j] <= Ts) ? 1 : 0;
        e = __builtin_amdgcn_readfirstlane(e);
        const int T = __builtin_amdgcn_readfirstlane((int)tmap[e * 72 + (Ts - tab[e])] - 1);
        u.pm = T; u.pn = pn;
        u.A0 = xg + (size_t)T * 256 * 4; u.A1 = u.A0;
        const size_t wo = ((size_t)e * DEXP + (size_t)pn * 128) * 2048;
        u.B0 = w1t + wo; u.B1 = w3t + wo;
        return true;
    }
};
struct MoeSched2 {
    const char* act; const char* w2t; const unsigned* tmap; volatile LAS int* tab; int ntiles, G, c; const unsigned* done7; int start, cnt, rest;
    __device__ __forceinline__ void a_ready(const Unit& u) const { unit_wait(done7 + u.pm, 4u); }
    __device__ __forceinline__ void done(const Unit&) const {}
    __device__ __forceinline__ void plan() {
        const int n = ntiles * 4;
        const int base = n / G, r = n - base * G;
        const int T3 = 3 * n;
        int bhi = (T3 / G) - 2 * (base + 1); if (bhi < 0) bhi = 0;
        int blo = (T3 / G) - 2 * base; if (blo < 0) blo = 0;
        long tot = (long)r * bhi + (long)(G - r) * blo;
        if (tot > n) { blo = (int)((n - (long)r * bhi) / (G - r)); if (blo < 0) { blo = 0; bhi = n / (r > 0 ? r : 1); } tot = (long)r * bhi + (long)(G - r) * blo; if (tot > n) { bhi = 0; blo = n / G; tot = (long)G * blo; } }
        start = (c < r) ? c * bhi : r * bhi + (c - r) * blo; cnt = (c < r) ? bhi : blo; rest = (int)tot;
    }
    __device__ __forceinline__ bool next(int i, Unit& u) const {
        int L;
        if (i < cnt) L = start + i; else { L = rest + (i - cnt) * G + c; }
        if (L >= ntiles * 4) return false;
        const int Ts = L >> 2, pn = L & 3; int e = 0;
        for (int j = 1; j < NEXP; ++j) e += (tab[j] <= Ts) ? 1 : 0;
        e = __builtin_amdgcn_readfirstlane(e);
        const int T = __builtin_amdgcn_readfirstlane((int)tmap[e * 72 + (Ts - tab[e])] - 1);
        u.pm = T; u.pn = pn;
        u.A0 = act + (size_t)T * 256 * 1024; u.A1 = u.A0 + (size_t)128 * 1024;
        u.B0 = w2t + ((size_t)e * D + (size_t)pn * 256) * 1024; u.B1 = u.B0 + (size_t)128 * 1024;
        return true;
    }
};
struct EpiMoe1 {
    h16* act;
    __device__ __forceinline__ void operator()(const AccT& acc, const Unit& u, int wr, int wc, int fr, int fq) const {
#pragma unroll
        for (int ai = 0; ai < 2; ++ai)
#pragma unroll
            for (int m = 0; m < 4; ++m) {
                const int row = u.pm * 256 + ai * 128 + wr * 64 + m * 16 + fr;
                float v[8];
#pragma unroll
                for (int n = 0; n < 2; ++n)
#pragma unroll
                    for (int j = 0; j < 4; ++j) { const float a = acc[ai][0][m][n][j], b = acc[ai][1][m][n][j]; v[4 * n + j] = a * frcp_(1.f + fexp_(-a)) * b; }
                u32x4 w; w.x = pkh(v[0], v[1]); w.y = pkh(v[2], v[3]); w.z = pkh(v[4], v[5]); w.w = pkh(v[6], v[7]);
                *(u32x4*)(act + (size_t)row * DEXP + u.pn * 128 + wc * 32 + 8 * fq) = w;
            }
    }
};
struct EpiMoe2 {
    h16* yb;
    __device__ __forceinline__ void operator()(const AccT& acc, const Unit& u, int wr, int wc, int fr, int fq) const {
#pragma unroll
        for (int ai = 0; ai < 2; ++ai)
#pragma unroll
            for (int m = 0; m < 4; ++m) {
                const int row = u.pm * 256 + ai * 128 + wr * 64 + m * 16 + fr;
#pragma unroll
                for (int bj = 0; bj < 2; ++bj) {
                    const f32x4 v0 = acc[ai][bj][m][0], v1 = acc[ai][bj][m][1];
                    u32x4 w; w.x = pkh(v0[0], v0[1]); w.y = pkh(v0[2], v0[3]); w.z = pkh(v1[0], v1[1]); w.w = pkh(v1[2], v1[3]);
                    *(u32x4*)(yb + (size_t)row * D + u.pn * 256 + bj * 128 + wc * 32 + 8 * fq) = w;
                }
            }
    }
};

__device__ __forceinline__ void p0_transpose_item(const float* W, int K, int N, h16* WT, LAS h16* scr, int item, int lane) {
    const int nblk = N / 64, kb = item / nblk, nb = item % nblk, k0 = 64 * kb, n0 = 64 * nb;
    const float* src = W + (size_t)k0 * N + n0 + lane;
#pragma unroll 32
    for (int i = 0; i < 64; ++i) scr[i * 66 + lane] = (h16)src[(size_t)i * N];
    LDS_WAIT(); asm volatile("" ::: "memory");
    const int c = lane & 7;
#pragma unroll
    for (int j = 0; j < 8; ++j) { const int n = (lane >> 3) + 8 * j; const LAS h16* s = scr + (8 * c) * 66 + n;
        h16x8 o;
#pragma unroll
        for (int t = 0; t < 8; ++t) o[t] = s[t * 66];
        *(h16x8*)(WT + (size_t)(n0 + n) * K + k0 + 8 * c) = o; }
    LDS_WAIT(); asm volatile("" ::: "memory");
}

__device__ __forceinline__ void phase_p0(KP p, LAS unsigned char* lds, int vcu, int G) {
    const int tid = tid_now(), lane = tid & 63, wave = __builtin_amdgcn_readfirstlane(tid >> 6);
    unsigned char* ws = p->ws;
    LAS float* sc = (LAS float*)lds;
    LAS float* red = (LAS float*)(lds + 12288);
    for (int i = tid; i < 3 * 1024; i += NTHREADS) { const float x = (i < 2048) ? p->in[I_C][i] : p->in[I_CCTX][i - 2048]; sc[i] = x / (1.f + __expf(-x)); }
    __syncthreads();
    float* mod = (float*)(ws + WS_MOD);
    for (int it = blockIdx.x; it < DEPTH * 96; it += G) {
        const int l = it / 96, nb = it % 96, n = nb * 64 + lane;
        const float* W = p->in[I_WADA] + (size_t)l * D * 6144 + n;
        float a0 = 0.f, a1 = 0.f, a2 = 0.f;
#pragma unroll 32
        for (int k = wave * 128; k < wave * 128 + 128; ++k) { const float w = W[(size_t)k * 6144]; a0 += sc[k] * w; a1 += sc[1024 + k] * w; a2 += sc[2048 + k] * w; }
        red[(wave * 3 + 0) * 64 + lane] = a0; red[(wave * 3 + 1) * 64 + lane] = a1; red[(wave * 3 + 2) * 64 + lane] = a2;
        __syncthreads();
        if (tid < 192) { const int v = tid >> 6, ln = tid & 63; float s = p->in[I_BADA][l * 6144 + nb * 64 + ln];
#pragma unroll
            for (int w = 0; w < 8; ++w) s += red[(w * 3 + v) * 64 + ln];
            mod[((size_t)l * 3 + v) * 6144 + nb * 64 + ln] = s; }
        __syncthreads();
    }
    if (blockIdx.x == 0) {
        f32x2* tab = (f32x2*)(ws + WS_ROPE);
        for (int i = tid; i < 128 * 8; i += NTHREADS) { const int pos = i >> 3, j = i & 7; const float f = powf(10000.f, -(float)j / 8.f); const float ang = (float)pos * f; tab[i] = (f32x2){cosf(ang), sinf(ang)}; }
        if (tid < DEPTH) { const float* lv = p->in[I_DLAM] + tid * 128; float s1 = 0.f, s2 = 0.f;
            for (int j = 0; j < 32; ++j) { s1 += lv[j] * lv[32 + j]; s2 += lv[64 + j] * lv[96 + j]; }
            ((float*)(ws + WS_LAM))[tid] = expf(s1) - expf(s2) + (0.8f - 0.6f * expf(-0.3f * (float)tid)); }
    }
    LAS h16* scr = (LAS h16*)(lds + 32768 + wave * 8448);
    const int gw = vcu * NWAVES + wave, NGW = G * NWAVES;
    constexpr int N_IN = DEPTH * 16 * 40, N_OUT = DEPTH * 16 * 16, N_E = DEPTH * NEXP * 128, N_RG = DEPTH * 2 * 8;
    constexpr int NITEMS = N_IN + N_OUT + 3 * N_E + 2 * N_RG;
    for (int it = gw; it < NITEMS; it += NGW) {
        int r = it;
        if (r < N_IN) { const int l = r / 640; p0_transpose_item(p->in[I_WIN] + (size_t)l * D * INC, D, INC, (h16*)(ws + WS_WIN) + (size_t)l * INC * D, scr, r % 640, lane); continue; } r -= N_IN;
        if (r < N_OUT) { const int l = r / 256; p0_transpose_item(p->in[I_WOUT] + (size_t)l * D * D, D, D, (h16*)(ws + WS_WOUT) + (size_t)l * D * D, scr, r % 256, lane); continue; } r -= N_OUT;
        if (r < N_E) { const int mi = r / 128; p0_transpose_item(p->in[I_W1] + (size_t)mi * D * DEXP, D, DEXP, (h16*)(ws + WS_W1) + (size_t)mi * D * DEXP, scr, r % 128, lane); continue; } r -= N_E;
        if (r < N_E) { const int mi = r / 128; p0_transpose_item(p->in[I_W3] + (size_t)mi * D * DEXP, D, DEXP, (h16*)(ws + WS_W3) + (size_t)mi * D * DEXP, scr, r % 128, lane); continue; } r -= N_E;
        if (r < N_E) { const int mi = r / 128; p0_transpose_item(p->in[I_W2] + (size_t)mi * D * DEXP, DEXP, D, (h16*)(ws + WS_W2) + (size_t)mi * D * DEXP, scr, r % 128, lane); continue; } r -= N_E;
        {
            const int gate = r / N_RG; r %= N_RG; const int mi = r; const int ldir = mi >> 3, nb = mi & 7;
            const float* src = p->in[gate ? I_RGWI : I_RGWR] + (size_t)mi * 4096;
            h16* dst = (h16*)(ws + WS_RGW) + ((size_t)(ldir * 2 + gate) * 8 + nb) * 4096;
            p0_transpose_item(src, 64, 64, dst, scr, 0, lane);
        }
    }
}

__device__ __forceinline__ void phase_norm1(KP p, int l, int mode, volatile LAS int* tab, int vcu, int G, bool dummy) {
    const int tid = tid_now(); const int lane = tid & 63, wave = __builtin_amdgcn_readfirstlane(tid >> 6);
    unsigned char* ws = p->ws;
    float* xl = (float*)(ws + WS_XL); h16* hl = (h16*)(ws + (dummy ? WS_ACT : WS_HL)); float* xlo = dummy ? (float*)(ws + WS_XG) : xl;
    const float* mod = (const float*)(ws + WS_MOD);
    const int* asg = (const int*)(ws + WS_ASG); const float* ew = (const float*)(ws + WS_EW);
    const h16* yb = (const h16*)(ws + WS_YB);
    const int nrows = (mode == 2) ? NLAT : NROW;
    const int prev_rows = (l == DEPTH) ? NLAT : NROW;
    const int gw = vcu * NWAVES + wave, NGW = G * NWAVES;
    for (int row = gw; row < nrows; row += NGW) {
        const int v = (row < NLAT) ? (row >> 13) : 2;
        f32x4 x[4];
        if (mode == 0) {
            const float* src = (row < NLAT) ? p->in[I_X] + (size_t)row * D : p->in[I_CTX] + (size_t)(row - NLAT) * D;
#pragma unroll
            for (int j = 0; j < 4; ++j) x[j] = *(const f32x4*)(src + 4 * lane + 256 * j);
        } else {
            const float* src = xl + (size_t)row * D;
#pragma unroll
            for (int j = 0; j < 4; ++j) x[j] = *(const f32x4*)(src + 4 * lane + 256 * j);
            if (row < prev_rows) {
                const int a0 = asg[row * 2], a1 = asg[row * 2 + 1];
                const float w0 = ew[row * 2], w1 = ew[row * 2 + 1];
                const size_t s0 = (size_t)a0, s1 = (size_t)a1;
                const float* ga = mod + ((size_t)(l - 1) * 3 + v) * 6144 + 5 * 1024;
#pragma unroll
                for (int j = 0; j < 4; ++j) {
                    const int c = 4 * lane + 256 * j;
                    const h16x4 y0 = *(const h16x4*)(yb + s0 * D + c), y1 = *(const h16x4*)(yb + s1 * D + c);
                    const f32x4 g = *(const f32x4*)(ga + c);
#pragma unroll
                    for (int e = 0; e < 4; ++e) x[j][e] += g[e] * (w0 * (float)y0[e] + w1 * (float)y1[e]);
                }
            }
        }
        if (mode != 2) {
            float* dst = xlo + (size_t)row * D;
#pragma unroll
            for (int j = 0; j < 4; ++j) *(f32x4*)(dst + 4 * lane + 256 * j) = x[j];
        }
        float ss = 0.f;
#pragma unroll
        for (int j = 0; j < 4; ++j) ss += x[j][0] * x[j][0] + x[j][1] * x[j][1] + x[j][2] * x[j][2] + x[j][3] * x[j][3];
        const float rstd = rsqrtf(wave_sum(ss) * (1.f / D) + EPS);
        if (mode == 2) {
            const float* g = p->in[I_GFINAL]; float* o = p->out + (size_t)row * D;
#pragma unroll
            for (int j = 0; j < 4; ++j) { const int c = 4 * lane + 256 * j; const f32x4 gv = *(const f32x4*)(g + c); *(f32x4*)(o + c) = x[j] * rstd * gv; }
        } else {
            const float* g = p->in[I_GMIX] + l * D; const float* sh = mod + ((size_t)l * 3 + v) * 6144; const float* scl = sh + 1024;
            h16* o = hl + (size_t)row * D;
#pragma unroll
            for (int j = 0; j < 4; ++j) { const int c = 4 * lane + 256 * j; const f32x4 gv = *(const f32x4*)(g + c), sv = *(const f32x4*)(scl + c), hv = *(const f32x4*)(sh + c);
                const f32x4 y = x[j] * rstd * gv * (1.f + sv) + hv;
                u32x2 w; w.x = pkh(y[0], y[1]); w.y = pkh(y[2], y[3]); *(u32x2*)(o + c) = w; }
        }
    }
}

#define SM_THR 6.0f
#define SOFTMAX_TILE(s, m, l, oA, oB, pfa, pfb) do { \
    float mx_ = fmaxf(fmaxf(s[0], s[1]), s[2]); \
    _Pragma("unroll") for (int r_ = 3; r_ < 15; r_ += 2) mx_ = fmaxf(fmaxf(mx_, s[r_]), s[r_ + 1]); \
    mx_ = fmaxf(mx_, s[15]); mx_ = xhalf_max(mx_); \
    if (__any(mx_ > m + SM_THR)) { const float dl_ = (mx_ > m + SM_THR) ? (mx_ - m) : 0.f; m += dl_; \
        const float al_ = __builtin_amdgcn_exp2f(-dl_); l *= al_; oA *= al_; oB *= al_; } \
    _Pragma("unroll") for (int r_ = 0; r_ < 16; ++r_) s[r_] = __builtin_amdgcn_exp2f(s[r_] - m); \
    { float sm_ = 0.f; _Pragma("unroll") for (int r_ = 0; r_ < 16; ++r_) sm_ += s[r_]; l += sm_; } \
    _Pragma("unroll") for (int j_ = 0; j_ < 8; ++j_) { pfa[j_] = (h16)s[j_]; pfb[j_] = (h16)s[8 + j_]; } \
} while (0)

__device__ __forceinline__ int pi32(int r) { return (r & 19) | (((r >> 3) & 1) << 2) | (((r >> 2) & 1) << 3); }

constexpr int DA_STAGE = 18432;
__device__ __forceinline__ unsigned pkrtz(float a, float b) { return __builtin_bit_cast(unsigned, __builtin_amdgcn_cvt_pkrtz(a, b)); }
__device__ __forceinline__ void da_exp_pack(f32x16& s, float& l, h16x8& pa, h16x8& pb) {
#pragma unroll
    for (int r = 0; r < 16; ++r) s[r] = __builtin_amdgcn_exp2f(s[r]);
    u32x4 wa, wb;
    wa.x = pkrtz(s[0], s[1]); wa.y = pkrtz(s[2], s[3]); wa.z = pkrtz(s[4], s[5]); wa.w = pkrtz(s[6], s[7]);
    wb.x = pkrtz(s[8], s[9]); wb.y = pkrtz(s[10], s[11]); wb.z = pkrtz(s[12], s[13]); wb.w = pkrtz(s[14], s[15]);
    const h16x2 one2 = {(h16)1.f, (h16)1.f};
    float sm = l;
#pragma unroll
    for (int j = 0; j < 4; ++j) { sm = __builtin_amdgcn_fdot2(__builtin_bit_cast(h16x2, wa[j]), one2, sm, false); sm = __builtin_amdgcn_fdot2(__builtin_bit_cast(h16x2, wb[j]), one2, sm, false); }
    l = sm;
    pa = __builtin_bit_cast(h16x8, wa); pb = __builtin_bit_cast(h16x8, wb);
}
__device__ __forceinline__ void diff_unit(KP p, int l, int b, int h, int qrow0, int kt0, int nkt, LAS unsigned char* lds) {
    const int tid = tid_now(), lane = tid & 63, wid = __builtin_amdgcn_readfirstlane(tid >> 6), q32 = lane & 31, hi = lane >> 5;
    unsigned char* ws = p->ws;
    const h16* Qd = (const h16*)(ws + WS_QD); const h16* Kd = (const h16*)(ws + WS_KD); const h16* VdT = (const h16*)(ws + WS_VDT);
    h16* mix = (h16*)(ws + WS_MIX);
    const int qrow = qrow0 + wid * 32 + q32;
    h16x8 qf00, qf01, qf10, qf11;
    {
        const h16* qp = Qd + (size_t)qrow * 256 + h * 64 + hi * 8;
        qf00 = *(const h16x8*)(qp); qf01 = *(const h16x8*)(qp + 16); qf10 = *(const h16x8*)(qp + 32); qf11 = *(const h16x8*)(qp + 48);
    }
    const h16x8 zero8 = {0, 0, 0, 0, 0, 0, 0, 0};
    f32x16 negm0, negm1;
    {
        const float* km = (const float*)((const unsigned*)(ws + WS_CTL) + CW_KMAX + l * 16) + (b * 4 + h) * 2;
        float q0 = 0.f, q1 = 0.f;
#pragma unroll
        for (int j = 0; j < 8; ++j) { q0 += (float)qf00[j] * (float)qf00[j] + (float)qf01[j] * (float)qf01[j]; q1 += (float)qf10[j] * (float)qf10[j] + (float)qf11[j] * (float)qf11[j]; }
        q0 = xhalf_sum(q0); q1 = xhalf_sum(q1);
        const float m0 = sqrtf(q0 * km[0]) * 1.004f + 0.01f - 10.f, m1 = sqrtf(q1 * km[1]) * 1.004f + 0.01f - 10.f;
#pragma unroll
        for (int r = 0; r < 16; ++r) { negm0[r] = -m0; negm1[r] = -m1; }
    }
    const int srow = tid >> 3, sch = tid & 7;
    const h16* kg = Kd + ((size_t)(b * KEYS + kt0 * 64 + srow)) * 256 + h * 64 + sch * 8;
    const h16* vg = VdT + ((size_t)((b * 4 + h) * 64 + srow)) * KEYS + kt0 * 64 + sch * 8;
    const int sto = srow * 144 + sch * 16;
    const int koff = pi32(q32) * 144 + hi * 16, voff = 9216 + q32 * 144 + hi * 16;
    float l0 = 0.f, l1 = 0.f;
    f32x16 o00 = {}, o01 = {}, o10 = {}, o11 = {};
#define DA_MF(a_, b_, c_) __builtin_amdgcn_mfma_f32_32x32x16_f16(a_, b_, c_, 0, 0, 0)
#define DA_KLOAD(addr) do { const LAS unsigned char* kb_ = (addr); kf0a = *(const LAS h16x8*)(kb_); kf0b = *(const LAS h16x8*)(kb_ + 32); kf1a = *(const LAS h16x8*)(kb_ + 64); kf1b = *(const LAS h16x8*)(kb_ + 96); } while (0)
#define DA_VLOAD(addr) do { const LAS unsigned char* vb_ = (addr); v00 = *(const LAS h16x8*)(vb_); v10 = *(const LAS h16x8*)(vb_ + 4608); v01 = *(const LAS h16x8*)(vb_ + 32); v11 = *(const LAS h16x8*)(vb_ + 4608 + 32); } while (0)
#define DA_STEP(PP0a, PP0b, PP1a, PP1b, PN0a, PN0b, PN1a, PN1b, vaddr, kaddr) do { \
        o00 = DA_MF(v00, PP0a, o00); o10 = DA_MF(v00, PP1a, o10); o01 = DA_MF(v10, PP0a, o01); o11 = DA_MF(v10, PP1a, o11); \
        o00 = DA_MF(v01, PP0b, o00); o10 = DA_MF(v01, PP1b, o10); o01 = DA_MF(v11, PP0b, o01); o11 = DA_MF(v11, PP1b, o11); \
        da_exp_pack(s0, l0, PN0a, PN0b); \
        s0 = DA_MF(kf0a, qf00, negm0); s0 = DA_MF(kf0b, qf01, s0); \
        da_exp_pack(s1, l1, PN1a, PN1b); \
        s1 = DA_MF(kf1a, qf10, negm1); s1 = DA_MF(kf1b, qf11, s1); \
        DA_VLOAD(vaddr); DA_KLOAD(kaddr); \
    } while (0)
    __syncthreads();
    u32x4 kreg = *(const u32x4*)kg, vreg = *(const u32x4*)vg;
    *(LAS u32x4*)(lds + sto) = kreg; *(LAS u32x4*)(lds + 9216 + sto) = vreg;
    kreg = *(const u32x4*)(kg + (size_t)64 * 256); vreg = *(const u32x4*)(vg + 64);
    *(LAS u32x4*)(lds + DA_STAGE + sto) = kreg; *(LAS u32x4*)(lds + DA_STAGE + 9216 + sto) = vreg;
    if (nkt > 2) { kreg = *(const u32x4*)(kg + (size_t)2 * 64 * 256); vreg = *(const u32x4*)(vg + 2 * 64); }
    __syncthreads();
    f32x16 s0, s1;
    h16x8 kf0a, kf0b, kf1a, kf1b, v00, v10, v01, v11;
    h16x8 pa0a = zero8, pa0b = zero8, pa1a = zero8, pa1b = zero8, pb0a = zero8, pb0b = zero8, pb1a = zero8, pb1b = zero8;
    DA_KLOAD(lds + koff);
    s0 = DA_MF(kf0a, qf00, negm0); s0 = DA_MF(kf0b, qf01, s0);
    s1 = DA_MF(kf1a, qf10, negm1); s1 = DA_MF(kf1b, qf11, s1);
    DA_KLOAD(lds + koff + 4608);
    DA_VLOAD(lds + voff);
    int cur = 0, nxt = DA_STAGE, wrs = 2 * DA_STAGE;
    for (int t = 0; t < nkt; ++t) {
        if (t + 2 < nkt) { *(LAS u32x4*)(lds + wrs + sto) = kreg; *(LAS u32x4*)(lds + wrs + 9216 + sto) = vreg; }
        if (t + 3 < nkt) { kreg = *(const u32x4*)(kg + (size_t)(t + 3) * 64 * 256); vreg = *(const u32x4*)(vg + (size_t)(t + 3) * 64); }
        const int pf = (t + 1 < nkt) ? nxt : cur;
        DA_STEP(pb0a, pb0b, pb1a, pb1b, pa0a, pa0b, pa1a, pa1b, lds + cur + voff, lds + pf + koff);
        DA_STEP(pa0a, pa0b, pa1a, pa1b, pb0a, pb0b, pb1a, pb1b, lds + cur + voff + 64, lds + pf + koff + 4608);
        { const int tmp = cur; cur = nxt; nxt = wrs; wrs = tmp; }
        __syncthreads();
    }
    o00 = DA_MF(v00, pb0a, o00); o10 = DA_MF(v00, pb1a, o10); o01 = DA_MF(v10, pb0a, o01); o11 = DA_MF(v10, pb1a, o11);
    o00 = DA_MF(v01, pb0b, o00); o10 = DA_MF(v01, pb1b, o10); o01 = DA_MF(v11, pb0b, o01); o11 = DA_MF(v11, pb1b, o11);
#undef DA_MF
#undef DA_KLOAD
#undef DA_VLOAD
#undef DA_STEP
    const float lam = ((const float*)(ws + WS_LAM))[l];
    const float lam_init = 0.8f - 0.6f * expf(-0.3f * (float)l);
    const float r0 = 1.f / xhalf_sum(l0), r1 = lam / xhalf_sum(l1);
    f32x16 y0 = o00 * r0 - o10 * r1, y1 = o01 * r0 - o11 * r1;
    float ss = 0.f;
#pragma unroll
    for (int r = 0; r < 16; ++r) ss += y0[r] * y0[r] + y1[r] * y1[r];
    ss = xhalf_sum(ss);
    const float sc = rsqrtf(ss * (1.f / 64.f) + EPS) * (1.f - lam_init);
    const float* g = p->in[I_DSUBG] + l * 64;
    h16* dst = mix + (size_t)qrow * D + 768 + h * 64;
#pragma unroll
    for (int r4 = 0; r4 < 4; ++r4) {
        const int e0 = 8 * r4 + 4 * hi;
        const f32x4 g0 = *(const f32x4*)(g + e0), g1 = *(const f32x4*)(g + 32 + e0);
        u32x2 w0, w1;
        w0.x = pkh(y0[4 * r4] * sc * g0[0], y0[4 * r4 + 1] * sc * g0[1]); w0.y = pkh(y0[4 * r4 + 2] * sc * g0[2], y0[4 * r4 + 3] * sc * g0[3]);
        w1.x = pkh(y1[4 * r4] * sc * g1[0], y1[4 * r4 + 1] * sc * g1[1]); w1.y = pkh(y1[4 * r4 + 2] * sc * g1[2], y1[4 * r4 + 3] * sc * g1[3]);
        *(u32x2*)(dst + e0) = w0; *(u32x2*)(dst + 32 + e0) = w1;
    }
}

constexpr int NA_K = 0, NA_V = 33792, NA_BIAS = 33792 + 36864;
__device__ __forceinline__ void na_unit(KP p, int l, int b, int gr, bool isctx, LAS unsigned char* lds) {
    const int tid = tid_now(), lane = tid & 63, wid = __builtin_amdgcn_readfirstlane(tid >> 6), q32 = lane & 31, hi = lane >> 5;
    const int h = wid >> 1, qt = wid & 1;
    unsigned char* ws = p->ws;
    const h16* qa = (const h16*)(ws + WS_QA); const h16* Ka = (const h16*)(ws + WS_KA); const h16* VaT = (const h16*)(ws + WS_VAT);
    h16* mix = (h16*)(ws + WS_MIX);
    const int qrow = isctx ? (NLAT + b * CTX + gr * 64 + qt * 32 + q32) : (b * SEQ + gr * 64 + qt * 32 + q32);
    h16x8 qf[4];
#pragma unroll
    for (int ks = 0; ks < 4; ++ks) qf[ks] = *(const h16x8*)(qa + (size_t)qrow * 256 + h * 64 + ks * 16 + hi * 8);
    const int nloc = isctx ? 0 : 8, ntile = nloc + 4;
    int kr0 = gr - 4; kr0 = kr0 < 0 ? 0 : (kr0 > 120 ? 120 : kr0);
    LAS float* bias = (LAS float*)(lds + NA_BIAS);
    __syncthreads();
    if (!isctx) { const float* rp = p->in[I_RPB] + (size_t)l * 4 * 15 * 31; for (int i = tid; i < 4 * 15 * 31; i += NTHREADS) bias[i] = rp[i] * LOG2E; }
    const int koff = NA_K + pi32(q32) * 528 + h * 128 + hi * 16;
    const int voff = NA_V + (h * 64 + q32) * 144 + hi * 16;
    const int cq = qt * 32 + q32; int cs = cq - 8; cs = cs < 0 ? 0 : (cs > 48 ? 48 : cs);
    float m = 0.f, ls = 0.f; f32x16 o0 = {}, o1 = {};
    u32x4 kpre[4], vpre[4];
#define NA_LOAD(t_) do { const int key0_ = ((t_) < nloc) ? (kr0 + (t_)) * 64 : SEQ + ((t_) - nloc) * 64; \
        _Pragma("unroll") for (int i = 0; i < 4; ++i) { const int id = tid + 512 * i; \
            kpre[i] = *(const u32x4*)(Ka + ((size_t)(b * KEYS + key0_ + (id >> 5))) * 256 + (id & 31) * 8); \
            vpre[i] = *(const u32x4*)(VaT + ((size_t)(b * 256 + (id >> 3))) * KEYS + key0_ + (id & 7) * 8); } } while (0)
    NA_LOAD(0);
    for (int t = 0; t < ntile; ++t) {
        __syncthreads();
#pragma unroll
        for (int i = 0; i < 4; ++i) { const int id = tid + 512 * i;
            *(LAS u32x4*)(lds + NA_K + (id >> 5) * 528 + (id & 31) * 16) = kpre[i];
            *(LAS u32x4*)(lds + NA_V + (id >> 3) * 144 + (id & 7) * 16) = vpre[i]; }
        __syncthreads();
        if (t + 1 < ntile) NA_LOAD(t + 1);
#pragma unroll
        for (int th = 0; th < 2; ++th) {
            f32x16 s = {};
#pragma unroll
            for (int ks = 0; ks < 4; ++ks) { const h16x8 kf = *(const LAS h16x8*)(lds + koff + th * 32 * 528 + ks * 32); s = __builtin_amdgcn_mfma_f32_32x32x16_f16(kf, qf[ks], s, 0, 0, 0); }
            if (t < nloc) {
                const int dr = kr0 + t - gr;
                const LAS float* brow = bias + (h * 15 + dr + 7) * 31 + 15 - cq;
#pragma unroll
                for (int r = 0; r < 16; ++r) { const int kc = 32 * th + 16 * (r >> 3) + 8 * hi + (r & 7);
                    const bool ok = (kc >= cs) && (kc < cs + 16); const int kcc = ok ? kc : cq; s[r] = ok ? s[r] + brow[kcc] : -INFINITY; }
            }
            h16x8 pa, pb;
            SOFTMAX_TILE(s, m, ls, o0, o1, pa, pb);
            const h16x8 v00 = *(const LAS h16x8*)(lds + voff + th * 64), v10 = *(const LAS h16x8*)(lds + voff + 32 * 144 + th * 64);
            const h16x8 v01 = *(const LAS h16x8*)(lds + voff + th * 64 + 32), v11 = *(const LAS h16x8*)(lds + voff + 32 * 144 + th * 64 + 32);
            o0 = __builtin_amdgcn_mfma_f32_32x32x16_f16(v00, pa, o0, 0, 0, 0); o1 = __builtin_amdgcn_mfma_f32_32x32x16_f16(v10, pa, o1, 0, 0, 0);
            o0 = __builtin_amdgcn_mfma_f32_32x32x16_f16(v01, pb, o0, 0, 0, 0); o1 = __builtin_amdgcn_mfma_f32_32x32x16_f16(v11, pb, o1, 0, 0, 0);
        }
    }
    const float rl = 1.f / xhalf_sum(ls);
    h16* dst = mix + (size_t)qrow * D + h * 64;
#pragma unroll
    for (int r4 = 0; r4 < 4; ++r4) {
        const int e0 = 8 * r4 + 4 * hi; u32x2 w0, w1;
        w0.x = pkh(o0[4 * r4] * rl, o0[4 * r4 + 1] * rl); w0.y = pkh(o0[4 * r4 + 2] * rl, o0[4 * r4 + 3] * rl);
        w1.x = pkh(o1[4 * r4] * rl, o1[4 * r4 + 1] * rl); w1.y = pkh(o1[4 * r4 + 2] * rl, o1[4 * r4 + 3] * rl);
        *(u32x2*)(dst + e0) = w0; *(u32x2*)(dst + 32 + e0) = w1;
    }
}

constexpr int RG_X32 = 0, RG_X16 = 16384, RG_W = 25600, RG_AB = 62464, RG_SEG = 128000;
__device__ __forceinline__ void rg_load_x(h16x8 (&xv)[4], const h16* xr, int q, int tid, bool valid) {
    const int RT = q >> 3, nb = q & 7;
    const int r = tid >> 3, ch = nb * 64 + (tid & 7) * 8;
    const bool isctx = RT >= 256; const int j = isctx ? ((RT - 256) & 3) : (RT & 127); const int seqlen = isctx ? CTX : SEQ;
#pragma unroll
    for (int tap = 0; tap < 4; ++tap) {
        const int t = j * 64 + r + tap - 2;
        if (valid && t >= 0 && t < seqlen) xv[tap] = *(const h16x8*)(xr + (size_t)(RT * 64 + r + tap - 2) * 512 + ch);
        else xv[tap] = (h16x8){0, 0, 0, 0, 0, 0, 0, 0};
    }
}
__device__ __forceinline__ void rg_gate_block(KP p, int l, int q0, int qstride, int qend, LAS unsigned char* lds, const int mode) {
    const int tid = tid_now(), lane = tid & 63, wid = __builtin_amdgcn_readfirstlane(tid >> 6), q32 = lane & 31, hi = lane >> 5;
    unsigned char* ws = p->ws;
    const h16* xr = (const h16*)(ws + WS_XR);
    float* agg = (float*)(ws + WS_AGG);
    const h16* gg = (const h16*)(ws + WS_GG); h16* mix = (h16*)(ws + WS_MIX);
    LAS float* x32 = (LAS float*)(lds + RG_X32); LAS h16* x16 = (LAS h16*)(lds + RG_X16); LAS h16* Wl = (LAS h16*)(lds + RG_W); LAS float* ab = (LAS float*)(lds + RG_AB); LAS float* seg = (LAS float*)(lds + RG_SEG);
    LAS float* carryL = (LAS float*)(lds + RG_SEG + 4096);
    if (q0 >= qend) return;
    const int nb0 = q0 & 7;
    const bool skip_ctx_out = (l == DEPTH - 1);
    h16x8 xv[4];
    rg_load_x(xv, xr, q0, tid, true);
    if (mode == 1 && tid < 256) {
        const int dir = tid >> 7, b = (tid >> 6) & 1, chl = tid & 63;
        const float* ag = agg + ((((size_t)dir * 2 + b) * 132) * 512 + nb0 * 64 + chl) * 2;
        float h = 0.f;
#pragma unroll 1
        for (int c0 = 0; c0 < 132; c0 += 33) {
            f32x2 v[33];
#pragma unroll
            for (int i = 0; i < 33; ++i) v[i] = *(const f32x2*)(ag + (size_t)(c0 + i) * 1024);
#pragma unroll
            for (int i = 0; i < 33; ++i) {
                const int c = c0 + i;
                int RT; if (dir == 0) RT = (c < 4) ? 256 + 4 * b + c : 128 * b + (c - 4); else RT = (c < 4) ? 256 + 4 * b + (3 - c) : 128 * b + 127 - (c - 4);
                const int dq = RT * 8 + nb0 - q0;
                if (dq >= 0 && (dq % qstride) == 0 && dq / qstride < 12) carryL[((dq / qstride) * 2 + dir) * 64 + chl] = h;
                h = v[i].x * h + v[i].y;
            }
        }
    }
    int cur_nb = -1;
    float cwr[4][8], cbr[8]; float g_br, g_bi, g_sp;
#define RG_LOAD_CONSTS(nb_) do { \
        const int ch_ = (nb_) * 64 + (tid & 7) * 8; const float* cw_ = p->in[I_CONVW] + (size_t)l * 4 * 512 + ch_; const float* cb_ = p->in[I_CONVB] + l * 512 + ch_; \
        _Pragma("unroll") for (int e = 0; e < 8; ++e) { cbr[e] = cb_[e]; _Pragma("unroll") for (int tap = 0; tap < 4; ++tap) cwr[tap][e] = cw_[tap * 512 + e]; } \
        const int dir_ = wid >> 2, chg_ = (nb_) * 64 + ((wid >> 1) & 1) * 32 + q32; \
        g_br = p->in[I_RGBR][(l * 2 + dir_) * 512 + chg_]; g_bi = p->in[I_RGBI][(l * 2 + dir_) * 512 + chg_]; \
        const float lamv_ = p->in[I_RGLAM][(l * 2 + dir_) * 512 + chg_]; g_sp = (lamv_ > 15.f) ? __expf(-lamv_) : log1pf(__expf(-lamv_)); } while (0)
    RG_LOAD_CONSTS(nb0);
    int const_nb = nb0;
    __syncthreads();
    int kt = 0;
    for (int q = q0; q < qend; q += qstride, ++kt) {
        const int RT = q >> 3, nb = q & 7;
        const int row0 = RT * 64;
        const bool isctx = RT >= 256; int b, j;
        if (isctx) { const int qq = RT - 256; b = qq >> 2; j = qq & 3; } else { b = RT >> 7; j = RT & 127; }
        h16x8 ggv;
        {
            const int r = tid >> 3, c8 = (tid & 7) * 8, ch = nb * 64 + c8;
            if (mode == 1) ggv = *(const h16x8*)(gg + (size_t)(row0 + r) * 512 + ch);
            if (nb != const_nb) { RG_LOAD_CONSTS(nb); const_nb = nb; }
            float accv[8];
#pragma unroll
            for (int e = 0; e < 8; ++e) accv[e] = cbr[e];
#pragma unroll
            for (int tap = 0; tap < 4; ++tap)
#pragma unroll
                for (int e = 0; e < 8; ++e) accv[e] += (float)xv[tap][e] * cwr[tap][e];
            *(LAS f32x4*)(x32 + r * 64 + c8) = (f32x4){accv[0], accv[1], accv[2], accv[3]}; *(LAS f32x4*)(x32 + r * 64 + c8 + 4) = (f32x4){accv[4], accv[5], accv[6], accv[7]};
            { u32x4 w; w.x = pkh(accv[0], accv[1]); w.y = pkh(accv[2], accv[3]); w.z = pkh(accv[4], accv[5]); w.w = pkh(accv[6], accv[7]); *(LAS u32x4*)(x16 + r * 72 + c8) = w; }
            if (nb != cur_nb) {
                const h16* wsrc = (const h16*)(ws + WS_RGW);
#pragma unroll
                for (int i = 0; i < 4; ++i) { const int id = tid + 512 * i; const int n = id >> 3, kc = id & 7; const int dg = n >> 6, nn = n & 63;
                    *(LAS u32x4*)(Wl + n * 72 + kc * 8) = *(const u32x4*)(wsrc + (((size_t)(l * 4 + dg) * 8 + nb) * 64 + nn) * 64 + kc * 8); }
                cur_nb = nb;
            }
        }
        lds_barrier();
        rg_load_x(xv, xr, q + qstride, tid, q + qstride < qend);
        {
            const int mt = wid & 1, g = wid >> 1, dir = g >> 1, ch2 = g & 1;
            f32x16 cr = {}, ci = {};
#pragma unroll
            for (int ks = 0; ks < 4; ++ks) {
                const h16x8 af = *(const LAS h16x8*)(x16 + (mt * 32 + q32) * 72 + ks * 16 + hi * 8);
                const h16x8 br = *(const LAS h16x8*)(Wl + (dir * 128 + ch2 * 32 + q32) * 72 + ks * 16 + hi * 8);
                const h16x8 bi = *(const LAS h16x8*)(Wl + (dir * 128 + 64 + ch2 * 32 + q32) * 72 + ks * 16 + hi * 8);
                cr = __builtin_amdgcn_mfma_f32_32x32x16_f16(af, br, cr, 0, 0, 0);
                ci = __builtin_amdgcn_mfma_f32_32x32x16_f16(af, bi, ci, 0, 0, 0);
            }
            const int chl = ch2 * 32 + q32;
            const float b_r = g_br, b_i = g_bi, sp = g_sp;
#pragma unroll
            for (int r = 0; r < 16; ++r) {
                const int tr = mt * 32 + crow(r, hi);
                const float rg = sigmoidf_(cr[r] + b_r), ig = sigmoidf_(ci[r] + b_i);
                const float la = -8.f * rg * sp;
                const float a = fexp_(la);
                const float x2 = 2.f * la;
                float om;
                if (x2 > -0.3f) om = -x2 * (1.f + x2 * (0.5f + x2 * (0.16666667f + x2 * (0.041666668f + x2 * (0.0083333338f + x2 * 0.0013888889f))))); else om = 1.f - fexp_(x2);
                const float bx = __builtin_amdgcn_sqrtf(om) * ig * x32[tr * 64 + chl];
                ab[((dir * 2 + 0) * 64 + tr) * 64 + chl] = a; ab[((dir * 2 + 1) * 64 + tr) * 64 + chl] = bx;
            }
        }
        lds_barrier();
        if (mode == 0) {
            {
                const int sg = tid >> 7, dir = (tid >> 6) & 1, chl = tid & 63; float A = 1.f, H = 0.f;
                const LAS float* pa = ab + (dir * 2 + 0) * 4096 + sg * 16 * 64 + chl; const LAS float* pb = ab + (dir * 2 + 1) * 4096 + sg * 16 * 64 + chl;
                if (dir == 0) {
#pragma unroll
                    for (int r = 0; r < 16; ++r) { const float a = pa[r * 64]; H = a * H + pb[r * 64]; A *= a; }
                } else {
#pragma unroll
                    for (int r = 15; r >= 0; --r) { const float a = pa[r * 64]; H = a * H + pb[r * 64]; A *= a; }
                }
                seg[((dir * 4 + sg) * 64 + chl) * 2] = A; seg[((dir * 4 + sg) * 64 + chl) * 2 + 1] = H;
            }
            lds_barrier();
            if (tid < 128) {
                const int dir = tid >> 6, chl = tid & 63; float A = 1.f, H = 0.f;
#pragma unroll
                for (int i = 0; i < 4; ++i) { const int sg = dir ? 3 - i : i; const float a = seg[((dir * 4 + sg) * 64 + chl) * 2], hh = seg[((dir * 4 + sg) * 64 + chl) * 2 + 1]; H = a * H + hh; A *= a; }
                int c;
                if (dir == 0) c = isctx ? j : 4 + j; else c = isctx ? 3 - j : 4 + 127 - j;
                float* dst = agg + ((((size_t)dir * 2 + b) * 132 + c) * 512 + nb * 64 + chl) * 2;
                dst[0] = A; dst[1] = H;
            }
        } else {
            if (tid < 128) {
                const int dir = tid >> 6, chl = tid & 63;
                float h = carryL[(kt * 2 + dir) * 64 + chl];
                LAS float* pa = ab + (dir * 2 + 0) * 4096 + chl; LAS float* pb = ab + (dir * 2 + 1) * 4096 + chl;
#pragma unroll 1
                for (int g0 = 0; g0 < 64; g0 += 16) {
                    const int r0 = dir ? 48 - g0 : g0;
                    float av[16], bv[16];
#pragma unroll
                    for (int i = 0; i < 16; ++i) { av[i] = pa[(r0 + i) * 64]; bv[i] = pb[(r0 + i) * 64]; }
                    if (dir == 0) {
#pragma unroll
                        for (int i = 0; i < 16; ++i) { h = av[i] * h + bv[i]; bv[i] = h; }
                    } else {
#pragma unroll
                        for (int i = 15; i >= 0; --i) { h = av[i] * h + bv[i]; bv[i] = h; }
                    }
#pragma unroll
                    for (int i = 0; i < 16; ++i) pb[(r0 + i) * 64] = bv[i];
                }
            }
            lds_barrier();
            if (!(isctx && skip_ctx_out)) {
                const int r = tid >> 3, c8 = (tid & 7) * 8;
                const LAS float* hf = ab + (0 * 2 + 1) * 4096 + r * 64 + c8; const LAS float* hb = ab + (1 * 2 + 1) * 4096 + r * 64 + c8;
                u32x4 w;
                w.x = pkh((hf[0] + hb[0]) * (float)ggv[0], (hf[1] + hb[1]) * (float)ggv[1]); w.y = pkh((hf[2] + hb[2]) * (float)ggv[2], (hf[3] + hb[3]) * (float)ggv[3]);
                w.z = pkh((hf[4] + hb[4]) * (float)ggv[4], (hf[5] + hb[5]) * (float)ggv[5]); w.w = pkh((hf[6] + hb[6]) * (float)ggv[6], (hf[7] + hb[7]) * (float)ggv[7]);
                *(u32x4*)(mix + (size_t)(row0 + r) * D + 256 + nb * 64 + c8) = w;
            }
        }
    }
}

__device__ __forceinline__ void phase_mix(KP p, int l, LAS unsigned char* lds, int G) {
    const bool last = (l == DEPTH - 1);
    const int n_dc = last ? 0 : 8, n_nc = last ? 0 : 8;
    const int U0 = 256, U1 = U0 + n_dc, U2 = U1 + 256, U3 = U2 + n_nc, U4 = U3 + 264 * 8;
    int u = blockIdx.x;
    for (; u < U3; u += G) {
        if (u < U0) { const int bh = u >> 5, qb = u & 31; REP(30) diff_unit(p, l, bh >> 2, bh & 3, (bh >> 2) * SEQ + qb * 256, 0, 132, lds); }
        else if (u < U1) { const int bh = u - U0; diff_unit(p, l, bh >> 2, bh & 3, NLAT + (bh >> 2) * CTX, 128, 4, lds); }
        else if (u < U2) { const int q = u - U1; REP(31) na_unit(p, l, q >> 7, q & 127, false, lds); }
        else { const int q = u - U2; na_unit(p, l, q >> 2, q & 3, true, lds); }
    }
    REP(32) rg_gate_block(p, l, u - U3, G, U4 - U3, lds, 0);
}

__device__ __forceinline__ void phase_scan(KP p, int l, LAS unsigned char* lds, int G) {
    const bool last = (l == DEPTH - 1);
    const int U3 = 256 + (last ? 0 : 8) + 256 + (last ? 0 : 8);
    int u = blockIdx.x; while (u < U3) u += G;
    rg_gate_block(p, l, u - U3, G, 264 * 8, lds, 1);
}

__device__ __forceinline__ void phase_route(KP p, int l, LAS unsigned char* lds, int vcu, int G, bool dummy) {
    const int tid = tid_now(), lane = tid & 63, wave = __builtin_amdgcn_readfirstlane(tid >> 6);
    unsigned char* ws = p->ws;
    const float* xl = (const float*)(ws + WS_XL); h16* xg = (h16*)(ws + (dummy ? WS_YB : WS_XG));
    const float* mod = (const float*)(ws + WS_MOD);
    int* asg = (int*)(ws + (dummy ? 7 * MiB : WS_ASG)); float* ew = (float*)(ws + (dummy ? 7 * MiB + 512 * 1024 : WS_EW));
    unsigned* cnt = (unsigned*)(ws + WS_CTL) + CW_CNT + l * 32 + (dummy ? 512 : 0);
    unsigned* pool = (unsigned*)(ws + WS_CTL) + CW_POOL + l + (dummy ? 8 : 0); unsigned* tmap = (unsigned*)(ws + WS_CTL) + (dummy ? 32768 : CW_TMAP) + l * 32 * 72; unsigned* owner = (unsigned*)(ws + WS_CTL) + (dummy ? 45000 : CW_OWNER) + l * 192;
    const int nrows = (l == DEPTH - 1) ? NLAT : NROW;
    LAS h16* xh = (LAS h16*)lds; LAS h16* xlo = (LAS h16*)(lds + 33024); LAS float* part = (LAS float*)(lds + 66048); LAS float* logit = (LAS float*)(lds + 90624);
    const float* wg = p->in[I_RWG] + (size_t)l * D * 4; const float* we = p->in[I_RWE] + (size_t)l * D * 32;
    const float* g = p->in[I_GFFN] + l * D;
    const int c16 = lane & 15, kq = lane >> 4;
    h16x8 bh[4][3], bl[4][3];
#pragma unroll
    for (int ks = 0; ks < 4; ++ks)
#pragma unroll
        for (int nt = 0; nt < 3; ++nt) {
            const int n = nt * 16 + c16;
#pragma unroll
            for (int j = 0; j < 8; ++j) {
                const int k = wave * 128 + ks * 32 + kq * 8 + j;
                float w = (n < 32) ? we[(size_t)k * 32 + n] : ((n < 36) ? wg[(size_t)k * 4 + (n - 32)] : 0.f);
                w *= 64.f; const h16 hh = (h16)w; bh[ks][nt][j] = hh; bl[ks][nt][j] = (h16)(w - (float)hh);
            }
        }
    LAS int* r_e = (LAS int*)(lds + 93184);
    LAS int* r_rk = r_e + 80;
    LAS float* r_w = (LAS float*)(r_rk + 80);
    LAS int* hist = (LAS int*)(r_w + 160);
    LAS int* baseL = hist + 32;
    LAS int* slotL = baseL + 32;
    h16* hl = (h16*)(ws + WS_HL);
    int* rlist = (int*)((unsigned*)(ws + WS_CTL) + CW_RLIST + l * (MAXTILES * 256));
    if (tid < 32) hist[tid] = 0;
    const int ngroups = nrows / 16;
    int nloc = 0;
    const unsigned* done5 = (const unsigned*)(ws + WS_CTL) + CW_D5 + l * 128;
    const int nskip = 0;
    const int rG = G - (nskip > 0 ? nskip : 0), ridx = (int)blockIdx.x - (nskip > 0 ? nskip : 0);
    if (ridx < 0) return;
    if (tid < 64) {
        for (int grp = ridx; grp < ngroups; grp += rG) {
            const unsigned need = (grp >> 4) >= NLAT / 256 ? 16u : 4u; unsigned spins = 0;
            while ((unsigned)__builtin_amdgcn_readfirstlane(__hip_atomic_load(done5 + (grp >> 4), __ATOMIC_RELAXED, __HIP_MEMORY_SCOPE_AGENT)) < need) { __builtin_amdgcn_s_sleep(2); if (++spins > (1u << 24)) break; }
        }
        __builtin_amdgcn_fence(__ATOMIC_ACQUIRE, "agent");
        asm volatile("s_waitcnt vmcnt(0)" ::: "memory");
    }
    __syncthreads();
    f32x4 xr[2][4];
#define R6_LOAD(grp_) do { _Pragma("unroll") for (int rr = 0; rr < 2; ++rr) { const int row_ = (grp_) * 16 + wave * 2 + rr; \
            _Pragma("unroll") for (int j = 0; j < 4; ++j) xr[rr][j] = *(const f32x4*)(xl + (size_t)row_ * D + 4 * lane + 256 * j); } } while (0)
    if (ridx < ngroups) R6_LOAD(ridx);
    for (int grp = ridx, kk = 0; grp < ngroups; grp += rG, ++kk) {
        lds_barrier();
#pragma unroll
        for (int rr = 0; rr < 2; ++rr) {
            const int lr = wave * 2 + rr, row = grp * 16 + lr; const int v = (row < NLAT) ? (row >> 13) : 2;
            f32x4 x[4]; float ss = 0.f;
#pragma unroll
            for (int j = 0; j < 4; ++j) x[j] = xr[rr][j];
            if (row >= NLAT && l != DEPTH - 1) {
                const float* pp = (const float*)(ws + WS_RGA) + (size_t)(row - NLAT) * D;
#pragma unroll
                for (int kq = 0; kq < 4; ++kq)
#pragma unroll
                    for (int j = 0; j < 4; ++j) x[j] += *(const f32x4*)(pp + (size_t)kq * NCTX * D + 4 * lane + 256 * j);
#pragma unroll
                for (int j = 0; j < 4; ++j) *(f32x4*)((float*)(ws + WS_XL) + (size_t)row * D + 4 * lane + 256 * j) = x[j];
            }
#pragma unroll
            for (int j = 0; j < 4; ++j) ss += x[j][0] * x[j][0] + x[j][1] * x[j][1] + x[j][2] * x[j][2] + x[j][3] * x[j][3];
            const float rstd = rsqrtf(wave_sum(ss) * (1.f / D) + EPS);
            const float* sh = mod + ((size_t)l * 3 + v) * 6144 + 3 * 1024; const float* scl = sh + 1024;
            h16* o = hl + (size_t)row * D;
#pragma unroll
            for (int j = 0; j < 4; ++j) { const int c = 4 * lane + 256 * j; const f32x4 gv = *(const f32x4*)(g + c), sv = *(const f32x4*)(scl + c), hv = *(const f32x4*)(sh + c);
                const f32x4 y = x[j] * rstd * gv * (1.f + sv) + hv;
                h16x4 yh, yl;
#pragma unroll
                for (int e = 0; e < 4; ++e) { yh[e] = (h16)y[e]; yl[e] = (h16)(y[e] - (float)yh[e]); }
                *(LAS h16x4*)(xh + lr * 1032 + c) = yh; *(LAS h16x4*)(xlo + lr * 1032 + c) = yl; *(h16x4*)(o + c) = yh; }
        }
        if (grp + rG < ngroups) R6_LOAD(grp + rG);
        lds_barrier();
        {
            f32x4 acc[3] = {{0.f, 0.f, 0.f, 0.f}, {0.f, 0.f, 0.f, 0.f}, {0.f, 0.f, 0.f, 0.f}};
#pragma unroll
            for (int ks = 0; ks < 4; ++ks) {
                const int ko = c16 * 1032 + wave * 128 + ks * 32 + kq * 8;
                const h16x8 ah = *(const LAS h16x8*)(xh + ko), al = *(const LAS h16x8*)(xlo + ko);
#pragma unroll
                for (int nt = 0; nt < 3; ++nt) {
                    acc[nt] = __builtin_amdgcn_mfma_f32_16x16x32_f16(ah, bh[ks][nt], acc[nt], 0, 0, 0);
                    acc[nt] = __builtin_amdgcn_mfma_f32_16x16x32_f16(ah, bl[ks][nt], acc[nt], 0, 0, 0);
                    acc[nt] = __builtin_amdgcn_mfma_f32_16x16x32_f16(al, bh[ks][nt], acc[nt], 0, 0, 0);
                }
            }
#pragma unroll
            for (int nt = 0; nt < 3; ++nt)
#pragma unroll
                for (int r = 0; r < 4; ++r) part[(wave * 16 + kq * 4 + r) * 48 + nt * 16 + c16] = acc[nt][r];
        }
        lds_barrier();
        for (int i = tid; i < 16 * 36; i += NTHREADS) { const int r = i / 36, o = i % 36; const int n = (o < 4) ? 32 + o : o - 4;
            float sacc = 0.f;
#pragma unroll
            for (int w = 0; w < 8; ++w) sacc += part[(w * 16 + r) * 48 + n];
            logit[i] = sacc * (1.f / 64.f) + ((o < 4) ? p->in[I_RBG][l * 4 + o] : p->in[I_RBE][l * 32 + o - 4]); }
        lds_barrier();
        if (tid < 16) {
            const LAS float* lg = logit + tid * 36;
            int gi = 0; float gm = lg[0];
#pragma unroll
            for (int i = 1; i < 4; ++i) if (lg[i] > gm) { gm = lg[i]; gi = i; }
            float gs = 0.f;
#pragma unroll
            for (int i = 0; i < 4; ++i) gs += __expf(lg[i] - gm);
            const float gtop = 1.f / gs;
            const LAS float* el = lg + 4 + gi * 8;
            int i1 = 0; float m1 = el[0];
#pragma unroll
            for (int i = 1; i < 8; ++i) if (el[i] > m1) { m1 = el[i]; i1 = i; }
            int i2 = -1; float m2 = -INFINITY;
#pragma unroll
            for (int i = 0; i < 8; ++i) if (i != i1 && el[i] > m2) { m2 = el[i]; i2 = i; }
            const float e2 = __expf(m2 - m1); const float inv = 1.f / (1.f + e2);
            const int ea = gi * 8 + i1, eb = gi * 8 + i2;
            const int ra = atomicAdd((int*)(hist + ea), 1), rb = atomicAdd((int*)(hist + eb), 1);
            const int lr = kk * 16 + tid;
            r_e[lr] = ea | (eb << 8); r_rk[lr] = ra | (rb << 16); r_w[lr * 2] = gtop * inv; r_w[lr * 2 + 1] = gtop * e2 * inv;
        }
        nloc = kk * 16 + 16;
    }
    __syncthreads();
    if (tid < 32) {
        const int n = hist[tid]; int base = 0;
        if (n > 0) {
            base = (int)atomicAdd(&cnt[tid], (unsigned)n);
            const int j0 = base >> 8, j1 = (base + n - 1) >> 8;
            if ((base & 255) == 0) { const unsigned t = atomicAdd(pool, 1u); __hip_atomic_store(owner + t, (unsigned)tid, __ATOMIC_RELAXED, __HIP_MEMORY_SCOPE_AGENT); __hip_atomic_store(tmap + tid * 72 + j0, t + 1u, __ATOMIC_RELAXED, __HIP_MEMORY_SCOPE_AGENT); }
            if (j1 != j0) { const unsigned t = atomicAdd(pool, 1u); __hip_atomic_store(owner + t, (unsigned)tid, __ATOMIC_RELAXED, __HIP_MEMORY_SCOPE_AGENT); __hip_atomic_store(tmap + tid * 72 + j1, t + 1u, __ATOMIC_RELAXED, __HIP_MEMORY_SCOPE_AGENT); }
        }
        baseL[tid] = base;
    }
    __syncthreads();
    if (tid < nloc) {
        const int lr = tid, grp = ridx + (lr >> 4) * rG, row = grp * 16 + (lr & 15);
        const int ee = r_e[lr], rk = r_rk[lr]; const int ea = ee & 255, eb = ee >> 8;
        const unsigned pa = (unsigned)(baseL[ea] + (rk & 0xffff)), pb = (unsigned)(baseL[eb] + (rk >> 16));
        unsigned* tma = tmap + ea * 72 + (pa >> 8); unsigned* tmb = tmap + eb * 72 + (pb >> 8);
        unsigned ta = 0u, tb = 0u, spin = 0u;
        while (ta == 0u || tb == 0u) {
            if (ta == 0u) ta = __hip_atomic_load(tma, __ATOMIC_RELAXED, __HIP_MEMORY_SCOPE_AGENT);
            if (tb == 0u) tb = __hip_atomic_load(tmb, __ATOMIC_RELAXED, __HIP_MEMORY_SCOPE_AGENT);
            if (++spin > (1u << 22)) break;
        }
        const int sa_ = (int)((ta - 1u) * 256u + (pa & 255u)), sb_ = (int)((tb - 1u) * 256u + (pb & 255u));
        asg[row * 2] = sa_; asg[row * 2 + 1] = sb_;
        ew[row * 2] = r_w[lr * 2]; ew[row * 2 + 1] = r_w[lr * 2 + 1];
        rlist[sa_] = row; rlist[sb_] = row;
    }
}

__device__ __forceinline__ void moe_table(KP p, int l, volatile LAS int* tab) {
    __syncthreads();
    if (tid_now() == 0) {
        const unsigned* cnt = (const unsigned*)(p->ws + WS_CTL) + CW_CNT + l * 32; int s = 0;
        for (int e = 0; e < NEXP; ++e) { tab[e] = s; s += (int)((__hip_atomic_load(cnt + e, __ATOMIC_RELAXED, __HIP_MEMORY_SCOPE_AGENT) + 255u) >> 8); }
        tab[NEXP] = s;
    }
    __syncthreads();
}

__global__ void __launch_bounds__(NTHREADS, 2) fwd_kernel(Params p_) {
    KP p = (KP)__builtin_amdgcn_kernarg_segment_ptr();
#define RELOAD_P() asm volatile("" : "+s"(p))
    extern __shared__ __attribute__((aligned(16))) unsigned char lds_raw[];
    LAS unsigned char* lds = (LAS unsigned char*)lds_raw;
    volatile LAS unsigned* MISC = (volatile LAS unsigned*)(lds + MISC_OFF);
    volatile LAS int* tab = (volatile LAS int*)(lds + MISC_OFF + 64);
    const int tid = threadIdx.x;
    const int G = gridDim.x; const int bx = blockIdx.x; const int vcu = (G % 8 == 0) ? (bx % 8) * (G / 8) + bx / 8 : bx;
    unsigned char* ws = p->ws;
    for (int u = tid; u < 256; u += NTHREADS) MISC[u] = 0u;
    __syncthreads();
    {
        XcdBarrier b0 = xcd_barrier_post((unsigned*)(ws + WS_CTL) + CW_BAR, MISC);
        cg::this_grid().sync();
        if (tid == 0) { unsigned nloc, nx; xcd_barrier_complete(b0.bar, b0.x, nloc, nx); MISC[0] = nloc; MISC[1] = nx; }
        __syncthreads();
    }
#define GRID_BAR() do { GRID_BAR1(); if (PROBE_REPEAT == 99) GRID_BAR1(); if (PROBE_STAMP >= 0 && blockIdx.x == 0 && tid == 0) { ((unsigned long long*)(ws + WS_LAM + 1024))[nstamp] = __builtin_amdgcn_s_memrealtime(); } ++nstamp; } while (0)
#define GRID_BAR1() do { RELOAD_P(); { unsigned char* w_ = p->ws; XcdBarrier b_; b_.bar = (unsigned*)(w_ + WS_CTL) + CW_BAR; b_.x = xb_xcc_id(); b_.st = MISC; xcd_barrier(b_); } \
    RELOAD_P(); ws = p->ws; } while (0)
#ifdef ONLY_PHASE
#define PH(n) (ONLY_PHASE == (n))
#else
#define PH(n) 1
#endif

    int nstamp = 0;
    if (PROBE_STAMP >= 0 && blockIdx.x == 0 && tid == 0) ((unsigned long long*)(ws + WS_LAM + 1024))[63] = __builtin_amdgcn_s_memrealtime();
    REP(0) if (PH(0)) phase_p0(p, lds, vcu, G);
    GRID_BAR();
#pragma unroll 1
    for (int l = 0; l < DEPTH; ++l) {
        const bool last = (l == DEPTH - 1);
        REP(1) if (PH(1)) phase_norm1(p, l, l == 0 ? 0 : 1, tab, vcu, G, DUMMY(1));
        GRID_BAR();
        REP(2) if (PH(2)) {
            pg8::DenseSched S; S.init(ws + WS_HL, ws + WS_WIN + (size_t)l * INC * D * 2, NROW, INC, D, G, bx);
            EpiInProj E{(h16*)(ws + WS_QA), (h16*)(ws + WS_KA), (h16*)(ws + WS_VAT), (h16*)(ws + WS_XR), (h16*)(ws + WS_GG), (h16*)(ws + WS_QD), (h16*)(ws + WS_KD), (h16*)(ws + WS_VDT), (const f32x2*)(ws + WS_ROPE), (unsigned*)(ws + WS_CTL) + CW_KMAX + l * 16, lds + 131072};
            pg8::gemm_phase<EpiInProj, pg8::DenseSched>(lds, D, S, E);
        }
        GRID_BAR();
        if (PH(3)) phase_mix(p, l, lds, G);
        GRID_BAR();
        REP(4) if (PH(4)) phase_scan(p, l, lds, G);
        GRID_BAR();
        REP(5) if (PH(5)) {
            pg8::DenseSched S; S.init(ws + WS_MIX, ws + WS_WOUT + (size_t)l * D * D * 2, NLAT, D, D, G, bx, (unsigned*)(ws + WS_CTL) + CW_D5 + l * 128);
            EpiOutProj E{(float*)(ws + WS_XL), (const float*)(ws + WS_MOD) + (size_t)l * 3 * 6144, (float*)(ws + WS_XL)};
            pg8::gemm_phase<EpiOutProj, pg8::DenseSched>(lds, D, S, E);
        }
        if (PH(5) && !last) {
            RELOAD_P(); ws = p->ws;
            CtxSplitSched S2{(const char*)(ws + WS_MIX), (const char*)(ws + WS_WOUT + (size_t)l * D * D * 2), (int)blockIdx.x - (G - 32), (unsigned*)(ws + WS_CTL) + CW_D5 + l * 128};
            EpiOutPart E2{(float*)(ws + WS_RGA), (const float*)(ws + WS_MOD) + (size_t)l * 3 * 6144};
            int klen = 256; asm volatile("" : "+s"(klen));
            pg8::gemm_phase<EpiOutPart, CtxSplitSched>(lds, klen, S2, E2, nullptr, D);
        }
        REP(6) if (PH(6)) phase_route(p, l, lds, vcu, G, DUMMY(6));
        GRID_BAR();
        moe_table(p, l, tab);
        REP(8) if (PH(8)) {
            MoeSched1 S{(const char*)((const unsigned*)(ws + WS_CTL) + CW_RLIST + l * (MAXTILES * 256)), (const char*)(ws + WS_W1 + (size_t)l * NEXP * DEXP * D * 2), (const char*)(ws + WS_W3 + (size_t)l * NEXP * DEXP * D * 2), (const unsigned*)(ws + WS_CTL) + CW_TMAP + l * 32 * 72, tab, tab[NEXP], G, vcu, (unsigned*)(ws + WS_CTL) + CW_D7 + l * 192};
            EpiMoe1 E{(h16*)(ws + WS_ACT)};
            pg8::gemm_phase<EpiMoe1, MoeSched1, true>(lds, D, S, E, (const char*)(ws + WS_HL));
        }
        REP(9) if (PH(9)) {
            MoeSched2 S{(const char*)(ws + WS_ACT), (const char*)(ws + WS_W2 + (size_t)l * NEXP * DEXP * D * 2), (const unsigned*)(ws + WS_CTL) + CW_TMAP + l * 32 * 72, tab, tab[NEXP], G, vcu, (const unsigned*)(ws + WS_CTL) + CW_D7 + l * 192, 0, 0, 0};
            S.plan();
            EpiMoe2 E{(h16*)(ws + WS_YB)};
            pg8::gemm_phase<EpiMoe2, MoeSched2>(lds, DEXP, S, E);
        }
        GRID_BAR();
    }
    if (PH(10)) phase_norm1(p, DEPTH, 2, tab, vcu, G, false);
    if (PROBE_STAMP >= 0 && blockIdx.x == 0 && tid == 0) {
        const unsigned long long* st = (const unsigned long long*)(ws + WS_LAM + 1024);
        unsigned long long tot = 0;
        if (PROBE_STAMP == 7) tot = __builtin_amdgcn_s_memrealtime() - st[63];
        else if (PROBE_STAMP == 0) tot = st[0] - st[63];
        else for (int l = 0; l < DEPTH; ++l) { const int e = PROBE_STAMP + 6 * l; tot += st[e] - st[e - 1]; }
        asm volatile("s_waitcnt vmcnt(0)" ::: "memory");
        p->out[0] = (float)tot * (0.01f / ((PROBE_STAMP == 3 || PROBE_STAMP == 7) ? 100.f : 10.f));
    }
}

extern "C" void kernel_launch(void* const* d_in, const int* in_sizes, int n_in, void* d_out, int out_size, void* d_ws, size_t ws_size, hipStream_t stream) {
    static int grid = 0;
    if (grid == 0) {
        if (n_in != 28 || out_size != NLAT * D || ws_size < WS_END) { fprintf(stderr, "kernel_launch: unexpected shapes (n_in %d out %d ws %zu)\n", n_in, out_size, ws_size); grid = -1; return; }
        int dev = 0, cus = 0, per_cu = 0;
        if (hipGetDevice(&dev) != hipSuccess || hipDeviceGetAttribute(&cus, hipDeviceAttributeMultiprocessorCount, dev) != hipSuccess) { grid = -1; return; }
        if (hipFuncSetAttribute((const void*)fwd_kernel, hipFuncAttributeMaxDynamicSharedMemorySize, LDS_BYTES) != hipSuccess) { fprintf(stderr, "kernel_launch: hipFuncSetAttribute failed\n"); grid = -1; return; }
        if (hipOccupancyMaxActiveBlocksPerMultiprocessor(&per_cu, (const void*)fwd_kernel, NTHREADS, LDS_BYTES) != hipSuccess || per_cu < 1) { fprintf(stderr, "kernel_launch: occupancy query says %d blocks per CU\n", per_cu); (void)hipGetLastError(); grid = -1; return; }
        grid = cus;
    }
    if (grid < 0) return;
    (void)hipMemsetAsync((char*)d_ws + WS_CTL, 0, CTL_ZERO_BYTES, stream);
    Params p{};
    for (int i = 0; i < 28; ++i) p.in[i] = (const float*)d_in[i];
    p.out = (float*)d_out; p.ws = (unsigned char*)d_ws;
    void* args[] = {&p};
    hipError_t e = hipLaunchCooperativeKernel((const void*)fwd_kernel, dim3(grid), dim3(NTHREADS), args, LDS_BYTES, stream);
    if (e != hipSuccess) fprintf(stderr, "kernel_launch: cooperative launch failed: %s (grid %d)\n", hipGetErrorString(e), grid);
}
```

```cpp
#include <hip/hip_runtime.h>
#include <hip/hip_cooperative_groups.h>
#include <cstdio>
#include <cstdint>
namespace cg = cooperative_groups;

#define LAS __attribute__((address_space(3)))
typedef _Float16 h16;
typedef h16 h16x8 __attribute__((ext_vector_type(8)));
typedef h16 h16x4 __attribute__((ext_vector_type(4)));
typedef h16 h16x2 __attribute__((ext_vector_type(2)));
typedef float f32x2 __attribute__((ext_vector_type(2)));
typedef float f32x4 __attribute__((ext_vector_type(4)));
typedef float f32x16 __attribute__((ext_vector_type(16)));
typedef unsigned u32x2 __attribute__((ext_vector_type(2)));
typedef unsigned u32x4 __attribute__((ext_vector_type(4)));

#define PROBE_REPEAT -1
#define PROBE_STAMP -1
#define REP(n) for (int rep_ = 0; rep_ < ((PROBE_REPEAT == (n)) ? 2 : 1); ++rep_)
#define DUMMY(n) ((PROBE_REPEAT == (n)) && rep_ == 0)
constexpr int D = 1024, NBATCH = 2, SEQ = 8192, CTX = 256, DEPTH = 4;
constexpr int NLAT = NBATCH * SEQ, NCTX = NBATCH * CTX, NROW = NLAT + NCTX;
constexpr int KEYS = SEQ + CTX;
constexpr int INC = 2560;
constexpr int NEXP = 32, DEXP = 512;
constexpr int NWAVES = 8, NTHREADS = 512;
constexpr float EPS = 1e-6f;
constexpr float LOG2E = 1.4426950408889634f;

constexpr size_t MiB = 1u << 20;
constexpr size_t WS_CTL = 0, CTL_ZERO_BYTES = 1 * MiB;
constexpr int CW_BAR = 4096;
constexpr int CW_CNT = 1024;
constexpr size_t WS_MOD = 1 * MiB;
constexpr size_t WS_LAM = 1 * MiB + 512 * 1024;
constexpr size_t WS_ROPE = 1 * MiB + 768 * 1024;
constexpr int CW_KMAX = 2048;
constexpr size_t WS_AGG = 2 * MiB;
constexpr size_t WS_ASG = 5 * MiB;
constexpr size_t WS_EW = 6 * MiB;
constexpr size_t WS_WIN = 8 * MiB;
constexpr size_t WS_WOUT = 28 * MiB;
constexpr size_t WS_RGW = 36 * MiB;
constexpr size_t WS_W1 = 40 * MiB;
constexpr size_t WS_W3 = 168 * MiB;
constexpr size_t WS_W2 = 296 * MiB;
constexpr size_t WS_XL = 424 * MiB;
constexpr size_t WS_HL = 490 * MiB;
constexpr size_t WS_QA = 523 * MiB;
constexpr size_t WS_KA = 532 * MiB;
constexpr size_t WS_VAT = 541 * MiB;
constexpr size_t WS_QD = 550 * MiB;
constexpr size_t WS_KD = 559 * MiB;
constexpr size_t WS_VDT = 568 * MiB;
constexpr size_t WS_XR = 577 * MiB;
constexpr size_t WS_GG = 594 * MiB;
constexpr size_t WS_RGA = 611 * MiB;
constexpr size_t WS_MIX = 743 * MiB;
constexpr size_t WS_XG = 776 * MiB;
constexpr size_t WS_ACT = 858 * MiB;
constexpr size_t WS_YB = 899 * MiB;
constexpr size_t WS_END = 981 * MiB;
constexpr int CW_POOL = 3000;
constexpr int CW_TMAP = 8192;
constexpr int CW_OWNER = 20480;
constexpr int MAXTILES = 164;
constexpr int CW_D5 = 21504;
constexpr int CW_RLIST = 65536;
constexpr int CW_D7 = 22528;

constexpr int LDS_BYTES = 147456;
constexpr int MISC_OFF = LDS_BYTES - 1024;

struct Params {
    const float* in[28];
    float* out;
    unsigned char* ws;
};
typedef __attribute__((address_space(4))) const Params* KP;
enum { I_X = 0, I_C, I_CTX, I_CCTX, I_WADA, I_BADA, I_GMIX, I_GFFN, I_WIN, I_WOUT, I_RPB, I_CONVW, I_CONVB, I_RGWR, I_RGBR, I_RGWI, I_RGBI, I_RGLAM,
       I_DLAM, I_DSUBG, I_RWG, I_RBG, I_RWE, I_RBE, I_W1, I_W3, I_W2, I_GFINAL };

__device__ __forceinline__ unsigned pkh(float a, float b) { h16x2 v = {(h16)a, (h16)b}; return __builtin_bit_cast(unsigned, v); }
__device__ __forceinline__ float wave_sum(float v) {
#pragma unroll
    for (int o = 1; o < 64; o <<= 1) v += __shfl_xor(v, o);
    return v;
}
__device__ __forceinline__ float xhalf_max(float m) { auto rr = __builtin_amdgcn_permlane32_swap(__float_as_uint(m), __float_as_uint(m), false, false); return fmaxf(__uint_as_float(rr[0]), __uint_as_float(rr[1])); }
__device__ __forceinline__ float xhalf_sum(float m) { auto rr = __builtin_amdgcn_permlane32_swap(__float_as_uint(m), __float_as_uint(m), false, false); return __uint_as_float(rr[0]) + __uint_as_float(rr[1]); }
__device__ __forceinline__ float fexp_(float x) { return __builtin_amdgcn_exp2f(x * LOG2E); }
__device__ __forceinline__ float frcp_(float x) { return __builtin_amdgcn_rcpf(x); }
__device__ __forceinline__ float sigmoidf_(float x) { return frcp_(1.f + fexp_(-x)); }
__device__ __forceinline__ float gelu_tanh(float x) { const float u = 0.7978845608028654f * (x + 0.044715f * x * x * x); return x * frcp_(1.f + fexp_(-2.f * u)); }
__device__ __forceinline__ int crow(int r, int hi) { return (r & 3) + 8 * (r >> 2) + 4 * hi; }
#define LDS_WAIT() asm volatile("s_waitcnt lgkmcnt(0)" ::: "memory")
__device__ __forceinline__ void lds_barrier() { asm volatile("s_waitcnt lgkmcnt(0)\n\ts_barrier" ::: "memory"); }
__device__ __forceinline__ int tid_now() { int t = threadIdx.x; asm volatile("" : "+v"(t)); return t; }

#define XB_TMO      128
#define XB_XCNT(j)  (256  + 64 * (j))
#define XB_XSUB(j)  (1280 + 64 * (j))
#define XB_XGEN(j)  (2304 + 64 * (j))
#define XB_TOP      3328
#define XB_TOPGEN   3392
#define XB_SPIN_CAP (1u << 22)
__device__ __forceinline__ unsigned xb_ld(unsigned* p)              { return __hip_atomic_load(p, __ATOMIC_RELAXED, __HIP_MEMORY_SCOPE_AGENT); }
__device__ __forceinline__ unsigned xb_add(unsigned* p, unsigned v) { return __hip_atomic_fetch_add(p, v, __ATOMIC_RELAXED, __HIP_MEMORY_SCOPE_AGENT); }
__device__ __forceinline__ unsigned xb_xcc_id() { return (unsigned)__builtin_amdgcn_s_getreg((3 << 11) | 20) & 0xFu; }
#define XB_SPIN(cond, bar) do { unsigned _sp = 0; while (cond) { __builtin_amdgcn_s_sleep(1); \
    if ((++_sp & 255u) == 0u) { if (xb_ld(&(bar)[XB_TMO])) break; if (_sp > XB_SPIN_CAP) { atomicAdd(&(bar)[XB_TMO], 1u); break; } } } } while (0)
struct XcdBarrier { unsigned* bar; unsigned x; volatile LAS unsigned* st; };
__device__ __forceinline__ XcdBarrier xcd_barrier_post(unsigned* bar, volatile LAS unsigned* st) {
    XcdBarrier b; b.bar = bar; b.x = xb_xcc_id(); b.st = st;
    if (threadIdx.x == 0) (void)xb_add(&bar[XB_XCNT(b.x)], 1u);
    return b;
}
__device__ __forceinline__ void xcd_barrier_complete(unsigned* bar, unsigned x, unsigned& nloc, unsigned& nx) {
    const unsigned G = gridDim.x * gridDim.y * gridDim.z;
    unsigned sum, cnt, mine, sp = 0u;
    for (;;) {
        sum = 0u; cnt = 0u; mine = 0u;
#pragma unroll 1
        for (unsigned j = 0; j < 16; ++j) { const unsigned c = xb_ld(&bar[XB_XCNT(j)]); sum += c; cnt += (c > 0u) ? 1u : 0u; mine = (j == x) ? c : mine; }
        if (sum == G) break;
        __builtin_amdgcn_s_sleep(1);
        if ((++sp & 255u) == 0u) { if (xb_ld(&bar[XB_TMO])) break; if (sp > XB_SPIN_CAP) { atomicAdd(&bar[XB_TMO], 1u); break; } }
    }
    nloc = mine > 0u ? mine : 1u; nx = cnt > 0u ? cnt : 1u;
}
__device__ __forceinline__ void xcd_barrier(const XcdBarrier& b) {
    asm volatile("s_waitcnt vmcnt(0)" ::: "memory");
    __syncthreads();
    if (threadIdx.x == 0) {
        unsigned* bar = b.bar;
        __builtin_amdgcn_s_waitcnt(0);
        const unsigned nloc = b.st[0], nx = b.st[1];
        const unsigned old = xb_add(&bar[XB_XSUB(b.x)], 1u);
        const unsigned gen = old / nloc;
        if (old + 1u == (gen + 1u) * nloc) {
            __builtin_amdgcn_fence(__ATOMIC_RELEASE, "agent");
            asm volatile("s_waitcnt vmcnt(0)" ::: "memory");
            const unsigned og = xb_add(&bar[XB_TOP], 1u);
            const unsigned tg = og / nx;
            if (og + 1u == (tg + 1u) * nx) xb_add(&bar[XB_TOPGEN], 1u);
            else XB_SPIN(xb_ld(&bar[XB_TOPGEN]) == tg, bar);
            __builtin_amdgcn_fence(__ATOMIC_ACQUIRE, "agent");
            xb_add(&bar[XB_XGEN(b.x)], 1u);
            asm volatile("s_waitcnt vmcnt(0)" ::: "memory");
        } else {
            XB_SPIN(xb_ld(&bar[XB_XGEN(b.x)]) == gen, bar);
            __builtin_amdgcn_fence(__ATOMIC_ACQUIRE, "agent");
            asm volatile("s_waitcnt vmcnt(0)" ::: "memory");
        }
    }
    __syncthreads();
}

__device__ __forceinline__ void unit_publish(unsigned* ctr) {
    asm volatile("s_waitcnt vmcnt(0)" ::: "memory");
    __builtin_amdgcn_s_barrier();
    if (threadIdx.x == 0) { __builtin_amdgcn_fence(__ATOMIC_RELEASE, "agent"); asm volatile("s_waitcnt vmcnt(0)" ::: "memory"); __hip_atomic_fetch_add(ctr, 1u, __ATOMIC_RELAXED, __HIP_MEMORY_SCOPE_AGENT); }
}
__device__ __forceinline__ void unit_wait(const unsigned* ctr, unsigned need) {
    if (threadIdx.x < 64) {
        unsigned spins = 0;
        while ((unsigned)__builtin_amdgcn_readfirstlane(__hip_atomic_load(ctr, __ATOMIC_RELAXED, __HIP_MEMORY_SCOPE_AGENT)) < need) { __builtin_amdgcn_s_sleep(2); if (++spins > (1u << 24)) break; }
        __builtin_amdgcn_fence(__ATOMIC_ACQUIRE, "agent");
        asm volatile("s_waitcnt vmcnt(0)" ::: "memory");
    }
    asm volatile("" ::: "memory"); __builtin_amdgcn_s_barrier(); asm volatile("" ::: "memory");
}

namespace pg8 {
constexpr int BM = 256, BK = 64, HALF = 128, HTB = HALF * BK * 2, STAGE_BYTES = 8 * HTB, NXCD = 8, WGM = 8;
__device__ __forceinline__ int lds_byte(int r, int c) { const int st = (r >> 4) * 2 + (c >> 5), rr = r & 15, cc = c & 31, ob = rr * 64 + cc * 2; return st * 1024 + (ob ^ (((ob >> 9) & 1) << 5)); }
__device__ __forceinline__ void stage_rc(int b, int& R, int& C) { const int st = b / 1024, sb = b % 1024, swz = sb ^ (((sb >> 9) & 1) << 5); R = (st >> 1) * 16 + swz / 64; C = (st & 1) * 32 + (swz % 64) / 2; }
__device__ __forceinline__ int perm32(int rho) { const int n = rho >> 4, i = rho & 15; return 8 * (i >> 2) + 4 * n + (i & 3); }

struct Unit { const char* A0; const char* A1; const char* B0; const char* B1; int pm, pn; };

struct DenseSched {
    const char* A; const char* Bt; int K, nM, nN, nwg, G, c; unsigned* done_ctr;
    __device__ __forceinline__ void init(const void* A_, const void* Bt_, int M, int N, int K_, int G_, int c_, unsigned* done_ = nullptr) { A = (const char*)A_; Bt = (const char*)Bt_; K = K_; nM = M / BM; nN = N / BM; nwg = nM * nN; G = G_; c = c_; done_ctr = done_; }
    __device__ __forceinline__ void a_ready(const Unit&) const {}
    __device__ __forceinline__ void done(const Unit& u) const { if (done_ctr) unit_publish(done_ctr + u.pm); }
    __device__ __forceinline__ bool next(int i, Unit& u) const {
        const long L = (long)i * G + c; if (L >= nwg) return false;
        int wgid = (int)L; { const int q = nwg / NXCD, r = nwg % NXCD, xcd = wgid % NXCD, off = wgid / NXCD; wgid = (xcd < r ? xcd * (q + 1) : r * (q + 1) + (xcd - r) * q) + off; }
        const int nig = WGM * nN, gid = wgid / nig, fm = gid * WGM, gsz = (nM - fm) < WGM ? (nM - fm) : WGM;
        u.pm = fm + ((wgid % nig) % gsz); u.pn = (wgid % nig) / gsz;
        const size_t hstep = (size_t)HALF * K * 2;
        u.A0 = A + (size_t)u.pm * 2 * hstep; u.A1 = u.A0 + hstep; u.B0 = Bt + (size_t)u.pn * 2 * hstep; u.B1 = u.B0 + hstep;
        return true;
    }
};

template <class Epi, class Sched, bool GATHER = false>
__device__ __forceinline__ void gemm_phase(LAS unsigned char* lds, const int K, const Sched& S, const Epi& E, const char* gbase = nullptr, const int pitch_ = 0) {
    const int pitch = pitch_ ? pitch_ : K;
    const int tid = tid_now(), wid = __builtin_amdgcn_readfirstlane(tid >> 6), lane = tid & 63, wr = wid >> 2, wc = wid & 3, fr = lane & 15, fq = lane >> 4;
    const int nt = K / BK;
    unsigned voffA[2], voffB[2];
#pragma unroll
    for (int i = 0; i < 2; ++i) { int R, C; stage_rc(tid * 16 + i * 8192, R, C); const int Rb = (R & ~31) + perm32(R & 31);
        voffA[i] = (unsigned)(R * pitch + C) * 2u; voffB[i] = (unsigned)(Rb * pitch + C) * 2u; }
    const size_t kstep = (size_t)(BK * 2);
    const unsigned ldsw = (unsigned)wid * 1024u;
    unsigned cv0[2] = {0u, 0u}, cv1[2] = {0u, 0u}, nv0[2] = {0u, 0u}, nv1[2] = {0u, 0u};
#define PG8_GOFF(v0_, v1_, listp) do { const int* rl_ = (const int*)(listp); _Pragma("unroll") for (int i_ = 0; i_ < 2; ++i_) { int R_, C_; stage_rc(tid * 16 + i_ * 8192, R_, C_); \
        v0_[i_] = (unsigned)rl_[R_] * (unsigned)(K * 2) + (unsigned)(C_ * 2); v1_[i_] = (unsigned)rl_[128 + R_] * (unsigned)(K * 2) + (unsigned)(C_ * 2); } } while (0)
#define PG8_STAGE2(bufoff, gb, va, vb, sel) do { _Pragma("unroll") for (int _i = 0; _i < 2; ++_i) \
        __builtin_amdgcn_global_load_lds((const unsigned*)((const char*)(gb) + ((sel) ? (vb)[_i] : (va)[_i])), (LAS unsigned*)(lds + (bufoff) + ldsw + _i * 8192), 16, 0, 0); } while (0)
    const int aoff = lds_byte(wr * 64 + fr, fq * 8), boff = lds_byte(wc * 32 + fr, fq * 8);
#define PG8_SA(b, h) (((b) * 2 + (h)) * HTB)
#define PG8_SB(b, h) ((4 + (b) * 2 + (h)) * HTB)
#define PG8_STAGE(bufoff, gbase, voff) do { _Pragma("unroll") for (int _i = 0; _i < 2; ++_i) \
        __builtin_amdgcn_global_load_lds((const unsigned*)((const char*)(gbase) + (voff)[_i]), (LAS unsigned*)(lds + (bufoff) + ldsw + _i * 8192), 16, 0, 0); } while (0)
#define PG8_LDA(dst, b, h) do { _Pragma("unroll") for (int m = 0; m < 4; ++m) _Pragma("unroll") for (int k = 0; k < 2; ++k) dst[m][k] = *(const LAS h16x8*)(lds + PG8_SA(b, h) + aoff + m * 2048 + k * 1024); } while (0)
#define PG8_LDB(dst, b, h) do { _Pragma("unroll") for (int n = 0; n < 2; ++n) _Pragma("unroll") for (int k = 0; k < 2; ++k) dst[n][k] = *(const LAS h16x8*)(lds + PG8_SB(b, h) + boff + n * 2048 + k * 1024); } while (0)
#define PG8_MMA(ai, bj, At, Bt) do { __builtin_amdgcn_s_setprio(1); _Pragma("unroll") for (int m = 0; m < 4; ++m) _Pragma("unroll") for (int n = 0; n < 2; ++n) _Pragma("unroll") for (int k = 0; k < 2; ++k) \
        acc[ai][bj][m][n] = __builtin_amdgcn_mfma_f32_16x16x32_f16(Bt[n][k], At[m][k], acc[ai][bj][m][n], 0, 0, 0); __builtin_amdgcn_s_setprio(0); } while (0)
#define PG8_WAIT_V(n) asm volatile("s_waitcnt vmcnt(" #n ")" ::: "memory")
#define PG8_WAIT_L(n) asm volatile("s_waitcnt lgkmcnt(" #n ")" ::: "memory")
#define PG8_BAR __builtin_amdgcn_s_barrier()
#define PG8_SCHED __builtin_amdgcn_sched_barrier(0)
    Unit cur, nxt; int ui = 0;
    if (!S.next(0, cur)) return;
    f32x4 acc[2][2][4][2];
#pragma unroll
    for (int a = 0; a < 2; ++a)
#pragma unroll
        for (int b = 0; b < 2; ++b)
#pragma unroll
            for (int m = 0; m < 4; ++m)
#pragma unroll
                for (int n = 0; n < 2; ++n) acc[a][b][m][n] = (f32x4){0.f, 0.f, 0.f, 0.f};
    h16x8 At[4][2], B0[2][2], B1[2][2];
    const char* cA0 = cur.A0; const char* cA1 = cur.A1; const char* cB0 = cur.B0; const char* cB1 = cur.B1;
    S.a_ready(cur);
    if constexpr (GATHER) { PG8_GOFF(cv0, cv1, cur.A0); }
    PG8_STAGE(PG8_SB(0, 0), cB0, voffB); PG8_STAGE(PG8_SB(0, 1), cB1, voffB);
    if constexpr (GATHER) { PG8_STAGE2(PG8_SA(0, 0), gbase, cv0, cv0, false); PG8_STAGE2(PG8_SA(0, 1), gbase, cv1, cv1, false); }
    else { PG8_STAGE(PG8_SA(0, 0), cA0, voffA); PG8_STAGE(PG8_SA(0, 1), cA1, voffA); }
    if (wr == 1) PG8_BAR;
    PG8_WAIT_V(2); PG8_BAR;
    PG8_STAGE(PG8_SB(1, 0), cB0 + kstep, voffB);
    if constexpr (GATHER) { PG8_STAGE2(PG8_SA(1, 0), gbase + kstep, cv0, cv0, false); } else { PG8_STAGE(PG8_SA(1, 0), cA0 + kstep, voffA); }
    PG8_STAGE(PG8_SB(1, 1), cB1 + kstep, voffB);
    PG8_WAIT_V(6); PG8_BAR;
    for (;;) {
        const bool has_next = S.next(ui + 1, nxt);
        const char* nA0 = has_next ? nxt.A0 : cA0; const char* nA1 = has_next ? nxt.A1 : cA1;
        const char* nB0 = has_next ? nxt.B0 : cB0; const char* nB1 = has_next ? nxt.B1 : cB1;
        for (int t = 0; t < nt; t += 2) {
            const bool last = (t == nt - 2);
            if (last && has_next) S.a_ready(nxt);
            if constexpr (GATHER) { if (last) { if (has_next) { PG8_GOFF(nv0, nv1, nxt.A0); } else { nv0[0] = cv0[0]; nv0[1] = cv0[1]; nv1[0] = cv1[0]; nv1[1] = cv1[1]; } } }
            const char* g1 = gbase + (size_t)(t + 1) * kstep; const char* g2 = gbase + (last ? (size_t)0 : (size_t)(t + 2) * kstep); const char* g3 = g2 + kstep;
            const char* a1_1 = cA1 + (size_t)(t + 1) * kstep;
            const char* a2_0 = last ? nA0 : cA0 + (size_t)(t + 2) * kstep; const char* a2_1 = last ? nA1 : cA1 + (size_t)(t + 2) * kstep;
            const char* b2_0 = last ? nB0 : cB0 + (size_t)(t + 2) * kstep; const char* b2_1 = last ? nB1 : cB1 + (size_t)(t + 2) * kstep;
            const char* a3_0 = a2_0 + kstep; const char* b3_0 = b2_0 + kstep; const char* b3_1 = b2_1 + kstep;
            PG8_LDB(B0, 0, 0); PG8_LDB(B1, 0, 1); PG8_SCHED; PG8_LDA(At, 0, 0); if constexpr (GATHER) { PG8_STAGE2(PG8_SA(1, 1), g1, cv1, cv1, false); } else { PG8_STAGE(PG8_SA(1, 1), a1_1, voffA); }
            PG8_WAIT_V(8); PG8_WAIT_L(0); PG8_BAR; PG8_MMA(0, 0, At, B0); PG8_MMA(0, 1, At, B1); PG8_BAR; PG8_SCHED;
            PG8_LDA(At, 0, 1); PG8_STAGE(PG8_SB(0, 0), b2_0, voffB); PG8_STAGE(PG8_SB(0, 1), b2_1, voffB); if constexpr (GATHER) { PG8_STAGE2(PG8_SA(0, 0), g2, cv0, nv0, last); } else { PG8_STAGE(PG8_SA(0, 0), a2_0, voffA); }
            PG8_WAIT_V(8); PG8_WAIT_L(0); PG8_BAR; PG8_MMA(1, 0, At, B0); PG8_MMA(1, 1, At, B1); PG8_BAR; PG8_SCHED;
            PG8_LDB(B0, 1, 0); PG8_LDB(B1, 1, 1); PG8_SCHED; PG8_LDA(At, 1, 0); if constexpr (GATHER) { PG8_STAGE2(PG8_SA(0, 1), g2, cv1, nv1, last); } else { PG8_STAGE(PG8_SA(0, 1), a2_1, voffA); }
            PG8_WAIT_V(8); PG8_WAIT_L(0); PG8_BAR; PG8_MMA(0, 0, At, B0); PG8_MMA(0, 1, At, B1); PG8_BAR; PG8_SCHED;
            PG8_LDA(At, 1, 1); PG8_STAGE(PG8_SB(1, 0), b3_0, voffB); PG8_STAGE(PG8_SB(1, 1), b3_1, voffB); if constexpr (GATHER) { PG8_STAGE2(PG8_SA(1, 0), g3, cv0, nv0, last); } else { PG8_STAGE(PG8_SA(1, 0), a3_0, voffA); }
            PG8_WAIT_V(8); PG8_WAIT_L(0); PG8_BAR; PG8_MMA(1, 0, At, B0); PG8_MMA(1, 1, At, B1); PG8_BAR; PG8_SCHED;
        }
        if (wr == 0) PG8_BAR;
        E(acc, cur, wr, wc, fr, fq);
        S.done(cur);
        if (!has_next) break;
#pragma unroll
        for (int a = 0; a < 2; ++a)
#pragma unroll
            for (int b = 0; b < 2; ++b)
#pragma unroll
                for (int m = 0; m < 4; ++m)
#pragma unroll
                    for (int n = 0; n < 2; ++n) acc[a][b][m][n] = (f32x4){0.f, 0.f, 0.f, 0.f};
        cur = nxt; cA0 = nA0; cA1 = nA1; cB0 = nB0; cB1 = nB1; ++ui;
        if constexpr (GATHER) { cv0[0] = nv0[0]; cv0[1] = nv0[1]; cv1[0] = nv1[0]; cv1[1] = nv1[1]; }
        if (wr == 1) PG8_BAR;
    }
    PG8_WAIT_V(0);
    PG8_BAR;
#undef PG8_SA
#undef PG8_SB
#undef PG8_STAGE
#undef PG8_STAGE2
#undef PG8_GOFF
#undef PG8_LDA
#undef PG8_LDB
#undef PG8_MMA
#undef PG8_WAIT_V
#undef PG8_WAIT_L
#undef PG8_BAR
#undef PG8_SCHED
}
}
using pg8::Unit;
typedef f32x4 AccT[2][2][4][2];

struct EpiInProj {
    h16 *qa, *ka, *vat, *xr, *gg, *qd, *kd, *vdt; const f32x2* rope; unsigned* kmax; LAS unsigned char* scr;
    __device__ __forceinline__ void operator()(const AccT& acc, const Unit& u, int wr, int wc, int fr, int fq) const {
        const int pn = u.pn;
        const bool isctx = (u.pm >= NLAT / 256);
        const float QSA = 0.125f * LOG2E, QSD = 0.17677669529663687f * LOG2E;
        float kn2[2] = {0.f, 0.f};
        if (pn == 2 || pn == 9) {
            h16* const vbase = (pn == 2 ? vat : vdt);
            LAS unsigned char* const sw = scr + (wr * 4 + wc) * 1536;
            const int lane = fq * 16 + fr;
#pragma unroll
            for (int ai = 0; ai < 2; ++ai)
#pragma unroll
                for (int m = 0; m < 4; ++m) {
                    const int row0 = u.pm * 256 + ai * 128 + wr * 64 + m * 16;
                    int b, key0;
                    if (isctx) { const int c = row0 - NLAT; b = c >> 8; key0 = SEQ + (c & 255); } else { b = row0 >> 13; key0 = row0 & (SEQ - 1); }
#pragma unroll
                    for (int bj = 0; bj < 2; ++bj) {
#pragma unroll
                        for (int j = 0; j < 8; ++j) *(LAS h16*)(sw + (fq * 8 + j) * 48 + fr * 2) = (h16)acc[ai][bj][m][j >> 2][j & 3];
                        asm volatile("s_waitcnt lgkmcnt(0)" ::: "memory");
                        const u32x4 w = *(const LAS u32x4*)(sw + (lane >> 1) * 48 + (lane & 1) * 16);
                        asm volatile("s_waitcnt lgkmcnt(0)" ::: "memory");
                        *(u32x4*)(vbase + ((size_t)(b * 256 + bj * 128 + wc * 32 + (lane >> 1))) * KEYS + key0 + (lane & 1) * 8) = w;
                    }
                }
            return;
        }
#pragma unroll
        for (int ai = 0; ai < 2; ++ai)
#pragma unroll
            for (int m = 0; m < 4; ++m) {
                const int row = u.pm * 256 + ai * 128 + wr * 64 + m * 16 + fr;
                int b, key, t;
                if (isctx) { const int c = row - NLAT; b = c >> 8; t = c & 255; key = SEQ + t; } else { b = row >> 13; t = row & (SEQ - 1); key = t; }
#pragma unroll
                for (int bj = 0; bj < 2; ++bj) {
                    const int col = bj * 128 + wc * 32 + 8 * fq;
                    float v[8];
#pragma unroll
                    for (int j = 0; j < 4; ++j) { v[j] = acc[ai][bj][m][0][j]; v[4 + j] = acc[ai][bj][m][1][j]; }
                    if (pn == 7 || pn == 8) {
                        float pr[8];
#pragma unroll
                        for (int j = 0; j < 8; ++j) pr[j] = __shfl_xor(v[j], 16);
                        if (!isctx) {
                            const int pos = (fq < 2) ? (t >> 6) : (t & 63);
                            const f32x2* tb = rope + pos * 8;
#pragma unroll
                            for (int j = 0; j < 8; ++j) { const f32x2 cs = tb[j]; const float sn = (fq & 1) ? cs.y : -cs.y; v[j] = v[j] * cs.x + pr[j] * sn; }
                        }
                        if (pn == 8) { float ss = 0.f;
#pragma unroll
                            for (int j = 0; j < 8; ++j) ss += v[j] * v[j];
                            kn2[bj] = fmaxf(kn2[bj], ss); }
                    }
                    {
                        h16* dst; float sc = 1.f;
                        if (pn == 0) { dst = qa + (size_t)row * 256 + col; sc = QSA; }
                        else if (pn == 1) { dst = ka + ((size_t)(b * KEYS + key)) * 256 + col; }
                        else if (pn == 3 || pn == 4) { dst = xr + (size_t)row * 512 + (pn - 3) * 256 + col; }
                        else if (pn == 5 || pn == 6) { dst = gg + (size_t)row * 512 + (pn - 5) * 256 + col;
#pragma unroll
                            for (int j = 0; j < 8; ++j) v[j] = gelu_tanh(v[j]); }
                        else if (pn == 7) { dst = qd + (size_t)row * 256 + col; sc = QSD; }
                        else { dst = kd + ((size_t)(b * KEYS + key)) * 256 + col; }
                        u32x4 w; w.x = pkh(v[0] * sc, v[1] * sc); w.y = pkh(v[2] * sc, v[3] * sc); w.z = pkh(v[4] * sc, v[5] * sc); w.w = pkh(v[6] * sc, v[7] * sc);
                        *(u32x4*)dst = w;
                    }
                }
            }
        if (pn == 8) {
            const int b = isctx ? (u.pm - NLAT / 256) : (u.pm >> 5);
#pragma unroll
            for (int bj = 0; bj < 2; ++bj) {
                float ss = kn2[bj]; ss += __shfl_xor(ss, 16); ss += __shfl_xor(ss, 32);
#pragma unroll
                for (int o = 1; o < 16; o <<= 1) ss = fmaxf(ss, __shfl_xor(ss, o));
                if ((fr | fq) == 0) atomicMax(kmax + (b * 4 + 2 * bj + (wc >> 1)) * 2 + (wc & 1), __float_as_uint(ss));
            }
        }
    }
};

struct EpiOutProj {
    float* xl; const float* mod; float* xo;
    __device__ __forceinline__ void operator()(const AccT& acc, const Unit& u, int wr, int wc, int fr, int fq) const {
        const int vsel = (u.pm >= NLAT / 256) ? 2 : (u.pm >= NLAT / 512 ? 1 : 0);
        const float* ga = mod + vsel * 6144 + 2 * 1024;
#pragma unroll
        for (int bj = 0; bj < 2; ++bj) {
            const int col = u.pn * 256 + bj * 128 + wc * 32 + 8 * fq;
            const f32x4 g0 = *(const f32x4*)(ga + col), g1 = *(const f32x4*)(ga + col + 4);
#pragma unroll
            for (int ai = 0; ai < 2; ++ai)
#pragma unroll
                for (int m = 0; m < 4; ++m) {
                    const int row = u.pm * 256 + ai * 128 + wr * 64 + m * 16 + fr;
                    const float* p = xl + (size_t)row * D + col; float* q = xo + (size_t)row * D + col;
                    f32x4 x0 = *(const f32x4*)p, x1 = *(const f32x4*)(p + 4);
                    x0 += g0 * acc[ai][bj][m][0]; x1 += g1 * acc[ai][bj][m][1];
                    *(f32x4*)q = x0; *(f32x4*)(q + 4) = x1;
                }
        }
    }
};

struct CtxSplitSched {
    const char* mix; const char* wt; int q; unsigned* done_ctr;
    __device__ __forceinline__ void a_ready(const Unit&) const {}
    __device__ __forceinline__ void done(const Unit& u) const { unit_publish(done_ctr + u.pm); }
    __device__ __forceinline__ bool next(int i, Unit& u) const {
        if (i != 0 || q < 0) return false;
        const int pm = NLAT / 256 + (q >> 4), pn = (q >> 2) & 3, kq = q & 3;
        u.pm = pm; u.pn = pn | (kq << 8);
        u.A0 = mix + (size_t)pm * 256 * 2048 + kq * 512; u.A1 = u.A0 + (size_t)128 * 2048;
        u.B0 = wt + (size_t)pn * 256 * 2048 + kq * 512; u.B1 = u.B0 + (size_t)128 * 2048;
        return true;
    }
};
struct EpiOutPart {
    float* part; const float* mod;
    __device__ __forceinline__ void operator()(const AccT& acc, const Unit& u, int wr, int wc, int fr, int fq) const {
        const int pn = u.pn & 255, kq = u.pn >> 8;
        const float* ga = mod + 2 * 6144 + 2 * 1024;
#pragma unroll
        for (int bj = 0; bj < 2; ++bj) {
            const int col = pn * 256 + bj * 128 + wc * 32 + 8 * fq;
            const f32x4 g0 = *(const f32x4*)(ga + col), g1 = *(const f32x4*)(ga + col + 4);
#pragma unroll
            for (int ai = 0; ai < 2; ++ai)
#pragma unroll
                for (int m = 0; m < 4; ++m) {
                    const int crow_ = (u.pm - NLAT / 256) * 256 + ai * 128 + wr * 64 + m * 16 + fr;
                    float* q_ = part + ((size_t)kq * NCTX + crow_) * D + col;
                    *(f32x4*)q_ = g0 * acc[ai][bj][m][0]; *(f32x4*)(q_ + 4) = g1 * acc[ai][bj][m][1];
                }
        }
    }
};

struct MoeSched1 {
    const char* xg; const char* w1t; const char* w3t; const unsigned* tmap; volatile LAS int* tab; int ntiles, G, c; unsigned* done7;
    __device__ __forceinline__ void a_ready(const Unit&) const {}
    __device__ __forceinline__ void done(const Unit& u) const { unit_publish(done7 + u.pm); }
    __device__ __forceinline__ bool next(int i, Unit& u) const {
        const int L = i * G + c; if (L >= ntiles * 4) return false;
        const int Ts = L >> 2, pn = L & 3; int e = 0;
        for (int j = 1; j < NEXP; ++j) e += (tab[j] <= Ts) ? 1 : 0;
        e = __builtin_amdgcn_readfirstlane(e);
        const int T = __builtin_amdgcn_readfirstlane((int)tmap[e * 72 + (Ts - tab[e])] - 1);
        u.pm = T; u.pn = pn;
        u.A0 = xg + (size_t)T * 256 * 4; u.A1 = u.A0;
        const size_t wo = ((size_t)e * DEXP + (size_t)pn * 128) * 2048;
        u.B0 = w1t + wo; u.B1 = w3t + wo;
        return true;
    }
};
struct MoeSched2 {
    const char* act; const char* w2t; const unsigned* tmap; volatile LAS int* tab; int ntiles, G, c; const unsigned* done7; int start, cnt, rest;
    __device__ __forceinline__ void a_ready(const Unit& u) const { unit_wait(done7 + u.pm, 4u); }
    __device__ __forceinline__ void done(const Unit&) const {}
    __device__ __forceinline__ void plan() {
        const int n = ntiles * 4;
        const int base = n / G, r = n - base * G;
        const int T3 = 3 * n;
        int bhi = (T3 / G) - 2 * (base + 1); if (bhi < 0) bhi = 0;
        int blo = (T3 / G) - 2 * base; if (blo < 0) blo = 0;
        long tot = (long)r * bhi + (long)(G - r) * blo;
        if (tot > n) { blo = (int)((n - (long)r * bhi) / (G - r)); if (blo < 0) { blo = 0; bhi = n / (r > 0 ? r : 1); } tot = (long)r * bhi + (long)(G - r) * blo; if (tot > n) { bhi = 0; blo = n / G; tot = (long)G * blo; } }
        start = (c < r) ? c * bhi : r * bhi + (c - r) * blo; cnt = (c < r) ? bhi : blo; rest = (int)tot;
    }
    __device__ __forceinline__ bool next(int i, Unit& u) const {
        int L;
        if (i < cnt) L = start + i; else { L = rest + (i - cnt) * G + c; }
        if (L >= ntiles * 4) return false;
        const int Ts = L >> 2, pn = L & 3; int e = 0;
        for (int j = 1; j < NEXP; ++j) e += (tab[j] <= Ts) ? 1 : 0;
        e = __builtin_amdgcn_readfirstlane(e);
        const int T = __builtin_amdgcn_readfirstlane((int)tmap[e * 72 + (Ts - tab[e])] - 1);
        u.pm = T; u.pn = pn;
        u.A0 = act + (size_t)T * 256 * 1024; u.A1 = u.A0 + (size_t)128 * 1024;
        u.B0 = w2t + ((size_t)e * D + (size_t)pn * 256) * 1024; u.B1 = u.B0 + (size_t)128 * 1024;
        return true;
    }
};
struct EpiMoe1 {
    h16* act;
    __device__ __forceinline__ void operator()(const AccT& acc, const Unit& u, int wr, int wc, int fr, int fq) const {
#pragma unroll
        for (int ai = 0; ai < 2; ++ai)
#pragma unroll
            for (int m = 0; m < 4; ++m) {
                const int row = u.pm * 256 + ai * 128 + wr * 64 + m * 16 + fr;
                float v[8];
#pragma unroll
                for (int n = 0; n < 2; ++n)
#pragma unroll
                    for (int j = 0; j < 4; ++j) { const float a = acc[ai][0][m][n][j], b = acc[ai][1][m][n][j]; v[4 * n + j] = a * frcp_(1.f + fexp_(-a)) * b; }
                u32x4 w; w.x = pkh(v[0], v[1]); w.y = pkh(v[2], v[3]); w.z = pkh(v[4], v[5]); w.w = pkh(v[6], v[7]);
                *(u32x4*)(act + (size_t)row * DEXP + u.pn * 128 + wc * 32 + 8 * fq) = w;
            }
    }
};
struct EpiMoe2 {
    h16* yb;
    __device__ __forceinline__ void operator()(const AccT& acc, const Unit& u, int wr, int wc, int fr, int fq) const {
#pragma unroll
        for (int ai = 0; ai < 2; ++ai)
#pragma unroll
            for (int m = 0; m < 4; ++m) {
                const int row = u.pm * 256 + ai * 128 + wr * 64 + m * 16 + fr;
#pragma unroll
                for (int bj = 0; bj < 2; ++bj) {
                    const f32x4 v0 = acc[ai][bj][m][0], v1 = acc[ai][bj][m][1];
                    u32x4 w; w.x = pkh(v0[0], v0[1]); w.y = pkh(v0[2], v0[3]); w.z = pkh(v1[0], v1[1]); w.w = pkh(v1[2], v1[3]);
                    *(u32x4*)(yb + (size_t)row * D + u.pn * 256 + bj * 128 + wc * 32 + 8 * fq) = w;
                }
            }
    }
};

__device__ __forceinline__ void p0_transpose_item(const float* W, int K, int N, h16* WT, LAS h16* scr, int item, int lane) {
    const int nblk = N / 64, kb = item / nblk, nb = item % nblk, k0 = 64 * kb, n0 = 64 * nb;
    const float* src = W + (size_t)k0 * N + n0 + lane;
#pragma unroll 32
    for (int i = 0; i < 64; ++i) scr[i * 66 + lane] = (h16)src[(size_t)i * N];
    LDS_WAIT(); asm volatile("" ::: "memory");
    const int c = lane & 7;
#pragma unroll
    for (int j = 0; j < 8; ++j) { const int n = (lane >> 3) + 8 * j; const LAS h16* s = scr + (8 * c) * 66 + n;
        h16x8 o;
#pragma unroll
        for (int t = 0; t < 8; ++t) o[t] = s[t * 66];
        *(h16x8*)(WT + (size_t)(n0 + n) * K + k0 + 8 * c) = o; }
    LDS_WAIT(); asm volatile("" ::: "memory");
}

__device__ __forceinline__ void phase_p0(KP p, LAS unsigned char* lds, int vcu, int G) {
    const int tid = tid_now(), lane = tid & 63, wave = __builtin_amdgcn_readfirstlane(tid >> 6);
    unsigned char* ws = p->ws;
    LAS float* sc = (LAS float*)lds;
    LAS float* red = (LAS float*)(lds + 12288);
    for (int i = tid; i < 3 * 1024; i += NTHREADS) { const float x = (i < 2048) ? p->in[I_C][i] : p->in[I_CCTX][i - 2048]; sc[i] = x / (1.f + __expf(-x)); }
    __syncthreads();
    float* mod = (float*)(ws + WS_MOD);
    for (int it = blockIdx.x; it < DEPTH * 96; it += G) {
        const int l = it / 96, nb = it % 96, n = nb * 64 + lane;
        const float* W = p->in[I_WADA] + (size_t)l * D * 6144 + n;
        float a0 = 0.f, a1 = 0.f, a2 = 0.f;
#pragma unroll 32
        for (int k = wave * 128; k < wave * 128 + 128; ++k) { const float w = W[(size_t)k * 6144]; a0 += sc[k] * w; a1 += sc[1024 + k] * w; a2 += sc[2048 + k] * w; }
        red[(wave * 3 + 0) * 64 + lane] = a0; red[(wave * 3 + 1) * 64 + lane] = a1; red[(wave * 3 + 2) * 64 + lane] = a2;
        __syncthreads();
        if (tid < 192) { const int v = tid >> 6, ln = tid & 63; float s = p->in[I_BADA][l * 6144 + nb * 64 + ln];
#pragma unroll
            for (int w = 0; w < 8; ++w) s += red[(w * 3 + v) * 64 + ln];
            mod[((size_t)l * 3 + v) * 6144 + nb * 64 + ln] = s; }
        __syncthreads();
    }
    if (blockIdx.x == 0) {
        f32x2* tab = (f32x2*)(ws + WS_ROPE);
        for (int i = tid; i < 128 * 8; i += NTHREADS) { const int pos = i >> 3, j = i & 7; const float f = powf(10000.f, -(float)j / 8.f); const float ang = (float)pos * f; tab[i] = (f32x2){cosf(ang), sinf(ang)}; }
        if (tid < DEPTH) { const float* lv = p->in[I_DLAM] + tid * 128; float s1 = 0.f, s2 = 0.f;
            for (int j = 0; j < 32; ++j) { s1 += lv[j] * lv[32 + j]; s2 += lv[64 + j] * lv[96 + j]; }
            ((float*)(ws + WS_LAM))[tid] = expf(s1) - expf(s2) + (0.8f - 0.6f * expf(-0.3f * (float)tid)); }
    }
    LAS h16* scr = (LAS h16*)(lds + 32768 + wave * 8448);
    const int gw = vcu * NWAVES + wave, NGW = G * NWAVES;
    constexpr int N_IN = DEPTH * 16 * 40, N_OUT = DEPTH * 16 * 16, N_E = DEPTH * NEXP * 128, N_RG = DEPTH * 2 * 8;
    constexpr int NITEMS = N_IN + N_OUT + 3 * N_E + 2 * N_RG;
    for (int it = gw; it < NITEMS; it += NGW) {
        int r = it;
        if (r < N_IN) { const int l = r / 640; p0_transpose_item(p->in[I_WIN] + (size_t)l * D * INC, D, INC, (h16*)(ws + WS_WIN) + (size_t)l * INC * D, scr, r % 640, lane); continue; } r -= N_IN;
        if (r < N_OUT) { const int l = r / 256; p0_transpose_item(p->in[I_WOUT] + (size_t)l * D * D, D, D, (h16*)(ws + WS_WOUT) + (size_t)l * D * D, scr, r % 256, lane); continue; } r -= N_OUT;
        if (r < N_E) { const int mi = r / 128; p0_transpose_item(p->in[I_W1] + (size_t)mi * D * DEXP, D, DEXP, (h16*)(ws + WS_W1) + (size_t)mi * D * DEXP, scr, r % 128, lane); continue; } r -= N_E;
        if (r < N_E) { const int mi = r / 128; p0_transpose_item(p->in[I_W3] + (size_t)mi * D * DEXP, D, DEXP, (h16*)(ws + WS_W3) + (size_t)mi * D * DEXP, scr, r % 128, lane); continue; } r -= N_E;
        if (r < N_E) { const int mi = r / 128; p0_transpose_item(p->in[I_W2] + (size_t)mi * D * DEXP, DEXP, D, (h16*)(ws + WS_W2) + (size_t)mi * D * DEXP, scr, r % 128, lane); continue; } r -= N_E;
        {
            const int gate = r / N_RG; r %= N_RG; const int mi = r; const int ldir = mi >> 3, nb = mi & 7;
            const float* src = p->in[gate ? I_RGWI : I_RGWR] + (size_t)mi * 4096;
            h16* dst = (h16*)(ws + WS_RGW) + ((size_t)(ldir * 2 + gate) * 8 + nb) * 4096;
            p0_transpose_item(src, 64, 64, dst, scr, 0, lane);
        }
    }
}

__device__ __forceinline__ void phase_norm1(KP p, int l, int mode, volatile LAS int* tab, int vcu, int G, bool dummy) {
    const int tid = tid_now(); const int lane = tid & 63, wave = __builtin_amdgcn_readfirstlane(tid >> 6);
    unsigned char* ws = p->ws;
    float* xl = (float*)(ws + WS_XL); h16* hl = (h16*)(ws + (dummy ? WS_ACT : WS_HL)); float* xlo = dummy ? (float*)(ws + WS_XG) : xl;
    const float* mod = (const float*)(ws + WS_MOD);
    const int* asg = (const int*)(ws + WS_ASG); const float* ew = (const float*)(ws + WS_EW);
    const h16* yb = (const h16*)(ws + WS_YB);
    const int nrows = (mode == 2) ? NLAT : NROW;
    const int prev_rows = (l == DEPTH) ? NLAT : NROW;
    const int gw = vcu * NWAVES + wave, NGW = G * NWAVES;
    for (int row = gw; row < nrows; row += NGW) {
        const int v = (row < NLAT) ? (row >> 13) : 2;
        f32x4 x[4];
        if (mode == 0) {
            const float* src = (row < NLAT) ? p->in[I_X] + (size_t)row * D : p->in[I_CTX] + (size_t)(row - NLAT) * D;
#pragma unroll
            for (int j = 0; j < 4; ++j) x[j] = *(const f32x4*)(src + 4 * lane + 256 * j);
        } else {
            const float* src = xl + (size_t)row * D;
#pragma unroll
            for (int j = 0; j < 4; ++j) x[j] = *(const f32x4*)(src + 4 * lane + 256 * j);
            if (row < prev_rows) {
                const int a0 = asg[row * 2], a1 = asg[row * 2 + 1];
                const float w0 = ew[row * 2], w1 = ew[row * 2 + 1];
                const size_t s0 = (size_t)a0, s1 = (size_t)a1;
                const float* ga = mod + ((size_t)(l - 1) * 3 + v) * 6144 + 5 * 1024;
#pragma unroll
                for (int j = 0; j < 4; ++j) {
                    const int c = 4 * lane + 256 * j;
                    const h16x4 y0 = *(const h16x4*)(yb + s0 * D + c), y1 = *(const h16x4*)(yb + s1 * D + c);
                    const f32x4 g = *(const f32x4*)(ga + c);
#pragma unroll
                    for (int e = 0; e < 4; ++e) x[j][e] += g[e] * (w0 * (float)y0[e] + w1 * (float)y1[e]);
                }
            }
        }
        if (mode != 2) {
            float* dst = xlo + (size_t)row * D;
#pragma unroll
            for (int j = 0; j < 4; ++j) *(f32x4*)(dst + 4 * lane + 256 * j) = x[j];
        }
        float ss = 0.f;
#pragma unroll
        for (int j = 0; j < 4; ++j) ss += x[j][0] * x[j][0] + x[j][1] * x[j][1] + x[j][2] * x[j][2] + x[j][3] * x[j][3];
        const float rstd = rsqrtf(wave_sum(ss) * (1.f / D) + EPS);
        if (mode == 2) {
            const float* g = p->in[I_GFINAL]; float* o = p->out + (size_t)row * D;
#pragma unroll
            for (int j = 0; j < 4; ++j) { const int c = 4 * lane + 256 * j; const f32x4 gv = *(const f32x4*)(g + c); *(f32x4*)(o + c) = x[j] * rstd * gv; }
        } else {
            const float* g = p->in[I_GMIX] + l * D; const float* sh = mod + ((size_t)l * 3 + v) * 6144; const float* scl = sh + 1024;
            h16* o = hl + (size_t)row * D;
#pragma unroll
            for (int j = 0; j < 4; ++j) { const int c = 4 * lane + 256 * j; const f32x4 gv = *(const f32x4*)(g + c), sv = *(const f32x4*)(scl + c), hv = *(const f32x4*)(sh + c);
                const f32x4 y = x[j] * rstd * gv * (1.f + sv) + hv;
                u32x2 w; w.x = pkh(y[0], y[1]); w.y = pkh(y[2], y[3]); *(u32x2*)(o + c) = w; }
        }
    }
}

#define SM_THR 6.0f
#define SOFTMAX_TILE(s, m, l, oA, oB, pfa, pfb) do { \
    float mx_ = fmaxf(fmaxf(s[0], s[1]), s[2]); \
    _Pragma("unroll") for (int r_ = 3; r_ < 15; r_ += 2) mx_ = fmaxf(fmaxf(mx_, s[r_]), s[r_ + 1]); \
    mx_ = fmaxf(mx_, s[15]); mx_ = xhalf_max(mx_); \
    if (__any(mx_ > m + SM_THR)) { const float dl_ = (mx_ > m + SM_THR) ? (mx_ - m) : 0.f; m += dl_; \
        const float al_ = __builtin_amdgcn_exp2f(-dl_); l *= al_; oA *= al_; oB *= al_; } \
    _Pragma("unroll") for (int r_ = 0; r_ < 16; ++r_) s[r_] = __builtin_amdgcn_exp2f(s[r_] - m); \
    { float sm_ = 0.f; _Pragma("unroll") for (int r_ = 0; r_ < 16; ++r_) sm_ += s[r_]; l += sm_; } \
    _Pragma("unroll") for (int j_ = 0; j_ < 8; ++j_) { pfa[j_] = (h16)s[j_]; pfb[j_] = (h16)s[8 + j_]; } \
} while (0)

__device__ __forceinline__ int pi32(int r) { return (r & 19) | (((r >> 3) & 1) << 2) | (((r >> 2) & 1) << 3); }

constexpr int DA_STAGE = 18432;
__device__ __forceinline__ unsigned pkrtz(float a, float b) { return __builtin_bit_cast(unsigned, __builtin_amdgcn_cvt_pkrtz(a, b)); }
__device__ __forceinline__ void da_exp_pack(f32x16& s, float& l, h16x8& pa, h16x8& pb) {
#pragma unroll
    for (int r = 0; r < 16; ++r) s[r] = __builtin_amdgcn_exp2f(s[r]);
    u32x4 wa, wb;
    wa.x = pkrtz(s[0], s[1]); wa.y = pkrtz(s[2], s[3]); wa.z = pkrtz(s[4], s[5]); wa.w = pkrtz(s[6], s[7]);
    wb.x = pkrtz(s[8], s[9]); wb.y = pkrtz(s[10], s[11]); wb.z = pkrtz(s[12], s[13]); wb.w = pkrtz(s[14], s[15]);
    const h16x2 one2 = {(h16)1.f, (h16)1.f};
    float sm = l;
#pragma unroll
    for (int j = 0; j < 4; ++j) { sm = __builtin_amdgcn_fdot2(__builtin_bit_cast(h16x2, wa[j]), one2, sm, false); sm = __builtin_amdgcn_fdot2(__builtin_bit_cast(h16x2, wb[j]), one2, sm, false); }
    l = sm;
    pa = __builtin_bit_cast(h16x8, wa); pb = __builtin_bit_cast(h16x8, wb);
}
__device__ __forceinline__ void diff_unit(KP p, int l, int b, int h, int qrow0, int kt0, int nkt, LAS unsigned char* lds) {
    const int tid = tid_now(), lane = tid & 63, wid = __builtin_amdgcn_readfirstlane(tid >> 6), q32 = lane & 31, hi = lane >> 5;
    unsigned char* ws = p->ws;
    const h16* Qd = (const h16*)(ws + WS_QD); const h16* Kd = (const h16*)(ws + WS_KD); const h16* VdT = (const h16*)(ws + WS_VDT);
    h16* mix = (h16*)(ws + WS_MIX);
    const int qrow = qrow0 + wid * 32 + q32;
    h16x8 qf00, qf01, qf10, qf11;
    {
        const h16* qp = Qd + (size_t)qrow * 256 + h * 64 + hi * 8;
        qf00 = *(const h16x8*)(qp); qf01 = *(const h16x8*)(qp + 16); qf10 = *(const h16x8*)(qp + 32); qf11 = *(const h16x8*)(qp + 48);
    }
    const h16x8 zero8 = {0, 0, 0, 0, 0, 0, 0, 0};
    f32x16 negm0, negm1;
    {
        const float* km = (const float*)((const unsigned*)(ws + WS_CTL) + CW_KMAX + l * 16) + (b * 4 + h) * 2;
        float q0 = 0.f, q1 = 0.f;
#pragma unroll
        for (int j = 0; j < 8; ++j) { q0 += (float)qf00[j] * (float)qf00[j] + (float)qf01[j] * (float)qf01[j]; q1 += (float)qf10[j] * (float)qf10[j] + (float)qf11[j] * (float)qf11[j]; }
        q0 = xhalf_sum(q0); q1 = xhalf_sum(q1);
        const float m0 = sqrtf(q0 * km[0]) * 1.004f + 0.01f - 10.f, m1 = sqrtf(q1 * km[1]) * 1.004f + 0.01f - 10.f;
#pragma unroll
        for (int r = 0; r < 16; ++r) { negm0[r] = -m0; negm1[r] = -m1; }
    }
    const int srow = tid >> 3, sch = tid & 7;
    const h16* kg = Kd + ((size_t)(b * KEYS + kt0 * 64 + srow)) * 256 + h * 64 + sch * 8;
    const h16* vg = VdT + ((size_t)((b * 4 + h) * 64 + srow)) * KEYS + kt0 * 64 + sch * 8;
    const int sto = srow * 144 + sch * 16;
    const int koff = pi32(q32) * 144 + hi * 16, voff = 9216 + q32 * 144 + hi * 16;
    float l0 = 0.f, l1 = 0.f;
    f32x16 o00 = {}, o01 = {}, o10 = {}, o11 = {};
#define DA_MF(a_, b_, c_) __builtin_amdgcn_mfma_f32_32x32x16_f16(a_, b_, c_, 0, 0, 0)
#define DA_KLOAD(addr) do { const LAS unsigned char* kb_ = (addr); kf0a = *(const LAS h16x8*)(kb_); kf0b = *(const LAS h16x8*)(kb_ + 32); kf1a = *(const LAS h16x8*)(kb_ + 64); kf1b = *(const LAS h16x8*)(kb_ + 96); } while (0)
#define DA_VLOAD(addr) do { const LAS unsigned char* vb_ = (addr); v00 = *(const LAS h16x8*)(vb_); v10 = *(const LAS h16x8*)(vb_ + 4608); v01 = *(const LAS h16x8*)(vb_ + 32); v11 = *(const LAS h16x8*)(vb_ + 4608 + 32); } while (0)
#define DA_STEP(PP0a, PP0b, PP1a, PP1b, PN0a, PN0b, PN1a, PN1b, vaddr, kaddr) do { \
        o00 = DA_MF(v00, PP0a, o00); o10 = DA_MF(v00, PP1a, o10); o01 = DA_MF(v10, PP0a, o01); o11 = DA_MF(v10, PP1a, o11); \
        o00 = DA_MF(v01, PP0b, o00); o10 = DA_MF(v01, PP1b, o10); o01 = DA_MF(v11, PP0b, o01); o11 = DA_MF(v11, PP1b, o11); \
        da_exp_pack(s0, l0, PN0a, PN0b); \
        s0 = DA_MF(kf0a, qf00, negm0); s0 = DA_MF(kf0b, qf01, s0); \
        da_exp_pack(s1, l1, PN1a, PN1b); \
        s1 = DA_MF(kf1a, qf10, negm1); s1 = DA_MF(kf1b, qf11, s1); \
        DA_VLOAD(vaddr); DA_KLOAD(kaddr); \
    } while (0)
    __syncthreads();
    u32x4 kreg = *(const u32x4*)kg, vreg = *(const u32x4*)vg;
    *(LAS u32x4*)(lds + sto) = kreg; *(LAS u32x4*)(lds + 9216 + sto) = vreg;
    kreg = *(const u32x4*)(kg + (size_t)64 * 256); vreg = *(const u32x4*)(vg + 64);
    *(LAS u32x4*)(lds + DA_STAGE + sto) = kreg; *(LAS u32x4*)(lds + DA_STAGE + 9216 + sto) = vreg;
    if (nkt > 2) { kreg = *(const u32x4*)(kg + (size_t)2 * 64 * 256); vreg = *(const u32x4*)(vg + 2 * 64); }
    __syncthreads();
    f32x16 s0, s1;
    h16x8 kf0a, kf0b, kf1a, kf1b, v00, v10, v01, v11;
    h16x8 pa0a = zero8, pa0b = zero8, pa1a = zero8, pa1b = zero8, pb0a = zero8, pb0b = zero8, pb1a = zero8, pb1b = zero8;
    DA_KLOAD(lds + koff);
    s0 = DA_MF(kf0a, qf00, negm0); s0 = DA_MF(kf0b, qf01, s0);
    s1 = DA_MF(kf1a, qf10, negm1); s1 = DA_MF(kf1b, qf11, s1);
    DA_KLOAD(lds + koff + 4608);
    DA_VLOAD(lds + voff);
    int cur = 0, nxt = DA_STAGE, wrs = 2 * DA_STAGE;
    for (int t = 0; t < nkt; ++t) {
        if (t + 2 < nkt) { *(LAS u32x4*)(lds + wrs + sto) = kreg; *(LAS u32x4*)(lds + wrs + 9216 + sto) = vreg; }
        if (t + 3 < nkt) { kreg = *(const u32x4*)(kg + (size_t)(t + 3) * 64 * 256); vreg = *(const u32x4*)(vg + (size_t)(t + 3) * 64); }
        const int pf = (t + 1 < nkt) ? nxt : cur;
        DA_STEP(pb0a, pb0b, pb1a, pb1b, pa0a, pa0b, pa1a, pa1b, lds + cur + voff, lds + pf + koff);
        DA_STEP(pa0a, pa0b, pa1a, pa1b, pb0a, pb0b, pb1a, pb1b, lds + cur + voff + 64, lds + pf + koff + 4608);
        { const int tmp = cur; cur = nxt; nxt = wrs; wrs = tmp; }
        __syncthreads();
    }
    o00 = DA_MF(v00, pb0a, o00); o10 = DA_MF(v00, pb1a, o10); o01 = DA_MF(v10, pb0a, o01); o11 = DA_MF(v10, pb1a, o11);
    o00 = DA_MF(v01, pb0b, o00); o10 = DA_MF(v01, pb1b, o10); o01 = DA_MF(v11, pb0b, o01); o11 = DA_MF(v11, pb1b, o11);
#undef DA_MF
#undef DA_KLOAD
#undef DA_VLOAD
#undef DA_STEP
    const float lam = ((const float*)(ws + WS_LAM))[l];
    const float lam_init = 0.8f - 0.6f * expf(-0.3f * (float)l);
    const float r0 = 1.f / xhalf_sum(l0), r1 = lam / xhalf_sum(l1);
    f32x16 y0 = o00 * r0 - o10 * r1, y1 = o01 * r0 - o11 * r1;
    float ss = 0.f;
#pragma unroll
    for (int r = 0; r < 16; ++r) ss += y0[r] * y0[r] + y1[r] * y1[r];
    ss = xhalf_sum(ss);
    const float sc = rsqrtf(ss * (1.f / 64.f) + EPS) * (1.f - lam_init);
    const float* g = p->in[I_DSUBG] + l * 64;
    h16* dst = mix + (size_t)qrow * D + 768 + h * 64;
#pragma unroll
    for (int r4 = 0; r4 < 4; ++r4) {
        const int e0 = 8 * r4 + 4 * hi;
        const f32x4 g0 = *(const f32x4*)(g + e0), g1 = *(const f32x4*)(g + 32 + e0);
        u32x2 w0, w1;
        w0.x = pkh(y0[4 * r4] * sc * g0[0], y0[4 * r4 + 1] * sc * g0[1]); w0.y = pkh(y0[4 * r4 + 2] * sc * g0[2], y0[4 * r4 + 3] * sc * g0[3]);
        w1.x = pkh(y1[4 * r4] * sc * g1[0], y1[4 * r4 + 1] * sc * g1[1]); w1.y = pkh(y1[4 * r4 + 2] * sc * g1[2], y1[4 * r4 + 3] * sc * g1[3]);
        *(u32x2*)(dst + e0) = w0; *(u32x2*)(dst + 32 + e0) = w1;
    }
}

constexpr int NA_K = 0, NA_V = 33792, NA_BIAS = 33792 + 36864;
__device__ __forceinline__ void na_unit(KP p, int l, int b, int gr, bool isctx, LAS unsigned char* lds) {
    const int tid = tid_now(), lane = tid & 63, wid = __builtin_amdgcn_readfirstlane(tid >> 6), q32 = lane & 31, hi = lane >> 5;
    const int h = wid >> 1, qt = wid & 1;
    unsigned char* ws = p->ws;
    const h16* qa = (const h16*)(ws + WS_QA); const h16* Ka = (const h16*)(ws + WS_KA); const h16* VaT = (const h16*)(ws + WS_VAT);
    h16* mix = (h16*)(ws + WS_MIX);
    const int qrow = isctx ? (NLAT + b * CTX + gr * 64 + qt * 32 + q32) : (b * SEQ + gr * 64 + qt * 32 + q32);
    h16x8 qf[4];
#pragma unroll
    for (int ks = 0; ks < 4; ++ks) qf[ks] = *(const h16x8*)(qa + (size_t)qrow * 256 + h * 64 + ks * 16 + hi * 8);
    const int nloc = isctx ? 0 : 8, ntile = nloc + 4;
    int kr0 = gr - 4; kr0 = kr0 < 0 ? 0 : (kr0 > 120 ? 120 : kr0);
    LAS float* bias = (LAS float*)(lds + NA_BIAS);
    __syncthreads();
    if (!isctx) { const float* rp = p->in[I_RPB] + (size_t)l * 4 * 15 * 31; for (int i = tid; i < 4 * 15 * 31; i += NTHREADS) bias[i] = rp[i] * LOG2E; }
    const int koff = NA_K + pi32(q32) * 528 + h * 128 + hi * 16;
    const int voff = NA_V + (h * 64 + q32) * 144 + hi * 16;
    const int cq = qt * 32 + q32; int cs = cq - 8; cs = cs < 0 ? 0 : (cs > 48 ? 48 : cs);
    float m = 0.f, ls = 0.f; f32x16 o0 = {}, o1 = {};
    u32x4 kpre[4], vpre[4];
#define NA_LOAD(t_) do { const int key0_ = ((t_) < nloc) ? (kr0 + (t_)) * 64 : SEQ + ((t_) - nloc) * 64; \
        _Pragma("unroll") for (int i = 0; i < 4; ++i) { const int id = tid + 512 * i; \
            kpre[i] = *(const u32x4*)(Ka + ((size_t)(b * KEYS + key0_ + (id >> 5))) * 256 + (id & 31) * 8); \
            vpre[i] = *(const u32x4*)(VaT + ((size_t)(b * 256 + (id >> 3))) * KEYS + key0_ + (id & 7) * 8); } } while (0)
    NA_LOAD(0);
    for (int t = 0; t < ntile; ++t) {
        __syncthreads();
#pragma unroll
        for (int i = 0; i < 4; ++i) { const int id = tid + 512 * i;
            *(LAS u32x4*)(lds + NA_K + (id >> 5) * 528 + (id & 31) * 16) = kpre[i];
            *(LAS u32x4*)(lds + NA_V + (id >> 3) * 144 + (id & 7) * 16) = vpre[i]; }
        __syncthreads();
        if (t + 1 < ntile) NA_LOAD(t + 1);
#pragma unroll
        for (int th = 0; th < 2; ++th) {
            f32x16 s = {};
#pragma unroll
            for (int ks = 0; ks < 4; ++ks) { const h16x8 kf = *(const LAS h16x8*)(lds + koff + th * 32 * 528 + ks * 32); s = __builtin_amdgcn_mfma_f32_32x32x16_f16(kf, qf[ks], s, 0, 0, 0); }
            if (t < nloc) {
                const int dr = kr0 + t - gr;
                const LAS float* browl = bias + (h * 15 + dr + 7) * 31 + 15 - cq + 8 * hi; const int dwin = 8 * hi - cs;
#pragma unroll
                for (int r = 0; r < 16; ++r) { const int cr_ = 32 * th + 16 * (r >> 3) + (r & 7);
                    s[r] = ((unsigned)(cr_ + dwin) < 16u) ? s[r] + browl[cr_] : -INFINITY; }
            }
            h16x8 pa, pb;
            SOFTMAX_TILE(s, m, ls, o0, o1, pa, pb);
            const h16x8 v00 = *(const LAS h16x8*)(lds + voff + th * 64), v10 = *(const LAS h16x8*)(lds + voff + 32 * 144 + th * 64);
            const h16x8 v01 = *(const LAS h16x8*)(lds + voff + th * 64 + 32), v11 = *(const LAS h16x8*)(lds + voff + 32 * 144 + th * 64 + 32);
            o0 = __builtin_amdgcn_mfma_f32_32x32x16_f16(v00, pa, o0, 0, 0, 0); o1 = __builtin_amdgcn_mfma_f32_32x32x16_f16(v10, pa, o1, 0, 0, 0);
            o0 = __builtin_amdgcn_mfma_f32_32x32x16_f16(v01, pb, o0, 0, 0, 0); o1 = __builtin_amdgcn_mfma_f32_32x32x16_f16(v11, pb, o1, 0, 0, 0);
        }
    }
    const float rl = 1.f / xhalf_sum(ls);
    h16* dst = mix + (size_t)qrow * D + h * 64;
#pragma unroll
    for (int r4 = 0; r4 < 4; ++r4) {
        const int e0 = 8 * r4 + 4 * hi; u32x2 w0, w1;
        w0.x = pkh(o0[4 * r4] * rl, o0[4 * r4 + 1] * rl); w0.y = pkh(o0[4 * r4 + 2] * rl, o0[4 * r4 + 3] * rl);
        w1.x = pkh(o1[4 * r4] * rl, o1[4 * r4 + 1] * rl); w1.y = pkh(o1[4 * r4 + 2] * rl, o1[4 * r4 + 3] * rl);
        *(u32x2*)(dst + e0) = w0; *(u32x2*)(dst + 32 + e0) = w1;
    }
}

constexpr int RG_X32 = 0, RG_X16 = 16384, RG_W = 25600, RG_AB = 62464, RG_SEG = 128000;
__device__ __forceinline__ void rg_load_x(h16x8 (&xv)[4], const h16* xr, int q, int tid, bool valid) {
    const int RT = q >> 3, nb = q & 7;
    const int r = tid >> 3, ch = nb * 64 + (tid & 7) * 8;
    const bool isctx = RT >= 256; const int j = isctx ? ((RT - 256) & 3) : (RT & 127); const int seqlen = isctx ? CTX : SEQ;
#pragma unroll
    for (int tap = 0; tap < 4; ++tap) {
        const int t = j * 64 + r + tap - 2;
        if (valid && t >= 0 && t < seqlen) xv[tap] = *(const h16x8*)(xr + (size_t)(RT * 64 + r + tap - 2) * 512 + ch);
        else xv[tap] = (h16x8){0, 0, 0, 0, 0, 0, 0, 0};
    }
}
__device__ __forceinline__ void rg_gate_block(KP p, int l, int q0, int qstride, int qend, LAS unsigned char* lds, const int mode) {
    const int tid = tid_now(), lane = tid & 63, wid = __builtin_amdgcn_readfirstlane(tid >> 6), q32 = lane & 31, hi = lane >> 5;
    unsigned char* ws = p->ws;
    const h16* xr = (const h16*)(ws + WS_XR);
    float* agg = (float*)(ws + WS_AGG);
    const h16* gg = (const h16*)(ws + WS_GG); h16* mix = (h16*)(ws + WS_MIX);
    LAS float* x32 = (LAS float*)(lds + RG_X32); LAS h16* x16 = (LAS h16*)(lds + RG_X16); LAS h16* Wl = (LAS h16*)(lds + RG_W); LAS float* ab = (LAS float*)(lds + RG_AB); LAS float* seg = (LAS float*)(lds + RG_SEG);
    LAS float* carryL = (LAS float*)(lds + RG_SEG + 4096);
    if (q0 >= qend) return;
    const int nb0 = q0 & 7;
    const bool skip_ctx_out = (l == DEPTH - 1);
    h16x8 xv[4];
    rg_load_x(xv, xr, q0, tid, true);
    if (mode == 1 && tid < 256) {
        const int dir = tid >> 7, b = (tid >> 6) & 1, chl = tid & 63;
        const float* ag = agg + ((((size_t)dir * 2 + b) * 132) * 512 + nb0 * 64 + chl) * 2;
        float h = 0.f;
#pragma unroll 1
        for (int c0 = 0; c0 < 132; c0 += 33) {
            f32x2 v[33];
#pragma unroll
            for (int i = 0; i < 33; ++i) v[i] = *(const f32x2*)(ag + (size_t)(c0 + i) * 1024);
#pragma unroll
            for (int i = 0; i < 33; ++i) {
                const int c = c0 + i;
                int RT; if (dir == 0) RT = (c < 4) ? 256 + 4 * b + c : 128 * b + (c - 4); else RT = (c < 4) ? 256 + 4 * b + (3 - c) : 128 * b + 127 - (c - 4);
                const int dq = RT * 8 + nb0 - q0;
                if (dq >= 0 && (dq % qstride) == 0 && dq / qstride < 12) carryL[((dq / qstride) * 2 + dir) * 64 + chl] = h;
                h = v[i].x * h + v[i].y;
            }
        }
    }
    int cur_nb = -1;
    float cwr[4][8], cbr[8]; float g_br, g_bi, g_sp;
#define RG_LOAD_CONSTS(nb_) do { \
        const int ch_ = (nb_) * 64 + (tid & 7) * 8; const float* cw_ = p->in[I_CONVW] + (size_t)l * 4 * 512 + ch_; const float* cb_ = p->in[I_CONVB] + l * 512 + ch_; \
        _Pragma("unroll") for (int e = 0; e < 8; ++e) { cbr[e] = cb_[e]; _Pragma("unroll") for (int tap = 0; tap < 4; ++tap) cwr[tap][e] = cw_[tap * 512 + e]; } \
        const int dir_ = wid >> 2, chg_ = (nb_) * 64 + ((wid >> 1) & 1) * 32 + q32; \
        g_br = p->in[I_RGBR][(l * 2 + dir_) * 512 + chg_]; g_bi = p->in[I_RGBI][(l * 2 + dir_) * 512 + chg_]; \
        const float lamv_ = p->in[I_RGLAM][(l * 2 + dir_) * 512 + chg_]; g_sp = (lamv_ > 15.f) ? __expf(-lamv_) : log1pf(__expf(-lamv_)); } while (0)
    RG_LOAD_CONSTS(nb0);
    int const_nb = nb0;
    __syncthreads();
    int kt = 0;
    for (int q = q0; q < qend; q += qstride, ++kt) {
        const int RT = q >> 3, nb = q & 7;
        const int row0 = RT * 64;
        const bool isctx = RT >= 256; int b, j;
        if (isctx) { const int qq = RT - 256; b = qq >> 2; j = qq & 3; } else { b = RT >> 7; j = RT & 127; }
        h16x8 ggv;
        {
            const int r = tid >> 3, c8 = (tid & 7) * 8, ch = nb * 64 + c8;
            if (mode == 1) ggv = *(const h16x8*)(gg + (size_t)(row0 + r) * 512 + ch);
            if (nb != const_nb) { RG_LOAD_CONSTS(nb); const_nb = nb; }
            float accv[8];
#pragma unroll
            for (int e = 0; e < 8; ++e) accv[e] = cbr[e];
#pragma unroll
            for (int tap = 0; tap < 4; ++tap)
#pragma unroll
                for (int e = 0; e < 8; ++e) accv[e] += (float)xv[tap][e] * cwr[tap][e];
            *(LAS f32x4*)(x32 + r * 64 + c8) = (f32x4){accv[0], accv[1], accv[2], accv[3]}; *(LAS f32x4*)(x32 + r * 64 + c8 + 4) = (f32x4){accv[4], accv[5], accv[6], accv[7]};
            { u32x4 w; w.x = pkh(accv[0], accv[1]); w.y = pkh(accv[2], accv[3]); w.z = pkh(accv[4], accv[5]); w.w = pkh(accv[6], accv[7]); *(LAS u32x4*)(x16 + r * 72 + c8) = w; }
            if (nb != cur_nb) {
                const h16* wsrc = (const h16*)(ws + WS_RGW);
#pragma unroll
                for (int i = 0; i < 4; ++i) { const int id = tid + 512 * i; const int n = id >> 3, kc = id & 7; const int dg = n >> 6, nn = n & 63;
                    *(LAS u32x4*)(Wl + n * 72 + kc * 8) = *(const u32x4*)(wsrc + (((size_t)(l * 4 + dg) * 8 + nb) * 64 + nn) * 64 + kc * 8); }
                cur_nb = nb;
            }
        }
        lds_barrier();
        rg_load_x(xv, xr, q + qstride, tid, q + qstride < qend);
        {
            const int mt = wid & 1, g = wid >> 1, dir = g >> 1, ch2 = g & 1;
            f32x16 cr = {}, ci = {};
#pragma unroll
            for (int ks = 0; ks < 4; ++ks) {
                const h16x8 af = *(const LAS h16x8*)(x16 + (mt * 32 + q32) * 72 + ks * 16 + hi * 8);
                const h16x8 br = *(const LAS h16x8*)(Wl + (dir * 128 + ch2 * 32 + q32) * 72 + ks * 16 + hi * 8);
                const h16x8 bi = *(const LAS h16x8*)(Wl + (dir * 128 + 64 + ch2 * 32 + q32) * 72 + ks * 16 + hi * 8);
                cr = __builtin_amdgcn_mfma_f32_32x32x16_f16(af, br, cr, 0, 0, 0);
                ci = __builtin_amdgcn_mfma_f32_32x32x16_f16(af, bi, ci, 0, 0, 0);
            }
            const int chl = ch2 * 32 + q32;
            const float b_r = g_br, b_i = g_bi, sp = g_sp;
#pragma unroll
            for (int r = 0; r < 16; ++r) {
                const int tr = mt * 32 + crow(r, hi);
                const float rg = sigmoidf_(cr[r] + b_r), ig = sigmoidf_(ci[r] + b_i);
                const float la = -8.f * rg * sp;
                const float a = fexp_(la);
                const float x2 = 2.f * la;
                float om;
                if (x2 > -0.3f) om = -x2 * (1.f + x2 * (0.5f + x2 * (0.16666667f + x2 * (0.041666668f + x2 * (0.0083333338f + x2 * 0.0013888889f))))); else om = 1.f - fexp_(x2);
                const float bx = __builtin_amdgcn_sqrtf(om) * ig * x32[tr * 64 + chl];
                ab[((dir * 2 + 0) * 64 + tr) * 64 + chl] = a; ab[((dir * 2 + 1) * 64 + tr) * 64 + chl] = bx;
            }
        }
        lds_barrier();
        if (mode == 0) {
            {
                const int sg = tid >> 7, dir = (tid >> 6) & 1, chl = tid & 63; float A = 1.f, H = 0.f;
                const LAS float* pa = ab + (dir * 2 + 0) * 4096 + sg * 16 * 64 + chl; const LAS float* pb = ab + (dir * 2 + 1) * 4096 + sg * 16 * 64 + chl;
                if (dir == 0) {
#pragma unroll
                    for (int r = 0; r < 16; ++r) { const float a = pa[r * 64]; H = a * H + pb[r * 64]; A *= a; }
                } else {
#pragma unroll
                    for (int r = 15; r >= 0; --r) { const float a = pa[r * 64]; H = a * H + pb[r * 64]; A *= a; }
                }
                seg[((dir * 4 + sg) * 64 + chl) * 2] = A; seg[((dir * 4 + sg) * 64 + chl) * 2 + 1] = H;
            }
            lds_barrier();
            if (tid < 128) {
                const int dir = tid >> 6, chl = tid & 63; float A = 1.f, H = 0.f;
#pragma unroll
                for (int i = 0; i < 4; ++i) { const int sg = dir ? 3 - i : i; const float a = seg[((dir * 4 + sg) * 64 + chl) * 2], hh = seg[((dir * 4 + sg) * 64 + chl) * 2 + 1]; H = a * H + hh; A *= a; }
                int c;
                if (dir == 0) c = isctx ? j : 4 + j; else c = isctx ? 3 - j : 4 + 127 - j;
                float* dst = agg + ((((size_t)dir * 2 + b) * 132 + c) * 512 + nb * 64 + chl) * 2;
                dst[0] = A; dst[1] = H;
            }
        } else {
            if (tid < 128) {
                const int dir = tid >> 6, chl = tid & 63;
                float h = carryL[(kt * 2 + dir) * 64 + chl];
                LAS float* pa = ab + (dir * 2 + 0) * 4096 + chl; LAS float* pb = ab + (dir * 2 + 1) * 4096 + chl;
#pragma unroll 1
                for (int g0 = 0; g0 < 64; g0 += 16) {
                    const int r0 = dir ? 48 - g0 : g0;
                    float av[16], bv[16];
#pragma unroll
                    for (int i = 0; i < 16; ++i) { av[i] = pa[(r0 + i) * 64]; bv[i] = pb[(r0 + i) * 64]; }
                    if (dir == 0) {
#pragma unroll
                        for (int i = 0; i < 16; ++i) { h = av[i] * h + bv[i]; bv[i] = h; }
                    } else {
#pragma unroll
                        for (int i = 15; i >= 0; --i) { h = av[i] * h + bv[i]; bv[i] = h; }
                    }
#pragma unroll
                    for (int i = 0; i < 16; ++i) pb[(r0 + i) * 64] = bv[i];
                }
            }
            lds_barrier();
            if (!(isctx && skip_ctx_out)) {
                const int r = tid >> 3, c8 = (tid & 7) * 8;
                const LAS float* hf = ab + (0 * 2 + 1) * 4096 + r * 64 + c8; const LAS float* hb = ab + (1 * 2 + 1) * 4096 + r * 64 + c8;
                u32x4 w;
                w.x = pkh((hf[0] + hb[0]) * (float)ggv[0], (hf[1] + hb[1]) * (float)ggv[1]); w.y = pkh((hf[2] + hb[2]) * (float)ggv[2], (hf[3] + hb[3]) * (float)ggv[3]);
                w.z = pkh((hf[4] + hb[4]) * (float)ggv[4], (hf[5] + hb[5]) * (float)ggv[5]); w.w = pkh((hf[6] + hb[6]) * (float)ggv[6], (hf[7] + hb[7]) * (float)ggv[7]);
                *(u32x4*)(mix + (size_t)(row0 + r) * D + 256 + nb * 64 + c8) = w;
            }
        }
    }
}

__device__ __forceinline__ void phase_mix(KP p, int l, LAS unsigned char* lds, int G) {
    const bool last = (l == DEPTH - 1);
    const int n_dc = last ? 0 : 8, n_nc = last ? 0 : 8;
    const int U0 = 256, U1 = U0 + n_dc, U2 = U1 + 256, U3 = U2 + n_nc, U4 = U3 + 264 * 8;
    int u = blockIdx.x;
    for (; u < U3; u += G) {
        if (u < U0) { const int bh = u >> 5, qb = u & 31; REP(30) diff_unit(p, l, bh >> 2, bh & 3, (bh >> 2) * SEQ + qb * 256, 0, 132, lds); }
        else if (u < U1) { const int bh = u - U0; diff_unit(p, l, bh >> 2, bh & 3, NLAT + (bh >> 2) * CTX, 128, 4, lds); }
        else if (u < U2) { const int q = u - U1; REP(31) na_unit(p, l, q >> 7, q & 127, false, lds); }
        else { const int q = u - U2; na_unit(p, l, q >> 2, q & 3, true, lds); }
    }
    REP(32) rg_gate_block(p, l, u - U3, G, U4 - U3, lds, 0);
}

__device__ __forceinline__ void phase_scan(KP p, int l, LAS unsigned char* lds, int G) {
    const bool last = (l == DEPTH - 1);
    const int U3 = 256 + (last ? 0 : 8) + 256 + (last ? 0 : 8);
    int u = blockIdx.x; while (u < U3) u += G;
    rg_gate_block(p, l, u - U3, G, 264 * 8, lds, 1);
}

__device__ __forceinline__ void phase_route(KP p, int l, LAS unsigned char* lds, int vcu, int G, bool dummy) {
    const int tid = tid_now(), lane = tid & 63, wave = __builtin_amdgcn_readfirstlane(tid >> 6);
    unsigned char* ws = p->ws;
    const float* xl = (const float*)(ws + WS_XL); h16* xg = (h16*)(ws + (dummy ? WS_YB : WS_XG));
    const float* mod = (const float*)(ws + WS_MOD);
    int* asg = (int*)(ws + (dummy ? 7 * MiB : WS_ASG)); float* ew = (float*)(ws + (dummy ? 7 * MiB + 512 * 1024 : WS_EW));
    unsigned* cnt = (unsigned*)(ws + WS_CTL) + CW_CNT + l * 32 + (dummy ? 512 : 0);
    unsigned* pool = (unsigned*)(ws + WS_CTL) + CW_POOL + l + (dummy ? 8 : 0); unsigned* tmap = (unsigned*)(ws + WS_CTL) + (dummy ? 32768 : CW_TMAP) + l * 32 * 72; unsigned* owner = (unsigned*)(ws + WS_CTL) + (dummy ? 45000 : CW_OWNER) + l * 192;
    const int nrows = (l == DEPTH - 1) ? NLAT : NROW;
    LAS h16* xh = (LAS h16*)lds; LAS h16* xlo = (LAS h16*)(lds + 33024); LAS float* part = (LAS float*)(lds + 66048); LAS float* logit = (LAS float*)(lds + 90624);
    const float* wg = p->in[I_RWG] + (size_t)l * D * 4; const float* we = p->in[I_RWE] + (size_t)l * D * 32;
    const float* g = p->in[I_GFFN] + l * D;
    const int c16 = lane & 15, kq = lane >> 4;
    h16x8 bh[4][3], bl[4][3];
#pragma unroll
    for (int ks = 0; ks < 4; ++ks)
#pragma unroll
        for (int nt = 0; nt < 3; ++nt) {
            const int n = nt * 16 + c16;
#pragma unroll
            for (int j = 0; j < 8; ++j) {
                const int k = wave * 128 + ks * 32 + kq * 8 + j;
                float w = (n < 32) ? we[(size_t)k * 32 + n] : ((n < 36) ? wg[(size_t)k * 4 + (n - 32)] : 0.f);
                w *= 64.f; const h16 hh = (h16)w; bh[ks][nt][j] = hh; bl[ks][nt][j] = (h16)(w - (float)hh);
            }
        }
    LAS int* r_e = (LAS int*)(lds + 93184);
    LAS int* r_rk = r_e + 80;
    LAS float* r_w = (LAS float*)(r_rk + 80);
    LAS int* hist = (LAS int*)(r_w + 160);
    LAS int* baseL = hist + 32;
    LAS int* slotL = baseL + 32;
    h16* hl = (h16*)(ws + WS_HL);
    int* rlist = (int*)((unsigned*)(ws + WS_CTL) + CW_RLIST + l * (MAXTILES * 256));
    if (tid < 32) hist[tid] = 0;
    const int ngroups = nrows / 16;
    int nloc = 0;
    const unsigned* done5 = (const unsigned*)(ws + WS_CTL) + CW_D5 + l * 128;
    const int nskip = 0;
    const int rG = G - (nskip > 0 ? nskip : 0), ridx = (int)blockIdx.x - (nskip > 0 ? nskip : 0);
    if (ridx < 0) return;
    if (tid < 64) {
        for (int grp = ridx; grp < ngroups; grp += rG) {
            const unsigned need = (grp >> 4) >= NLAT / 256 ? 16u : 4u; unsigned spins = 0;
            while ((unsigned)__builtin_amdgcn_readfirstlane(__hip_atomic_load(done5 + (grp >> 4), __ATOMIC_RELAXED, __HIP_MEMORY_SCOPE_AGENT)) < need) { __builtin_amdgcn_s_sleep(2); if (++spins > (1u << 24)) break; }
        }
        __builtin_amdgcn_fence(__ATOMIC_ACQUIRE, "agent");
        asm volatile("s_waitcnt vmcnt(0)" ::: "memory");
    }
    __syncthreads();
    f32x4 xr[2][4];
#define R6_LOAD(grp_) do { _Pragma("unroll") for (int rr = 0; rr < 2; ++rr) { const int row_ = (grp_) * 16 + wave * 2 + rr; \
            _Pragma("unroll") for (int j = 0; j < 4; ++j) xr[rr][j] = *(const f32x4*)(xl + (size_t)row_ * D + 4 * lane + 256 * j); } } while (0)
    if (ridx < ngroups) R6_LOAD(ridx);
    for (int grp = ridx, kk = 0; grp < ngroups; grp += rG, ++kk) {
        lds_barrier();
#pragma unroll
        for (int rr = 0; rr < 2; ++rr) {
            const int lr = wave * 2 + rr, row = grp * 16 + lr; const int v = (row < NLAT) ? (row >> 13) : 2;
            f32x4 x[4]; float ss = 0.f;
#pragma unroll
            for (int j = 0; j < 4; ++j) x[j] = xr[rr][j];
            if (row >= NLAT && l != DEPTH - 1) {
                const float* pp = (const float*)(ws + WS_RGA) + (size_t)(row - NLAT) * D;
#pragma unroll
                for (int kq = 0; kq < 4; ++kq)
#pragma unroll
                    for (int j = 0; j < 4; ++j) x[j] += *(const f32x4*)(pp + (size_t)kq * NCTX * D + 4 * lane + 256 * j);
#pragma unroll
                for (int j = 0; j < 4; ++j) *(f32x4*)((float*)(ws + WS_XL) + (size_t)row * D + 4 * lane + 256 * j) = x[j];
            }
#pragma unroll
            for (int j = 0; j < 4; ++j) ss += x[j][0] * x[j][0] + x[j][1] * x[j][1] + x[j][2] * x[j][2] + x[j][3] * x[j][3];
            const float rstd = rsqrtf(wave_sum(ss) * (1.f / D) + EPS);
            const float* sh = mod + ((size_t)l * 3 + v) * 6144 + 3 * 1024; const float* scl = sh + 1024;
            h16* o = hl + (size_t)row * D;
#pragma unroll
            for (int j = 0; j < 4; ++j) { const int c = 4 * lane + 256 * j; const f32x4 gv = *(const f32x4*)(g + c), sv = *(const f32x4*)(scl + c), hv = *(const f32x4*)(sh + c);
                const f32x4 y = x[j] * rstd * gv * (1.f + sv) + hv;
                h16x4 yh, yl;
#pragma unroll
                for (int e = 0; e < 4; ++e) { yh[e] = (h16)y[e]; yl[e] = (h16)(y[e] - (float)yh[e]); }
                *(LAS h16x4*)(xh + lr * 1032 + c) = yh; *(LAS h16x4*)(xlo + lr * 1032 + c) = yl; *(h16x4*)(o + c) = yh; }
        }
        if (grp + rG < ngroups) R6_LOAD(grp + rG);
        lds_barrier();
        {
            f32x4 acc[3] = {{0.f, 0.f, 0.f, 0.f}, {0.f, 0.f, 0.f, 0.f}, {0.f, 0.f, 0.f, 0.f}};
#pragma unroll
            for (int ks = 0; ks < 4; ++ks) {
                const int ko = c16 * 1032 + wave * 128 + ks * 32 + kq * 8;
                const h16x8 ah = *(const LAS h16x8*)(xh + ko), al = *(const LAS h16x8*)(xlo + ko);
#pragma unroll
                for (int nt = 0; nt < 3; ++nt) {
                    acc[nt] = __builtin_amdgcn_mfma_f32_16x16x32_f16(ah, bh[ks][nt], acc[nt], 0, 0, 0);
                    acc[nt] = __builtin_amdgcn_mfma_f32_16x16x32_f16(ah, bl[ks][nt], acc[nt], 0, 0, 0);
                    acc[nt] = __builtin_amdgcn_mfma_f32_16x16x32_f16(al, bh[ks][nt], acc[nt], 0, 0, 0);
                }
            }
#pragma unroll
            for (int nt = 0; nt < 3; ++nt)
#pragma unroll
                for (int r = 0; r < 4; ++r) part[(wave * 16 + kq * 4 + r) * 48 + nt * 16 + c16] = acc[nt][r];
        }
        lds_barrier();
        for (int i = tid; i < 16 * 36; i += NTHREADS) { const int r = i / 36, o = i % 36; const int n = (o < 4) ? 32 + o : o - 4;
            float sacc = 0.f;
#pragma unroll
            for (int w = 0; w < 8; ++w) sacc += part[(w * 16 + r) * 48 + n];
            logit[i] = sacc * (1.f / 64.f) + ((o < 4) ? p->in[I_RBG][l * 4 + o] : p->in[I_RBE][l * 32 + o - 4]); }
        lds_barrier();
        if (tid < 16) {
            const LAS float* lg = logit + tid * 36;
            int gi = 0; float gm = lg[0];
#pragma unroll
            for (int i = 1; i < 4; ++i) if (lg[i] > gm) { gm = lg[i]; gi = i; }
            float gs = 0.f;
#pragma unroll
            for (int i = 0; i < 4; ++i) gs += __expf(lg[i] - gm);
            const float gtop = 1.f / gs;
            const LAS float* el = lg + 4 + gi * 8;
            int i1 = 0; float m1 = el[0];
#pragma unroll
            for (int i = 1; i < 8; ++i) if (el[i] > m1) { m1 = el[i]; i1 = i; }
            int i2 = -1; float m2 = -INFINITY;
#pragma unroll
            for (int i = 0; i < 8; ++i) if (i != i1 && el[i] > m2) { m2 = el[i]; i2 = i; }
            const float e2 = __expf(m2 - m1); const float inv = 1.f / (1.f + e2);
            const int ea = gi * 8 + i1, eb = gi * 8 + i2;
            const int ra = atomicAdd((int*)(hist + ea), 1), rb = atomicAdd((int*)(hist + eb), 1);
            const int lr = kk * 16 + tid;
            r_e[lr] = ea | (eb << 8); r_rk[lr] = ra | (rb << 16); r_w[lr * 2] = gtop * inv; r_w[lr * 2 + 1] = gtop * e2 * inv;
        }
        nloc = kk * 16 + 16;
    }
    __syncthreads();
    if (tid < 32) {
        const int n = hist[tid]; int base = 0;
        if (n > 0) {
            base = (int)atomicAdd(&cnt[tid], (unsigned)n);
            const int j0 = base >> 8, j1 = (base + n - 1) >> 8;
            if ((base & 255) == 0) { const unsigned t = atomicAdd(pool, 1u); __hip_atomic_store(owner + t, (unsigned)tid, __ATOMIC_RELAXED, __HIP_MEMORY_SCOPE_AGENT); __hip_atomic_store(tmap + tid * 72 + j0, t + 1u, __ATOMIC_RELAXED, __HIP_MEMORY_SCOPE_AGENT); }
            if (j1 != j0) { const unsigned t = atomicAdd(pool, 1u); __hip_atomic_store(owner + t, (unsigned)tid, __ATOMIC_RELAXED, __HIP_MEMORY_SCOPE_AGENT); __hip_atomic_store(tmap + tid * 72 + j1, t + 1u, __ATOMIC_RELAXED, __HIP_MEMORY_SCOPE_AGENT); }
        }
        baseL[tid] = base;
    }
    __syncthreads();
    if (tid < nloc) {
        const int lr = tid, grp = ridx + (lr >> 4) * rG, row = grp * 16 + (lr & 15);
        const int ee = r_e[lr], rk = r_rk[lr]; const int ea = ee & 255, eb = ee >> 8;
        const unsigned pa = (unsigned)(baseL[ea] + (rk & 0xffff)), pb = (unsigned)(baseL[eb] + (rk >> 16));
        unsigned* tma = tmap + ea * 72 + (pa >> 8); unsigned* tmb = tmap + eb * 72 + (pb >> 8);
        unsigned ta = 0u, tb = 0u, spin = 0u;
        while (ta == 0u || tb == 0u) {
            if (ta == 0u) ta = __hip_atomic_load(tma, __ATOMIC_RELAXED, __HIP_MEMORY_SCOPE_AGENT);
            if (tb == 0u) tb = __hip_atomic_load(tmb, __ATOMIC_RELAXED, __HIP_MEMORY_SCOPE_AGENT);
            if (++spin > (1u << 22)) break;
        }
        const int sa_ = (int)((ta - 1u) * 256u + (pa & 255u)), sb_ = (int)((tb - 1u) * 256u + (pb & 255u));
        asg[row * 2] = sa_; asg[row * 2 + 1] = sb_;
        ew[row * 2] = r_w[lr * 2]; ew[row * 2 + 1] = r_w[lr * 2 + 1];
        rlist[sa_] = row; rlist[sb_] = row;
    }
}

__device__ __forceinline__ void moe_table(KP p, int l, volatile LAS int* tab) {
    __syncthreads();
    if (tid_now() == 0) {
        const unsigned* cnt = (const unsigned*)(p->ws + WS_CTL) + CW_CNT + l * 32; int s = 0;
        for (int e = 0; e < NEXP; ++e) { tab[e] = s; s += (int)((__hip_atomic_load(cnt + e, __ATOMIC_RELAXED, __HIP_MEMORY_SCOPE_AGENT) + 255u) >> 8); }
        tab[NEXP] = s;
    }
    __syncthreads();
}

__global__ void __launch_bounds__(NTHREADS, 2) fwd_kernel(Params p_) {
    KP p = (KP)__builtin_amdgcn_kernarg_segment_ptr();
#define RELOAD_P() asm volatile("" : "+s"(p))
    extern __shared__ __attribute__((aligned(16))) unsigned char lds_raw[];
    LAS unsigned char* lds = (LAS unsigned char*)lds_raw;
    volatile LAS unsigned* MISC = (volatile LAS unsigned*)(lds + MISC_OFF);
    volatile LAS int* tab = (volatile LAS int*)(lds + MISC_OFF + 64);
    const int tid = threadIdx.x;
    const int G = gridDim.x; const int bx = blockIdx.x; const int vcu = (G % 8 == 0) ? (bx % 8) * (G / 8) + bx / 8 : bx;
    unsigned char* ws = p->ws;
    for (int u = tid; u < 256; u += NTHREADS) MISC[u] = 0u;
    __syncthreads();
    {
        XcdBarrier b0 = xcd_barrier_post((unsigned*)(ws + WS_CTL) + CW_BAR, MISC);
        cg::this_grid().sync();
        if (tid == 0) { unsigned nloc, nx; xcd_barrier_complete(b0.bar, b0.x, nloc, nx); MISC[0] = nloc; MISC[1] = nx; }
        __syncthreads();
    }
#define GRID_BAR() do { GRID_BAR1(); if (PROBE_REPEAT == 99) GRID_BAR1(); if (PROBE_STAMP >= 0 && blockIdx.x == 0 && tid == 0) { ((unsigned long long*)(ws + WS_LAM + 1024))[nstamp] = __builtin_amdgcn_s_memrealtime(); } ++nstamp; } while (0)
#define GRID_BAR1() do { RELOAD_P(); { unsigned char* w_ = p->ws; XcdBarrier b_; b_.bar = (unsigned*)(w_ + WS_CTL) + CW_BAR; b_.x = xb_xcc_id(); b_.st = MISC; xcd_barrier(b_); } \
    RELOAD_P(); ws = p->ws; } while (0)
#ifdef ONLY_PHASE
#define PH(n) (ONLY_PHASE == (n))
#else
#define PH(n) 1
#endif

    int nstamp = 0;
    if (PROBE_STAMP >= 0 && blockIdx.x == 0 && tid == 0) ((unsigned long long*)(ws + WS_LAM + 1024))[63] = __builtin_amdgcn_s_memrealtime();
    REP(0) if (PH(0)) phase_p0(p, lds, vcu, G);
    GRID_BAR();
#pragma unroll 1
    for (int l = 0; l < DEPTH; ++l) {
        const bool last = (l == DEPTH - 1);
        REP(1) if (PH(1)) phase_norm1(p, l, l == 0 ? 0 : 1, tab, vcu, G, DUMMY(1));
        GRID_BAR();
        REP(2) if (PH(2)) {
            pg8::DenseSched S; S.init(ws + WS_HL, ws + WS_WIN + (size_t)l * INC * D * 2, NROW, INC, D, G, bx);
            EpiInProj E{(h16*)(ws + WS_QA), (h16*)(ws + WS_KA), (h16*)(ws + WS_VAT), (h16*)(ws + WS_XR), (h16*)(ws + WS_GG), (h16*)(ws + WS_QD), (h16*)(ws + WS_KD), (h16*)(ws + WS_VDT), (const f32x2*)(ws + WS_ROPE), (unsigned*)(ws + WS_CTL) + CW_KMAX + l * 16, lds + 131072};
            pg8::gemm_phase<EpiInProj, pg8::DenseSched>(lds, D, S, E);
        }
        GRID_BAR();
        if (PH(3)) phase_mix(p, l, lds, G);
        GRID_BAR();
        REP(4) if (PH(4)) phase_scan(p, l, lds, G);
        GRID_BAR();
        REP(5) if (PH(5)) {
            pg8::DenseSched S; S.init(ws + WS_MIX, ws + WS_WOUT + (size_t)l * D * D * 2, NLAT, D, D, G, bx, (unsigned*)(ws + WS_CTL) + CW_D5 + l * 128);
            EpiOutProj E{(float*)(ws + WS_XL), (const float*)(ws + WS_MOD) + (size_t)l * 3 * 6144, (float*)(ws + WS_XL)};
            pg8::gemm_phase<EpiOutProj, pg8::DenseSched>(lds, D, S, E);
        }
        if (PH(5) && !last) {
            RELOAD_P(); ws = p->ws;
            CtxSplitSched S2{(const char*)(ws + WS_MIX), (const char*)(ws + WS_WOUT + (size_t)l * D * D * 2), (int)blockIdx.x - (G - 32), (unsigned*)(ws + WS_CTL) + CW_D5 + l * 128};
            EpiOutPart E2{(float*)(ws + WS_RGA), (const float*)(ws + WS_MOD) + (size_t)l * 3 * 6144};
            int klen = 256; asm volatile("" : "+s"(klen));
            pg8::gemm_phase<EpiOutPart, CtxSplitSched>(lds, klen, S2, E2, nullptr, D);
        }
        REP(6) if (PH(6)) phase_route(p, l, lds, vcu, G, DUMMY(6));
        GRID_BAR();
        moe_table(p, l, tab);
        REP(8) if (PH(8)) {
            MoeSched1 S{(const char*)((const unsigned*)(ws + WS_CTL) + CW_RLIST + l * (MAXTILES * 256)), (const char*)(ws + WS_W1 + (size_t)l * NEXP * DEXP * D * 2), (const char*)(ws + WS_W3 + (size_t)l * NEXP * DEXP * D * 2), (const unsigned*)(ws + WS_CTL) + CW_TMAP + l * 32 * 72, tab, tab[NEXP], G, vcu, (unsigned*)(ws + WS_CTL) + CW_D7 + l * 192};
            EpiMoe1 E{(h16*)(ws + WS_ACT)};
            pg8::gemm_phase<EpiMoe1, MoeSched1, true>(lds, D, S, E, (const char*)(ws + WS_HL));
        }
        REP(9) if (PH(9)) {
            MoeSched2 S{(const char*)(ws + WS_ACT), (const char*)(ws + WS_W2 + (size_t)l * NEXP * DEXP * D * 2), (const unsigned*)(ws + WS_CTL) + CW_TMAP + l * 32 * 72, tab, tab[NEXP], G, vcu, (const unsigned*)(ws + WS_CTL) + CW_D7 + l * 192, 0, 0, 0};
            S.plan();
            EpiMoe2 E{(h16*)(ws + WS_YB)};
            pg8::gemm_phase<EpiMoe2, MoeSched2>(lds, DEXP, S, E);
        }
        GRID_BAR();
    }
    if (PH(10)) phase_norm1(p, DEPTH, 2, tab, vcu, G, false);
    if (PROBE_STAMP >= 0 && blockIdx.x == 0 && tid == 0) {
        const unsigned long long* st = (const unsigned long long*)(ws + WS_LAM + 1024);
        unsigned long long tot = 0;
        if (PROBE_STAMP == 7) tot = __builtin_amdgcn_s_memrealtime() - st[63];
        else if (PROBE_STAMP == 0) tot = st[0] - st[63];
        else for (int l = 0; l < DEPTH; ++l) { const int e = PROBE_STAMP + 6 * l; tot += st[e] - st[e - 1]; }
        asm volatile("s_waitcnt vmcnt(0)" ::: "memory");
        p->out[0] = (float)tot * (0.01f / ((PROBE_STAMP == 3 || PROBE_STAMP == 7) ? 100.f : 10.f));
    }
}

extern "C" void kernel_launch(void* const* d_in, const int* in_sizes, int n_in, void* d_out, int out_size, void* d_ws, size_t ws_size, hipStream_t stream) {
    static int grid = 0;
    if (grid == 0) {
        if (n_in != 28 || out_size != NLAT * D || ws_size < WS_END) { fprintf(stderr, "kernel_launch: unexpected shapes (n_in %d out %d ws %zu)\n", n_in, out_size, ws_size); grid = -1; return; }
        int dev = 0, cus = 0, per_cu = 0;
        if (hipGetDevice(&dev) != hipSuccess || hipDeviceGetAttribute(&cus, hipDeviceAttributeMultiprocessorCount, dev) != hipSuccess) { grid = -1; return; }
        if (hipFuncSetAttribute((const void*)fwd_kernel, hipFuncAttributeMaxDynamicSharedMemorySize, LDS_BYTES) != hipSuccess) { fprintf(stderr, "kernel_launch: hipFuncSetAttribute failed\n"); grid = -1; return; }
        if (hipOccupancyMaxActiveBlocksPerMultiprocessor(&per_cu, (const void*)fwd_kernel, NTHREADS, LDS_BYTES) != hipSuccess || per_cu < 1) { fprintf(stderr, "kernel_launch: occupancy query says %d blocks per CU\n", per_cu); (void)hipGetLastError(); grid = -1; return; }
        grid = cus;
    }
    if (grid < 0) return;
    (void)hipMemsetAsync((char*)d_ws + WS_CTL, 0, CTL_ZERO_BYTES, stream);
    Params p{};
    for (int i = 0; i < 28; ++i) p.in[i] = (const float*)d_in[i];
    p.out = (float*)d_out; p.ws = (unsigned char*)d_ws;
    void* args[] = {&p};
    hipError_t e = hipLaunchCooperativeKernel((const void*)fwd_kernel, dim3(grid), dim3(NTHREADS), args, LDS_BYTES, stream);
    if (e != hipSuccess) fprintf(stderr, "kernel_launch: cooperative launch failed: %s (grid %d)\n", hipGetErrorString(e), grid);
}
```

```cpp
#include <hip/hip_runtime.h>
#include <hip/hip_cooperative_groups.h>
#include <cstdio>
#include <cstdint>
namespace cg = cooperative_groups;

#define LAS __attribute__((address_space(3)))
typedef _Float16 h16;
typedef h16 h16x8 __attribute__((ext_vector_type(8)));
typedef h16 h16x4 __attribute__((ext_vector_type(4)));
typedef h16 h16x2 __attribute__((ext_vector_type(2)));
typedef float f32x2 __attribute__((ext_vector_type(2)));
typedef float f32x4 __attribute__((ext_vector_type(4)));
typedef float f32x16 __attribute__((ext_vector_type(16)));
typedef unsigned u32x2 __attribute__((ext_vector_type(2)));
typedef unsigned u32x4 __attribute__((ext_vector_type(4)));

#define PROBE_REPEAT -1
#define PROBE_STAMP -1
#define REP(n) for (int rep_ = 0; rep_ < ((PROBE_REPEAT == (n)) ? 2 : 1); ++rep_)
#define DUMMY(n) ((PROBE_REPEAT == (n)) && rep_ == 0)
constexpr int D = 1024, NBATCH = 2, SEQ = 8192, CTX = 256, DEPTH = 4;
constexpr int NLAT = NBATCH * SEQ, NCTX = NBATCH * CTX, NROW = NLAT + NCTX;
constexpr int KEYS = SEQ + CTX;
constexpr int INC = 2560;
constexpr int NEXP = 32, DEXP = 512;
constexpr int NWAVES = 8, NTHREADS = 512;
constexpr float EPS = 1e-6f;
constexpr float LOG2E = 1.4426950408889634f;

constexpr size_t MiB = 1u << 20;
constexpr size_t WS_CTL = 0, CTL_ZERO_BYTES = 1 * MiB;
constexpr int CW_BAR = 4096;
constexpr int CW_CNT = 1024;
constexpr size_t WS_MOD = 1 * MiB;
constexpr size_t WS_LAM = 1 * MiB + 512 * 1024;
constexpr size_t WS_ROPE = 1 * MiB + 768 * 1024;
constexpr int CW_KMAX = 2048;
constexpr size_t WS_AGG = 2 * MiB;
constexpr size_t WS_ASG = 5 * MiB;
constexpr size_t WS_EW = 6 * MiB;
constexpr size_t WS_WIN = 8 * MiB;
constexpr size_t WS_WOUT = 28 * MiB;
constexpr size_t WS_RGW = 36 * MiB;
constexpr size_t WS_W1 = 40 * MiB;
constexpr size_t WS_W3 = 168 * MiB;
constexpr size_t WS_W2 = 296 * MiB;
constexpr size_t WS_XL = 424 * MiB;
constexpr size_t WS_HL = 490 * MiB;
constexpr size_t WS_QA = 523 * MiB;
constexpr size_t WS_KA = 532 * MiB;
constexpr size_t WS_VAT = 541 * MiB;
constexpr size_t WS_QD = 550 * MiB;
constexpr size_t WS_KD = 559 * MiB;
constexpr size_t WS_VDT = 568 * MiB;
constexpr size_t WS_XR = 577 * MiB;
constexpr size_t WS_GG = 594 * MiB;
constexpr size_t WS_RGA = 611 * MiB;
constexpr size_t WS_MIX = 743 * MiB;
constexpr size_t WS_XG = 776 * MiB;
constexpr size_t WS_ACT = 858 * MiB;
constexpr size_t WS_YB = 899 * MiB;
constexpr size_t WS_END = 981 * MiB;
constexpr int CW_POOL = 3000;
constexpr int CW_TMAP = 8192;
constexpr int CW_OWNER = 20480;
constexpr int MAXTILES = 164;
constexpr int CW_D5 = 21504;
constexpr int CW_RLIST = 65536;
constexpr int CW_D7 = 22528;

constexpr int LDS_BYTES = 147456;
constexpr int MISC_OFF = LDS_BYTES - 1024;

struct Params {
    const float* in[28];
    float* out;
    unsigned char* ws;
};
typedef __attribute__((address_space(4))) const Params* KP;
enum { I_X = 0, I_C, I_CTX, I_CCTX, I_WADA, I_BADA, I_GMIX, I_GFFN, I_WIN, I_WOUT, I_RPB, I_CONVW, I_CONVB, I_RGWR, I_RGBR, I_RGWI, I_RGBI, I_RGLAM,
       I_DLAM, I_DSUBG, I_RWG, I_RBG, I_RWE, I_RBE, I_W1, I_W3, I_W2, I_GFINAL };

__device__ __forceinline__ unsigned pkh(float a, float b) { h16x2 v = {(h16)a, (h16)b}; return __builtin_bit_cast(unsigned, v); }
__device__ __forceinline__ float wave_sum(float v) {
#pragma unroll
    for (int o = 1; o < 64; o <<= 1) v += __shfl_xor(v, o);
    return v;
}
__device__ __forceinline__ float xhalf_max(float m) { auto rr = __builtin_amdgcn_permlane32_swap(__float_as_uint(m), __float_as_uint(m), false, false); return fmaxf(__uint_as_float(rr[0]), __uint_as_float(rr[1])); }
__device__ __forceinline__ float xhalf_sum(float m) { auto rr = __builtin_amdgcn_permlane32_swap(__float_as_uint(m), __float_as_uint(m), false, false); return __uint_as_float(rr[0]) + __uint_as_float(rr[1]); }
__device__ __forceinline__ float fexp_(float x) { return __builtin_amdgcn_exp2f(x * LOG2E); }
__device__ __forceinline__ float frcp_(float x) { return __builtin_amdgcn_rcpf(x); }
__device__ __forceinline__ float sigmoidf_(float x) { return frcp_(1.f + fexp_(-x)); }
__device__ __forceinline__ float gelu_tanh(float x) { const float u = 0.7978845608028654f * (x + 0.044715f * x * x * x); return x * frcp_(1.f + fexp_(-2.f * u)); }
__device__ __forceinline__ int crow(int r, int hi) { return (r & 3) + 8 * (r >> 2) + 4 * hi; }
#define LDS_WAIT() asm volatile("s_waitcnt lgkmcnt(0)" ::: "memory")
__device__ __forceinline__ void lds_barrier() { asm volatile("s_waitcnt lgkmcnt(0)\n\ts_barrier" ::: "memory"); }
__device__ __forceinline__ int tid_now() { int t = threadIdx.x; asm volatile("" : "+v"(t)); return t; }

#define XB_TMO      128
#define XB_XCNT(j)  (256  + 64 * (j))
#define XB_XSUB(j)  (1280 + 64 * (j))
#define XB_XGEN(j)  (2304 + 64 * (j))
#define XB_TOP      3328
#define XB_TOPGEN   3392
#define XB_SPIN_CAP (1u << 22)
__device__ __forceinline__ unsigned xb_ld(unsigned* p)              { return __hip_atomic_load(p, __ATOMIC_RELAXED, __HIP_MEMORY_SCOPE_AGENT); }
__device__ __forceinline__ unsigned xb_add(unsigned* p, unsigned v) { return __hip_atomic_fetch_add(p, v, __ATOMIC_RELAXED, __HIP_MEMORY_SCOPE_AGENT); }
__device__ __forceinline__ unsigned xb_xcc_id() { return (unsigned)__builtin_amdgcn_s_getreg((3 << 11) | 20) & 0xFu; }
#define XB_SPIN(cond, bar) do { unsigned _sp = 0; while (cond) { __builtin_amdgcn_s_sleep(1); \
    if ((++_sp & 255u) == 0u) { if (xb_ld(&(bar)[XB_TMO])) break; if (_sp > XB_SPIN_CAP) { atomicAdd(&(bar)[XB_TMO], 1u); break; } } } } while (0)
struct XcdBarrier { unsigned* bar; unsigned x; volatile LAS unsigned* st; };
__device__ __forceinline__ XcdBarrier xcd_barrier_post(unsigned* bar, volatile LAS unsigned* st) {
    XcdBarrier b; b.bar = bar; b.x = xb_xcc_id(); b.st = st;
    if (threadIdx.x == 0) (void)xb_add(&bar[XB_XCNT(b.x)], 1u);
    return b;
}
__device__ __forceinline__ void xcd_barrier_complete(unsigned* bar, unsigned x, unsigned& nloc, unsigned& nx) {
    const unsigned G = gridDim.x * gridDim.y * gridDim.z;
    unsigned sum, cnt, mine, sp = 0u;
    for (;;) {
        sum = 0u; cnt = 0u; mine = 0u;
#pragma unroll 1
        for (unsigned j = 0; j < 16; ++j) { const unsigned c = xb_ld(&bar[XB_XCNT(j)]); sum += c; cnt += (c > 0u) ? 1u : 0u; mine = (j == x) ? c : mine; }
        if (sum == G) break;
        __builtin_amdgcn_s_sleep(1);
        if ((++sp & 255u) == 0u) { if (xb_ld(&bar[XB_TMO])) break; if (sp > XB_SPIN_CAP) { atomicAdd(&bar[XB_TMO], 1u); break; } }
    }
    nloc = mine > 0u ? mine : 1u; nx = cnt > 0u ? cnt : 1u;
}
__device__ __forceinline__ void xcd_barrier(const XcdBarrier& b) {
    asm volatile("s_waitcnt vmcnt(0)" ::: "memory");
    __syncthreads();
    if (threadIdx.x == 0) {
        unsigned* bar = b.bar;
        __builtin_amdgcn_s_waitcnt(0);
        const unsigned nloc = b.st[0], nx = b.st[1];
        const unsigned old = xb_add(&bar[XB_XSUB(b.x)], 1u);
        const unsigned gen = old / nloc;
        if (old + 1u == (gen + 1u) * nloc) {
            __builtin_amdgcn_fence(__ATOMIC_RELEASE, "agent");
            asm volatile("s_waitcnt vmcnt(0)" ::: "memory");
            const unsigned og = xb_add(&bar[XB_TOP], 1u);
            const unsigned tg = og / nx;
            if (og + 1u == (tg + 1u) * nx) xb_add(&bar[XB_TOPGEN], 1u);
            else XB_SPIN(xb_ld(&bar[XB_TOPGEN]) == tg, bar);
            __builtin_amdgcn_fence(__ATOMIC_ACQUIRE, "agent");
            xb_add(&bar[XB_XGEN(b.x)], 1u);
            asm volatile("s_waitcnt vmcnt(0)" ::: "memory");
        } else {
            XB_SPIN(xb_ld(&bar[XB_XGEN(b.x)]) == gen, bar);
            __builtin_amdgcn_fence(__ATOMIC_ACQUIRE, "agent");
            asm volatile("s_waitcnt vmcnt(0)" ::: "memory");
        }
    }
    __syncthreads();
}

__device__ __forceinline__ void unit_publish(unsigned* ctr) {
    asm volatile("s_waitcnt vmcnt(0)" ::: "memory");
    __builtin_amdgcn_s_barrier();
    if (threadIdx.x == 0) { __builtin_amdgcn_fence(__ATOMIC_RELEASE, "agent"); asm volatile("s_waitcnt vmcnt(0)" ::: "memory"); __hip_atomic_fetch_add(ctr, 1u, __ATOMIC_RELAXED, __HIP_MEMORY_SCOPE_AGENT); }
}
__device__ __forceinline__ void unit_wait(const unsigned* ctr, unsigned need) {
    if (threadIdx.x < 64) {
        unsigned spins = 0;
        while ((unsigned)__builtin_amdgcn_readfirstlane(__hip_atomic_load(ctr, __ATOMIC_RELAXED, __HIP_MEMORY_SCOPE_AGENT)) < need) { __builtin_amdgcn_s_sleep(2); if (++spins > (1u << 24)) break; }
        __builtin_amdgcn_fence(__ATOMIC_ACQUIRE, "agent");
        asm volatile("s_waitcnt vmcnt(0)" ::: "memory");
    }
    asm volatile("" ::: "memory"); __builtin_amdgcn_s_barrier(); asm volatile("" ::: "memory");
}

namespace pg8 {
constexpr int BM = 256, BK = 64, HALF = 128, HTB = HALF * BK * 2, STAGE_BYTES = 8 * HTB, NXCD = 8, WGM = 8;
__device__ __forceinline__ int lds_byte(int r, int c) { const int st = (r >> 4) * 2 + (c >> 5), rr = r & 15, cc = c & 31, ob = rr * 64 + cc * 2; return st * 1024 + (ob ^ (((ob >> 9) & 1) << 5)); }
__device__ __forceinline__ void stage_rc(int b, int& R, int& C) { const int st = b / 1024, sb = b % 1024, swz = sb ^ (((sb >> 9) & 1) << 5); R = (st >> 1) * 16 + swz / 64; C = (st & 1) * 32 + (swz % 64) / 2; }
__device__ __forceinline__ int perm32(int rho) { const int n = rho >> 4, i = rho & 15; return 8 * (i >> 2) + 4 * n + (i & 3); }

struct Unit { const char* A0; const char* A1; const char* B0; const char* B1; int pm, pn; };

struct DenseSched {
    const char* A; const char* Bt; int K, nM, nN, nwg, G, c; unsigned* done_ctr;
    __device__ __forceinline__ void init(const void* A_, const void* Bt_, int M, int N, int K_, int G_, int c_, unsigned* done_ = nullptr) { A = (const char*)A_; Bt = (const char*)Bt_; K = K_; nM = M / BM; nN = N / BM; nwg = nM * nN; G = G_; c = c_; done_ctr = done_; }
    __device__ __forceinline__ void a_ready(const Unit&) const {}
    __device__ __forceinline__ void done(const Unit& u) const { if (done_ctr) unit_publish(done_ctr + u.pm); }
    __device__ __forceinline__ bool next(int i, Unit& u) const {
        const long L = (long)i * G + c; if (L >= nwg) return false;
        int wgid = (int)L; { const int q = nwg / NXCD, r = nwg % NXCD, xcd = wgid % NXCD, off = wgid / NXCD; wgid = (xcd < r ? xcd * (q + 1) : r * (q + 1) + (xcd - r) * q) + off; }
        const int nig = WGM * nN, gid = wgid / nig, fm = gid * WGM, gsz = (nM - fm) < WGM ? (nM - fm) : WGM;
        u.pm = fm + ((wgid % nig) % gsz); u.pn = (wgid % nig) / gsz;
        const size_t hstep = (size_t)HALF * K * 2;
        u.A0 = A + (size_t)u.pm * 2 * hstep; u.A1 = u.A0 + hstep; u.B0 = Bt + (size_t)u.pn * 2 * hstep; u.B1 = u.B0 + hstep;
        return true;
    }
};

template <class Epi, class Sched, bool GATHER = false>
__device__ __forceinline__ void gemm_phase(LAS unsigned char* lds, const int K, const Sched& S, const Epi& E, const char* gbase = nullptr, const int pitch_ = 0) {
    const int pitch = pitch_ ? pitch_ : K;
    const int tid = tid_now(), wid = __builtin_amdgcn_readfirstlane(tid >> 6), lane = tid & 63, wr = wid >> 2, wc = wid & 3, fr = lane & 15, fq = lane >> 4;
    const int nt = K / BK;
    unsigned voffA[2], voffB[2];
#pragma unroll
    for (int i = 0; i < 2; ++i) { int R, C; stage_rc(tid * 16 + i * 8192, R, C); const int Rb = (R & ~31) + perm32(R & 31);
        voffA[i] = (unsigned)(R * pitch + C) * 2u; voffB[i] = (unsigned)(Rb * pitch + C) * 2u; }
    const size_t kstep = (size_t)(BK * 2);
    const unsigned ldsw = (unsigned)wid * 1024u;
    unsigned cv0[2] = {0u, 0u}, cv1[2] = {0u, 0u}, nv0[2] = {0u, 0u}, nv1[2] = {0u, 0u};
#define PG8_GOFF(v0_, v1_, listp) do { const int* rl_ = (const int*)(listp); _Pragma("unroll") for (int i_ = 0; i_ < 2; ++i_) { int R_, C_; stage_rc(tid * 16 + i_ * 8192, R_, C_); \
        v0_[i_] = (unsigned)rl_[R_] * (unsigned)(K * 2) + (unsigned)(C_ * 2); v1_[i_] = (unsigned)rl_[128 + R_] * (unsigned)(K * 2) + (unsigned)(C_ * 2); } } while (0)
#define PG8_STAGE2(bufoff, gb, va, vb, sel) do { _Pragma("unroll") for (int _i = 0; _i < 2; ++_i) \
        __builtin_amdgcn_global_load_lds((const unsigned*)((const char*)(gb) + ((sel) ? (vb)[_i] : (va)[_i])), (LAS unsigned*)(lds + (bufoff) + ldsw + _i * 8192), 16, 0, 0); } while (0)
    const int aoff = lds_byte(wr * 64 + fr, fq * 8), boff = lds_byte(wc * 32 + fr, fq * 8);
#define PG8_SA(b, h) (((b) * 2 + (h)) * HTB)
#define PG8_SB(b, h) ((4 + (b) * 2 + (h)) * HTB)
#define PG8_STAGE(bufoff, gbase, voff) do { _Pragma("unroll") for (int _i = 0; _i < 2; ++_i) \
        __builtin_amdgcn_global_load_lds((const unsigned*)((const char*)(gbase) + (voff)[_i]), (LAS unsigned*)(lds + (bufoff) + ldsw + _i * 8192), 16, 0, 0); } while (0)
#define PG8_LDA(dst, b, h) do { _Pragma("unroll") for (int m = 0; m < 4; ++m) _Pragma("unroll") for (int k = 0; k < 2; ++k) dst[m][k] = *(const LAS h16x8*)(lds + PG8_SA(b, h) + aoff + m * 2048 + k * 1024); } while (0)
#define PG8_LDB(dst, b, h) do { _Pragma("unroll") for (int n = 0; n < 2; ++n) _Pragma("unroll") for (int k = 0; k < 2; ++k) dst[n][k] = *(const LAS h16x8*)(lds + PG8_SB(b, h) + boff + n * 2048 + k * 1024); } while (0)
#define PG8_MMA(ai, bj, At, Bt) do { __builtin_amdgcn_s_setprio(1); _Pragma("unroll") for (int m = 0; m < 4; ++m) _Pragma("unroll") for (int n = 0; n < 2; ++n) _Pragma("unroll") for (int k = 0; k < 2; ++k) \
        acc[ai][bj][m][n] = __builtin_amdgcn_mfma_f32_16x16x32_f16(Bt[n][k], At[m][k], acc[ai][bj][m][n], 0, 0, 0); __builtin_amdgcn_s_setprio(0); } while (0)
#define PG8_WAIT_V(n) asm volatile("s_waitcnt vmcnt(" #n ")" ::: "memory")
#define PG8_WAIT_L(n) asm volatile("s_waitcnt lgkmcnt(" #n ")" ::: "memory")
#define PG8_BAR __builtin_amdgcn_s_barrier()
#define PG8_SCHED __builtin_amdgcn_sched_barrier(0)
    Unit cur, nxt; int ui = 0;
    if (!S.next(0, cur)) return;
    f32x4 acc[2][2][4][2];
#pragma unroll
    for (int a = 0; a < 2; ++a)
#pragma unroll
        for (int b = 0; b < 2; ++b)
#pragma unroll
            for (int m = 0; m < 4; ++m)
#pragma unroll
                for (int n = 0; n < 2; ++n) acc[a][b][m][n] = (f32x4){0.f, 0.f, 0.f, 0.f};
    h16x8 At[4][2], B0[2][2], B1[2][2];
    const char* cA0 = cur.A0; const char* cA1 = cur.A1; const char* cB0 = cur.B0; const char* cB1 = cur.B1;
    S.a_ready(cur);
    if constexpr (GATHER) { PG8_GOFF(cv0, cv1, cur.A0); }
    PG8_STAGE(PG8_SB(0, 0), cB0, voffB); PG8_STAGE(PG8_SB(0, 1), cB1, voffB);
    if constexpr (GATHER) { PG8_STAGE2(PG8_SA(0, 0), gbase, cv0, cv0, false); PG8_STAGE2(PG8_SA(0, 1), gbase, cv1, cv1, false); }
    else { PG8_STAGE(PG8_SA(0, 0), cA0, voffA); PG8_STAGE(PG8_SA(0, 1), cA1, voffA); }
    if (wr == 1) PG8_BAR;
    PG8_WAIT_V(2); PG8_BAR;
    PG8_STAGE(PG8_SB(1, 0), cB0 + kstep, voffB);
    if constexpr (GATHER) { PG8_STAGE2(PG8_SA(1, 0), gbase + kstep, cv0, cv0, false); } else { PG8_STAGE(PG8_SA(1, 0), cA0 + kstep, voffA); }
    PG8_STAGE(PG8_SB(1, 1), cB1 + kstep, voffB);
    PG8_WAIT_V(6); PG8_BAR;
    for (;;) {
        const bool has_next = S.next(ui + 1, nxt);
        const char* nA0 = has_next ? nxt.A0 : cA0; const char* nA1 = has_next ? nxt.A1 : cA1;
        const char* nB0 = has_next ? nxt.B0 : cB0; const char* nB1 = has_next ? nxt.B1 : cB1;
        for (int t = 0; t < nt; t += 2) {
            const bool last = (t == nt - 2);
            if (last && has_next) S.a_ready(nxt);
            if constexpr (GATHER) { if (last) { if (has_next) { PG8_GOFF(nv0, nv1, nxt.A0); } else { nv0[0] = cv0[0]; nv0[1] = cv0[1]; nv1[0] = cv1[0]; nv1[1] = cv1[1]; } } }
            const char* g1 = gbase + (size_t)(t + 1) * kstep; const char* g2 = gbase + (last ? (size_t)0 : (size_t)(t + 2) * kstep); const char* g3 = g2 + kstep;
            const char* a1_1 = cA1 + (size_t)(t + 1) * kstep;
            const char* a2_0 = last ? nA0 : cA0 + (size_t)(t + 2) * kstep; const char* a2_1 = last ? nA1 : cA1 + (size_t)(t + 2) * kstep;
            const char* b2_0 = last ? nB0 : cB0 + (size_t)(t + 2) * kstep; const char* b2_1 = last ? nB1 : cB1 + (size_t)(t + 2) * kstep;
            const char* a3_0 = a2_0 + kstep; const char* b3_0 = b2_0 + kstep; const char* b3_1 = b2_1 + kstep;
            PG8_LDB(B0, 0, 0); PG8_LDB(B1, 0, 1); PG8_SCHED; PG8_LDA(At, 0, 0); if constexpr (GATHER) { PG8_STAGE2(PG8_SA(1, 1), g1, cv1, cv1, false); } else { PG8_STAGE(PG8_SA(1, 1), a1_1, voffA); }
            PG8_WAIT_V(8); PG8_WAIT_L(0); PG8_BAR; PG8_MMA(0, 0, At, B0); PG8_MMA(0, 1, At, B1); PG8_BAR; PG8_SCHED;
            PG8_LDA(At, 0, 1); PG8_STAGE(PG8_SB(0, 0), b2_0, voffB); PG8_STAGE(PG8_SB(0, 1), b2_1, voffB); if constexpr (GATHER) { PG8_STAGE2(PG8_SA(0, 0), g2, cv0, nv0, last); } else { PG8_STAGE(PG8_SA(0, 0), a2_0, voffA); }
            PG8_WAIT_V(8); PG8_WAIT_L(0); PG8_BAR; PG8_MMA(1, 0, At, B0); PG8_MMA(1, 1, At, B1); PG8_BAR; PG8_SCHED;
            PG8_LDB(B0, 1, 0); PG8_LDB(B1, 1, 1); PG8_SCHED; PG8_LDA(At, 1, 0); if constexpr (GATHER) { PG8_STAGE2(PG8_SA(0, 1), g2, cv1, nv1, last); } else { PG8_STAGE(PG8_SA(0, 1), a2_1, voffA); }
            PG8_WAIT_V(8); PG8_WAIT_L(0); PG8_BAR; PG8_MMA(0, 0, At, B0); PG8_MMA(0, 1, At, B1); PG8_BAR; PG8_SCHED;
            PG8_LDA(At, 1, 1); PG8_STAGE(PG8_SB(1, 0), b3_0, voffB); PG8_STAGE(PG8_SB(1, 1), b3_1, voffB); if constexpr (GATHER) { PG8_STAGE2(PG8_SA(1, 0), g3, cv0, nv0, last); } else { PG8_STAGE(PG8_SA(1, 0), a3_0, voffA); }
            PG8_WAIT_V(8); PG8_WAIT_L(0); PG8_BAR; PG8_MMA(1, 0, At, B0); PG8_MMA(1, 1, At, B1); PG8_BAR; PG8_SCHED;
        }
        if (wr == 0) PG8_BAR;
        E(acc, cur, wr, wc, fr, fq);
        S.done(cur);
        if (!has_next) break;
#pragma unroll
        for (int a = 0; a < 2; ++a)
#pragma unroll
            for (int b = 0; b < 2; ++b)
#pragma unroll
                for (int m = 0; m < 4; ++m)
#pragma unroll
                    for (int n = 0; n < 2; ++n) acc[a][b][m][n] = (f32x4){0.f, 0.f, 0.f, 0.f};
        cur = nxt; cA0 = nA0; cA1 = nA1; cB0 = nB0; cB1 = nB1; ++ui;
        if constexpr (GATHER) { cv0[0] = nv0[0]; cv0[1] = nv0[1]; cv1[0] = nv1[0]; cv1[1] = nv1[1]; }
        if (wr == 1) PG8_BAR;
    }
    PG8_WAIT_V(0);
    PG8_BAR;
#undef PG8_SA
#undef PG8_SB
#undef PG8_STAGE
#undef PG8_STAGE2
#undef PG8_GOFF
#undef PG8_LDA
#undef PG8_LDB
#undef PG8_MMA
#undef PG8_WAIT_V
#undef PG8_WAIT_L
#undef PG8_BAR
#undef PG8_SCHED
}
}
using pg8::Unit;
typedef f32x4 AccT[2][2][4][2];

struct EpiInProj {
    h16 *qa, *ka, *vat, *xr, *gg, *qd, *kd, *vdt; const f32x2* rope; unsigned* kmax; LAS unsigned char* scr;
    __device__ __forceinline__ void operator()(const AccT& acc, const Unit& u, int wr, int wc, int fr, int fq) const {
        const int pn = u.pn;
        const bool isctx = (u.pm >= NLAT / 256);
        const float QSA = 0.125f * LOG2E, QSD = 0.17677669529663687f * LOG2E;
        float kn2[2] = {0.f, 0.f};
        if (pn == 2 || pn == 9) {
            h16* const vbase = (pn == 2 ? vat : vdt);
            LAS unsigned char* const sw = scr + (wr * 4 + wc) * 1536;
            const int lane = fq * 16 + fr;
#pragma unroll
            for (int ai = 0; ai < 2; ++ai)
#pragma unroll
                for (int m = 0; m < 4; ++m) {
                    const int row0 = u.pm * 256 + ai * 128 + wr * 64 + m * 16;
                    int b, key0;
                    if (isctx) { const int c = row0 - NLAT; b = c >> 8; key0 = SEQ + (c & 255); } else { b = row0 >> 13; key0 = row0 & (SEQ - 1); }
#pragma unroll
                    for (int bj = 0; bj < 2; ++bj) {
#pragma unroll
                        for (int j = 0; j < 8; ++j) *(LAS h16*)(sw + (fq * 8 + j) * 48 + fr * 2) = (h16)acc[ai][bj][m][j >> 2][j & 3];
                        asm volatile("s_waitcnt lgkmcnt(0)" ::: "memory");
                        const u32x4 w = *(const LAS u32x4*)(sw + (lane >> 1) * 48 + (lane & 1) * 16);
                        asm volatile("s_waitcnt lgkmcnt(0)" ::: "memory");
                        *(u32x4*)(vbase + ((size_t)(b * 256 + bj * 128 + wc * 32 + (lane >> 1))) * KEYS + key0 + (lane & 1) * 8) = w;
                    }
                }
            return;
        }
#pragma unroll
        for (int ai = 0; ai < 2; ++ai)
#pragma unroll
            for (int m = 0; m < 4; ++m) {
                const int row = u.pm * 256 + ai * 128 + wr * 64 + m * 16 + fr;
                int b, key, t;
                if (isctx) { const int c = row - NLAT; b = c >> 8; t = c & 255; key = SEQ + t; } else { b = row >> 13; t = row & (SEQ - 1); key = t; }
#pragma unroll
                for (int bj = 0; bj < 2; ++bj) {
                    const int col = bj * 128 + wc * 32 + 8 * fq;
                    float v[8];
#pragma unroll
                    for (int j = 0; j < 4; ++j) { v[j] = acc[ai][bj][m][0][j]; v[4 + j] = acc[ai][bj][m][1][j]; }
                    if (pn == 7 || pn == 8) {
                        float pr[8];
#pragma unroll
                        for (int j = 0; j < 8; ++j) pr[j] = __shfl_xor(v[j], 16);
                        if (!isctx) {
                            const int pos = (fq < 2) ? (t >> 6) : (t & 63);
                            const f32x2* tb = rope + pos * 8;
#pragma unroll
                            for (int j = 0; j < 8; ++j) { const f32x2 cs = tb[j]; const float sn = (fq & 1) ? cs.y : -cs.y; v[j] = v[j] * cs.x + pr[j] * sn; }
                        }
                        if (pn == 8) { float ss = 0.f;
#pragma unroll
                            for (int j = 0; j < 8; ++j) ss += v[j] * v[j];
                            kn2[bj] = fmaxf(kn2[bj], ss); }
                    }
                    {
                        h16* dst; float sc = 1.f;
                        if (pn == 0) { dst = qa + (size_t)row * 256 + col; sc = QSA; }
                        else if (pn == 1) { dst = ka + ((size_t)(b * KEYS + key)) * 256 + col; }
                        else if (pn == 3 || pn == 4) { dst = xr + (size_t)row * 512 + (pn - 3) * 256 + col; }
                        else if (pn == 5 || pn == 6) { dst = gg + (size_t)row * 512 + (pn - 5) * 256 + col;
#pragma unroll
                            for (int j = 0; j < 8; ++j) v[j] = gelu_tanh(v[j]); }
                        else if (pn == 7) { dst = qd + (size_t)row * 256 + col; sc = QSD; }
                        else { dst = kd + ((size_t)(b * KEYS + key)) * 256 + col; }
                        u32x4 w; w.x = pkh(v[0] * sc, v[1] * sc); w.y = pkh(v[2] * sc, v[3] * sc); w.z = pkh(v[4] * sc, v[5] * sc); w.w = pkh(v[6] * sc, v[7] * sc);
                        *(u32x4*)dst = w;
                    }
                }
            }
        if (pn == 8) {
            const int b = isctx ? (u.pm - NLAT / 256) : (u.pm >> 5);
#pragma unroll
            for (int bj = 0; bj < 2; ++bj) {
                float ss = kn2[bj]; ss += __shfl_xor(ss, 16); ss += __shfl_xor(ss, 32);
#pragma unroll
                for (int o = 1; o < 16; o <<= 1) ss = fmaxf(ss, __shfl_xor(ss, o));
                if ((fr | fq) == 0) atomicMax(kmax + (b * 4 + 2 * bj + (wc >> 1)) * 2 + (wc & 1), __float_as_uint(ss));
            }
        }
    }
};

struct EpiOutProj {
    float* xl; const float* mod; float* xo;
    __device__ __forceinline__ void operator()(const AccT& acc, const Unit& u, int wr, int wc, int fr, int fq) const {
        const int vsel = (u.pm >= NLAT / 256) ? 2 : (u.pm >= NLAT / 512 ? 1 : 0);
        const float* ga = mod + vsel * 6144 + 2 * 1024;
#pragma unroll
        for (int bj = 0; bj < 2; ++bj) {
            const int col = u.pn * 256 + bj * 128 + wc * 32 + 8 * fq;
            const f32x4 g0 = *(const f32x4*)(ga + col), g1 = *(const f32x4*)(ga + col + 4);
#pragma unroll
            for (int ai = 0; ai < 2; ++ai)
#pragma unroll
                for (int m = 0; m < 4; ++m) {
                    const int row = u.pm * 256 + ai * 128 + wr * 64 + m * 16 + fr;
                    const float* p = xl + (size_t)row * D + col; float* q = xo + (size_t)row * D + col;
                    f32x4 x0 = *(const f32x4*)p, x1 = *(const f32x4*)(p + 4);
                    x0 += g0 * acc[ai][bj][m][0]; x1 += g1 * acc[ai][bj][m][1];
                    *(f32x4*)q = x0; *(f32x4*)(q + 4) = x1;
                }
        }
    }
};

struct CtxSplitSched {
    const char* mix; const char* wt; int q; unsigned* done_ctr;
    __device__ __forceinline__ void a_ready(const Unit&) const {}
    __device__ __forceinline__ void done(const Unit& u) const { unit_publish(done_ctr + u.pm); }
    __device__ __forceinline__ bool next(int i, Unit& u) const {
        if (i != 0 || q < 0) return false;
        const int pm = NLAT / 256 + (q >> 4), pn = (q >> 2) & 3, kq = q & 3;
        u.pm = pm; u.pn = pn | (kq << 8);
        u.A0 = mix + (size_t)pm * 256 * 2048 + kq * 512; u.A1 = u.A0 + (size_t)128 * 2048;
        u.B0 = wt + (size_t)pn * 256 * 2048 + kq * 512; u.B1 = u.B0 + (size_t)128 * 2048;
        return true;
    }
};
struct EpiOutPart {
    float* part; const float* mod;
    __device__ __forceinline__ void operator()(const AccT& acc, const Unit& u, int wr, int wc, int fr, int fq) const {
        const int pn = u.pn & 255, kq = u.pn >> 8;
        const float* ga = mod + 2 * 6144 + 2 * 1024;
#pragma unroll
        for (int bj = 0; bj < 2; ++bj) {
            const int col = pn * 256 + bj * 128 + wc * 32 + 8 * fq;
            const f32x4 g0 = *(const f32x4*)(ga + col), g1 = *(const f32x4*)(ga + col + 4);
#pragma unroll
            for (int ai = 0; ai < 2; ++ai)
#pragma unroll
                for (int m = 0; m < 4; ++m) {
                    const int crow_ = (u.pm - NLAT / 256) * 256 + ai * 128 + wr * 64 + m * 16 + fr;
                    float* q_ = part + ((size_t)kq * NCTX + crow_) * D + col;
                    *(f32x4*)q_ = g0 * acc[ai][bj][m][0]; *(f32x4*)(q_ + 4) = g1 * acc[ai][bj][m][1];
                }
        }
    }
};

struct MoeSched1 {
    const char* xg; const char* w1t; const char* w3t; const unsigned* tmap; volatile LAS int* tab; int ntiles, G, c; unsigned* done7;
    __device__ __forceinline__ void a_ready(const Unit&) const {}
    __device__ __forceinline__ void done(const Unit& u) const { unit_publish(done7 + u.pm); }
    __device__ __forceinline__ bool next(int i, Unit& u) const {
        const int L = i * G + c; if (L >= ntiles * 4) return false;
        const int Ts = L >> 2, pn = L & 3; int e = 0;
        for (int j = 1; j < NEXP; ++j) e += (tab[j] <= Ts) ? 1 : 0;
        e = __builtin_amdgcn_readfirstlane(e);
        const int T = __builtin_amdgcn_readfirstlane((int)tmap[e * 72 + (Ts - tab[e])] - 1);
        u.pm = T; u.pn = pn;
        u.A0 = xg + (size_t)T * 256 * 4; u.A1 = u.A0;
        const size_t wo = ((size_t)e * DEXP + (size_t)pn * 128) * 2048;
        u.B0 = w1t + wo; u.B1 = w3t + wo;
        return true;
    }
};
struct MoeSched2 {
    const char* act; const char* w2t; const unsigned* tmap; volatile LAS int* tab; int ntiles, G, c; const unsigned* done7; int start, cnt, rest;
    __device__ __forceinline__ void a_ready(const Unit& u) const { unit_wait(done7 + u.pm, 4u); }
    __device__ __forceinline__ void done(const Unit&) const {}
    __device__ __forceinline__ void plan() {
        const int n = ntiles * 4;
        const int base = n / G, r = n - base * G;
        const int T3 = 3 * n;
        int bhi = (T3 / G) - 2 * (base + 1); if (bhi < 0) bhi = 0;
        int blo = (T3 / G) - 2 * base; if (blo < 0) blo = 0;
        long tot = (long)r * bhi + (long)(G - r) * blo;
        if (tot > n) { blo = (int)((n - (long)r * bhi) / (G - r)); if (blo < 0) { blo = 0; bhi = n / (r > 0 ? r : 1); } tot = (long)r * bhi + (long)(G - r) * blo; if (tot > n) { bhi = 0; blo = n / G; tot = (long)G * blo; } }
        start = (c < r) ? c * bhi : r * bhi + (c - r) * blo; cnt = (c < r) ? bhi : blo; rest = (int)tot;
    }
    __device__ __forceinline__ bool next(int i, Unit& u) const {
        int L;
        if (i < cnt) L = start + i; else { L = rest + (i - cnt) * G + c; }
        if (L >= ntiles * 4) return false;
        const int Ts = L >> 2, pn = L & 3; int e = 0;
        for (int j = 1; j < NEXP; ++j) e += (tab[j] <= Ts) ? 1 : 0;
        e = __builtin_amdgcn_readfirstlane(e);
        const int T = __builtin_amdgcn_readfirstlane((int)tmap[e * 72 + (Ts - tab[e])] - 1);
        u.pm = T; u.pn = pn;
        u.A0 = act + (size_t)T * 256 * 1024; u.A1 = u.A0 + (size_t)128 * 1024;
        u.B0 = w2t + ((size_t)e * D + (size_t)pn * 256) * 1024; u.B1 = u.B0 + (size_t)128 * 1024;
        return true;
    }
};
struct EpiMoe1 {
    h16* act;
    __device__ __forceinline__ void operator()(const AccT& acc, const Unit& u, int wr, int wc, int fr, int fq) const {
#pragma unroll
        for (int ai = 0; ai < 2; ++ai)
#pragma unroll
            for (int m = 0; m < 4; ++m) {
                const int row = u.pm * 256 + ai * 128 + wr * 64 + m * 16 + fr;
                float v[8];
#pragma unroll
                for (int n = 0; n < 2; ++n)
#pragma unroll
                    for (int j = 0; j < 4; ++j) { const float a = acc[ai][0][m][n][j], b = acc[ai][1][m][n][j]; v[4 * n + j] = a * frcp_(1.f + fexp_(-a)) * b; }
                u32x4 w; w.x = pkh(v[0], v[1]); w.y = pkh(v[2], v[3]); w.z = pkh(v[4], v[5]); w.w = pkh(v[6], v[7]);
                *(u32x4*)(act + (size_t)row * DEXP + u.pn * 128 + wc * 32 + 8 * fq) = w;
            }
    }
};
struct EpiMoe2 {
    h16* yb;
    __device__ __forceinline__ void operator()(const AccT& acc, const Unit& u, int wr, int wc, int fr, int fq) const {
#pragma unroll
        for (int ai = 0; ai < 2; ++ai)
#pragma unroll
            for (int m = 0; m < 4; ++m) {
                const int row = u.pm * 256 + ai * 128 + wr * 64 + m * 16 + fr;
#pragma unroll
                for (int bj = 0; bj < 2; ++bj) {
                    const f32x4 v0 = acc[ai][bj][m][0], v1 = acc[ai][bj][m][1];
                    u32x4 w; w.x = pkh(v0[0], v0[1]); w.y = pkh(v0[2], v0[3]); w.z = pkh(v1[0], v1[1]); w.w = pkh(v1[2], v1[3]);
                    *(u32x4*)(yb + (size_t)row * D + u.pn * 256 + bj * 128 + wc * 32 + 8 * fq) = w;
                }
            }
    }
};

__device__ __forceinline__ void p0_transpose_item(const float* W, int K, int N, h16* WT, LAS h16* scr, int item, int lane) {
    const int nblk = N / 64, kb = item / nblk, nb = item % nblk, k0 = 64 * kb, n0 = 64 * nb;
    const float* src = W + (size_t)k0 * N + n0 + lane;
#pragma unroll 32
    for (int i = 0; i < 64; ++i) scr[i * 66 + lane] = (h16)src[(size_t)i * N];
    LDS_WAIT(); asm volatile("" ::: "memory");
    const int c = lane & 7;
#pragma unroll
    for (int j = 0; j < 8; ++j) { const int n = (lane >> 3) + 8 * j; const LAS h16* s = scr + (8 * c) * 66 + n;
        h16x8 o;
#pragma unroll
        for (int t = 0; t < 8; ++t) o[t] = s[t * 66];
        *(h16x8*)(WT + (size_t)(n0 + n) * K + k0 + 8 * c) = o; }
    LDS_WAIT(); asm volatile("" ::: "memory");
}

__device__ __forceinline__ void phase_p0(KP p, LAS unsigned char* lds, int vcu, int G) {
    const int tid = tid_now(), lane = tid & 63, wave = __builtin_amdgcn_readfirstlane(tid >> 6);
    unsigned char* ws = p->ws;
    LAS float* sc = (LAS float*)lds;
    LAS float* red = (LAS float*)(lds + 12288);
    for (int i = tid; i < 3 * 1024; i += NTHREADS) { const float x = (i < 2048) ? p->in[I_C][i] : p->in[I_CCTX][i - 2048]; sc[i] = x / (1.f + __expf(-x)); }
    __syncthreads();
    float* mod = (float*)(ws + WS_MOD);
    for (int it = blockIdx.x; it < DEPTH * 96; it += G) {
        const int l = it / 96, nb = it % 96, n = nb * 64 + lane;
        const float* W = p->in[I_WADA] + (size_t)l * D * 6144 + n;
        float a0 = 0.f, a1 = 0.f, a2 = 0.f;
#pragma unroll 32
        for (int k = wave * 128; k < wave * 128 + 128; ++k) { const float w = W[(size_t)k * 6144]; a0 += sc[k] * w; a1 += sc[1024 + k] * w; a2 += sc[2048 + k] * w; }
        red[(wave * 3 + 0) * 64 + lane] = a0; red[(wave * 3 + 1) * 64 + lane] = a1; red[(wave * 3 + 2) * 64 + lane] = a2;
        __syncthreads();
        if (tid < 192) { const int v = tid >> 6, ln = tid & 63; float s = p->in[I_BADA][l * 6144 + nb * 64 + ln];
#pragma unroll
            for (int w = 0; w < 8; ++w) s += red[(w * 3 + v) * 64 + ln];
            mod[((size_t)l * 3 + v) * 6144 + nb * 64 + ln] = s; }
        __syncthreads();
    }
    if (blockIdx.x == 0) {
        f32x2* tab = (f32x2*)(ws + WS_ROPE);
        for (int i = tid; i < 128 * 8; i += NTHREADS) { const int pos = i >> 3, j = i & 7; const float f = powf(10000.f, -(float)j / 8.f); const float ang = (float)pos * f; tab[i] = (f32x2){cosf(ang), sinf(ang)}; }
        if (tid < DEPTH) { const float* lv = p->in[I_DLAM] + tid * 128; float s1 = 0.f, s2 = 0.f;
            for (int j = 0; j < 32; ++j) { s1 += lv[j] * lv[32 + j]; s2 += lv[64 + j] * lv[96 + j]; }
            ((float*)(ws + WS_LAM))[tid] = expf(s1) - expf(s2) + (0.8f - 0.6f * expf(-0.3f * (float)tid)); }
    }
    LAS h16* scr = (LAS h16*)(lds + 32768 + wave * 8448);
    const int gw = vcu * NWAVES + wave, NGW = G * NWAVES;
    constexpr int N_IN = DEPTH * 16 * 40, N_OUT = DEPTH * 16 * 16, N_E = DEPTH * NEXP * 128, N_RG = DEPTH * 2 * 8;
    constexpr int NITEMS = N_IN + N_OUT + 3 * N_E + 2 * N_RG;
    for (int it = gw; it < NITEMS; it += NGW) {
        int r = it;
        if (r < N_IN) { const int l = r / 640; p0_transpose_item(p->in[I_WIN] + (size_t)l * D * INC, D, INC, (h16*)(ws + WS_WIN) + (size_t)l * INC * D, scr, r % 640, lane); continue; } r -= N_IN;
        if (r < N_OUT) { const int l = r / 256; p0_transpose_item(p->in[I_WOUT] + (size_t)l * D * D, D, D, (h16*)(ws + WS_WOUT) + (size_t)l * D * D, scr, r % 256, lane); continue; } r -= N_OUT;
        if (r < N_E) { const int mi = r / 128; p0_transpose_item(p->in[I_W1] + (size_t)mi * D * DEXP, D, DEXP, (h16*)(ws + WS_W1) + (size_t)mi * D * DEXP, scr, r % 128, lane); continue; } r -= N_E;
        if (r < N_E) { const int mi = r / 128; p0_transpose_item(p->in[I_W3] + (size_t)mi * D * DEXP, D, DEXP, (h16*)(ws + WS_W3) + (size_t)mi * D * DEXP, scr, r % 128, lane); continue; } r -= N_E;
        if (r < N_E) { const int mi = r / 128; p0_transpose_item(p->in[I_W2] + (size_t)mi * D * DEXP, DEXP, D, (h16*)(ws + WS_W2) + (size_t)mi * D * DEXP, scr, r % 128, lane); continue; } r -= N_E;
        {
            const int gate = r / N_RG; r %= N_RG; const int mi = r; const int ldir = mi >> 3, nb = mi & 7;
            const float* src = p->in[gate ? I_RGWI : I_RGWR] + (size_t)mi * 4096;
            h16* dst = (h16*)(ws + WS_RGW) + ((size_t)(ldir * 2 + gate) * 8 + nb) * 4096;
            p0_transpose_item(src, 64, 64, dst, scr, 0, lane);
        }
    }
}

__device__ __forceinline__ void phase_norm1(KP p, int l, int mode, volatile LAS int* tab, int vcu, int G, bool dummy) {
    const int tid = tid_now(); const int lane = tid & 63, wave = __builtin_amdgcn_readfirstlane(tid >> 6);
    unsigned char* ws = p->ws;
    float* xl = (float*)(ws + WS_XL); h16* hl = (h16*)(ws + (dummy ? WS_ACT : WS_HL)); float* xlo = dummy ? (float*)(ws + WS_XG) : xl;
    const float* mod = (const float*)(ws + WS_MOD);
    const int* asg = (const int*)(ws + WS_ASG); const float* ew = (const float*)(ws + WS_EW);
    const h16* yb = (const h16*)(ws + WS_YB);
    const int nrows = (mode == 2) ? NLAT : NROW;
    const int prev_rows = (l == DEPTH) ? NLAT : NROW;
    const int gw = vcu * NWAVES + wave, NGW = G * NWAVES;
    for (int row = gw; row < nrows; row += NGW) {
        const int v = (row < NLAT) ? (row >> 13) : 2;
        f32x4 x[4];
        if (mode == 0) {
            const float* src = (row < NLAT) ? p->in[I_X] + (size_t)row * D : p->in[I_CTX] + (size_t)(row - NLAT) * D;
#pragma unroll
            for (int j = 0; j < 4; ++j) x[j] = *(const f32x4*)(src + 4 * lane + 256 * j);
        } else {
            const float* src = xl + (size_t)row * D;
#pragma unroll
            for (int j = 0; j < 4; ++j) x[j] = *(const f32x4*)(src + 4 * lane + 256 * j);
            if (row < prev_rows) {
                const int a0 = asg[row * 2], a1 = asg[row * 2 + 1];
                const float w0 = ew[row * 2], w1 = ew[row * 2 + 1];
                const size_t s0 = (size_t)a0, s1 = (size_t)a1;
                const float* ga = mod + ((size_t)(l - 1) * 3 + v) * 6144 + 5 * 1024;
#pragma unroll
                for (int j = 0; j < 4; ++j) {
                    const int c = 4 * lane + 256 * j;
                    const h16x4 y0 = *(const h16x4*)(yb + s0 * D + c), y1 = *(const h16x4*)(yb + s1 * D + c);
                    const f32x4 g = *(const f32x4*)(ga + c);
#pragma unroll
                    for (int e = 0; e < 4; ++e) x[j][e] += g[e] * (w0 * (float)y0[e] + w1 * (float)y1[e]);
                }
            }
        }
        if (mode != 2) {
            float* dst = xlo + (size_t)row * D;
#pragma unroll
            for (int j = 0; j < 4; ++j) *(f32x4*)(dst + 4 * lane + 256 * j) = x[j];
        }
        float ss = 0.f;
#pragma unroll
        for (int j = 0; j < 4; ++j) ss += x[j][0] * x[j][0] + x[j][1] * x[j][1] + x[j][2] * x[j][2] + x[j][3] * x[j][3];
        const float rstd = rsqrtf(wave_sum(ss) * (1.f / D) + EPS);
        if (mode == 2) {
            const float* g = p->in[I_GFINAL]; float* o = p->out + (size_t)row * D;
#pragma unroll
            for (int j = 0; j < 4; ++j) { const int c = 4 * lane + 256 * j; const f32x4 gv = *(const f32x4*)(g + c); *(f32x4*)(o + c) = x[j] * rstd * gv; }
        } else {
            const float* g = p->in[I_GMIX] + l * D; const float* sh = mod + ((size_t)l * 3 + v) * 6144; const float* scl = sh + 1024;
            h16* o = hl + (size_t)row * D;
#pragma unroll
            for (int j = 0; j < 4; ++j) { const int c = 4 * lane + 256 * j; const f32x4 gv = *(const f32x4*)(g + c), sv = *(const f32x4*)(scl + c), hv = *(const f32x4*)(sh + c);
                const f32x4 y = x[j] * rstd * gv * (1.f + sv) + hv;
                u32x2 w; w.x = pkh(y[0], y[1]); w.y = pkh(y[2], y[3]); *(u32x2*)(o + c) = w; }
        }
    }
}

#define SM_THR 6.0f
#define SOFTMAX_TILE(s, m, l, oA, oB, pfa, pfb) do { \
    float mx_ = fmaxf(fmaxf(s[0], s[1]), s[2]); \
    _Pragma("unroll") for (int r_ = 3; r_ < 15; r_ += 2) mx_ = fmaxf(fmaxf(mx_, s[r_]), s[r_ + 1]); \
    mx_ = fmaxf(mx_, s[15]); mx_ = xhalf_max(mx_); \
    if (__any(mx_ > m + SM_THR)) { const float dl_ = (mx_ > m + SM_THR) ? (mx_ - m) : 0.f; m += dl_; \
        const float al_ = __builtin_amdgcn_exp2f(-dl_); l *= al_; oA *= al_; oB *= al_; } \
    _Pragma("unroll") for (int r_ = 0; r_ < 16; ++r_) s[r_] = __builtin_amdgcn_exp2f(s[r_] - m); \
    { float sm_ = 0.f; _Pragma("unroll") for (int r_ = 0; r_ < 16; ++r_) sm_ += s[r_]; l += sm_; } \
    _Pragma("unroll") for (int j_ = 0; j_ < 8; ++j_) { pfa[j_] = (h16)s[j_]; pfb[j_] = (h16)s[8 + j_]; } \
} while (0)

__device__ __forceinline__ int pi32(int r) { return (r & 19) | (((r >> 3) & 1) << 2) | (((r >> 2) & 1) << 3); }

constexpr int DA_STAGE = 18432;
__device__ __forceinline__ unsigned pkrtz(float a, float b) { return __builtin_bit_cast(unsigned, __builtin_amdgcn_cvt_pkrtz(a, b)); }
__device__ __forceinline__ void da_exp_pack(f32x16& s, float& l, h16x8& pa, h16x8& pb) {
#pragma unroll
    for (int r = 0; r < 16; ++r) s[r] = __builtin_amdgcn_exp2f(s[r]);
    u32x4 wa, wb;
    wa.x = pkrtz(s[0], s[1]); wa.y = pkrtz(s[2], s[3]); wa.z = pkrtz(s[4], s[5]); wa.w = pkrtz(s[6], s[7]);
    wb.x = pkrtz(s[8], s[9]); wb.y = pkrtz(s[10], s[11]); wb.z = pkrtz(s[12], s[13]); wb.w = pkrtz(s[14], s[15]);
    const h16x2 one2 = {(h16)1.f, (h16)1.f};
    const h16x2 t0 = __builtin_bit_cast(h16x2, wa.x) + __builtin_bit_cast(h16x2, wa.y), t1 = __builtin_bit_cast(h16x2, wa.z) + __builtin_bit_cast(h16x2, wa.w);
    const h16x2 t2 = __builtin_bit_cast(h16x2, wb.x) + __builtin_bit_cast(h16x2, wb.y), t3 = __builtin_bit_cast(h16x2, wb.z) + __builtin_bit_cast(h16x2, wb.w);
    const h16x2 u0 = t0 + t1, u1 = t2 + t3;
    l = __builtin_amdgcn_fdot2(u0 + u1, one2, l, false);
    pa = __builtin_bit_cast(h16x8, wa); pb = __builtin_bit_cast(h16x8, wb);
}
__device__ __forceinline__ void diff_unit(KP p, int l, int b, int h, int qrow0, int kt0, int nkt, LAS unsigned char* lds) {
    const int tid = tid_now(), lane = tid & 63, wid = __builtin_amdgcn_readfirstlane(tid >> 6), q32 = lane & 31, hi = lane >> 5;
    unsigned char* ws = p->ws;
    const h16* Qd = (const h16*)(ws + WS_QD); const h16* Kd = (const h16*)(ws + WS_KD); const h16* VdT = (const h16*)(ws + WS_VDT);
    h16* mix = (h16*)(ws + WS_MIX);
    const int qrow = qrow0 + wid * 32 + q32;
    h16x8 qf00, qf01, qf10, qf11;
    {
        const h16* qp = Qd + (size_t)qrow * 256 + h * 64 + hi * 8;
        qf00 = *(const h16x8*)(qp); qf01 = *(const h16x8*)(qp + 16); qf10 = *(const h16x8*)(qp + 32); qf11 = *(const h16x8*)(qp + 48);
    }
    const h16x8 zero8 = {0, 0, 0, 0, 0, 0, 0, 0};
    f32x16 negm0, negm1;
    {
        const float* km = (const float*)((const unsigned*)(ws + WS_CTL) + CW_KMAX + l * 16) + (b * 4 + h) * 2;
        float q0 = 0.f, q1 = 0.f;
#pragma unroll
        for (int j = 0; j < 8; ++j) { q0 += (float)qf00[j] * (float)qf00[j] + (float)qf01[j] * (float)qf01[j]; q1 += (float)qf10[j] * (float)qf10[j] + (float)qf11[j] * (float)qf11[j]; }
        q0 = xhalf_sum(q0); q1 = xhalf_sum(q1);
        const float m0 = sqrtf(q0 * km[0]) * 1.004f + 0.01f - 10.f, m1 = sqrtf(q1 * km[1]) * 1.004f + 0.01f - 10.f;
#pragma unroll
        for (int r = 0; r < 16; ++r) { negm0[r] = -m0; negm1[r] = -m1; }
    }
    const int srow = tid >> 3, sch = tid & 7;
    const h16* kg = Kd + ((size_t)(b * KEYS + kt0 * 64 + srow)) * 256 + h * 64 + sch * 8;
    const h16* vg = VdT + ((size_t)((b * 4 + h) * 64 + srow)) * KEYS + kt0 * 64 + sch * 8;
    const int sto = srow * 144 + sch * 16;
    const int koff = pi32(q32) * 144 + hi * 16, voff = 9216 + q32 * 144 + hi * 16;
    float l0 = 0.f, l1 = 0.f;
    f32x16 o00 = {}, o01 = {}, o10 = {}, o11 = {};
#define DA_MF(a_, b_, c_) __builtin_amdgcn_mfma_f32_32x32x16_f16(a_, b_, c_, 0, 0, 0)
#define DA_KLOAD(addr) do { const LAS unsigned char* kb_ = (addr); kf0a = *(const LAS h16x8*)(kb_); kf0b = *(const LAS h16x8*)(kb_ + 32); kf1a = *(const LAS h16x8*)(kb_ + 64); kf1b = *(const LAS h16x8*)(kb_ + 96); } while (0)
#define DA_VLOAD(addr) do { const LAS unsigned char* vb_ = (addr); v00 = *(const LAS h16x8*)(vb_); v10 = *(const LAS h16x8*)(vb_ + 4608); v01 = *(const LAS h16x8*)(vb_ + 32); v11 = *(const LAS h16x8*)(vb_ + 4608 + 32); } while (0)
#define DA_STEP(PP0a, PP0b, PP1a, PP1b, PN0a, PN0b, PN1a, PN1b, vaddr, kaddr) do { \
        o00 = DA_MF(v00, PP0a, o00); o10 = DA_MF(v00, PP1a, o10); o01 = DA_MF(v10, PP0a, o01); o11 = DA_MF(v10, PP1a, o11); \
        o00 = DA_MF(v01, PP0b, o00); o10 = DA_MF(v01, PP1b, o10); o01 = DA_MF(v11, PP0b, o01); o11 = DA_MF(v11, PP1b, o11); \
        da_exp_pack(s0, l0, PN0a, PN0b); \
        s0 = DA_MF(kf0a, qf00, negm0); s0 = DA_MF(kf0b, qf01, s0); \
        da_exp_pack(s1, l1, PN1a, PN1b); \
        s1 = DA_MF(kf1a, qf10, negm1); s1 = DA_MF(kf1b, qf11, s1); \
        DA_VLOAD(vaddr); DA_KLOAD(kaddr); \
    } while (0)
    __syncthreads();
    u32x4 kreg = *(const u32x4*)kg, vreg = *(const u32x4*)vg;
    *(LAS u32x4*)(lds + sto) = kreg; *(LAS u32x4*)(lds + 9216 + sto) = vreg;
    kreg = *(const u32x4*)(kg + (size_t)64 * 256); vreg = *(const u32x4*)(vg + 64);
    *(LAS u32x4*)(lds + DA_STAGE + sto) = kreg; *(LAS u32x4*)(lds + DA_STAGE + 9216 + sto) = vreg;
    if (nkt > 2) { kreg = *(const u32x4*)(kg + (size_t)2 * 64 * 256); vreg = *(const u32x4*)(vg + 2 * 64); }
    __syncthreads();
    f32x16 s0, s1;
    h16x8 kf0a, kf0b, kf1a, kf1b, v00, v10, v01, v11;
    h16x8 pa0a = zero8, pa0b = zero8, pa1a = zero8, pa1b = zero8, pb0a = zero8, pb0b = zero8, pb1a = zero8, pb1b = zero8;
    DA_KLOAD(lds + koff);
    s0 = DA_MF(kf0a, qf00, negm0); s0 = DA_MF(kf0b, qf01, s0);
    s1 = DA_MF(kf1a, qf10, negm1); s1 = DA_MF(kf1b, qf11, s1);
    DA_KLOAD(lds + koff + 4608);
    DA_VLOAD(lds + voff);
    int cur = 0, nxt = DA_STAGE, wrs = 2 * DA_STAGE;
    for (int t = 0; t < nkt; ++t) {
        if (t + 2 < nkt) { *(LAS u32x4*)(lds + wrs + sto) = kreg; *(LAS u32x4*)(lds + wrs + 9216 + sto) = vreg; }
        if (t + 3 < nkt) { kreg = *(const u32x4*)(kg + (size_t)(t + 3) * 64 * 256); vreg = *(const u32x4*)(vg + (size_t)(t + 3) * 64); }
        const int pf = (t + 1 < nkt) ? nxt : cur;
        DA_STEP(pb0a, pb0b, pb1a, pb1b, pa0a, pa0b, pa1a, pa1b, lds + cur + voff, lds + pf + koff);
        DA_STEP(pa0a, pa0b, pa1a, pa1b, pb0a, pb0b, pb1a, pb1b, lds + cur + voff + 64, lds + pf + koff + 4608);
        { const int tmp = cur; cur = nxt; nxt = wrs; wrs = tmp; }
        __syncthreads();
    }
    o00 = DA_MF(v00, pb0a, o00); o10 = DA_MF(v00, pb1a, o10); o01 = DA_MF(v10, pb0a, o01); o11 = DA_MF(v10, pb1a, o11);
    o00 = DA_MF(v01, pb0b, o00); o10 = DA_MF(v01, pb1b, o10); o01 = DA_MF(v11, pb0b, o01); o11 = DA_MF(v11, pb1b, o11);
#undef DA_MF
#undef DA_KLOAD
#undef DA_VLOAD
#undef DA_STEP
    const float lam = ((const float*)(ws + WS_LAM))[l];
    const float lam_init = 0.8f - 0.6f * expf(-0.3f * (float)l);
    const float r0 = 1.f / xhalf_sum(l0), r1 = lam / xhalf_sum(l1);
    f32x16 y0 = o00 * r0 - o10 * r1, y1 = o01 * r0 - o11 * r1;
    float ss = 0.f;
#pragma unroll
    for (int r = 0; r < 16; ++r) ss += y0[r] * y0[r] + y1[r] * y1[r];
    ss = xhalf_sum(ss);
    const float sc = rsqrtf(ss * (1.f / 64.f) + EPS) * (1.f - lam_init);
    const float* g = p->in[I_DSUBG] + l * 64;
    h16* dst = mix + (size_t)qrow * D + 768 + h * 64;
#pragma unroll
    for (int r4 = 0; r4 < 4; ++r4) {
        const int e0 = 8 * r4 + 4 * hi;
        const f32x4 g0 = *(const f32x4*)(g + e0), g1 = *(const f32x4*)(g + 32 + e0);
        u32x2 w0, w1;
        w0.x = pkh(y0[4 * r4] * sc * g0[0], y0[4 * r4 + 1] * sc * g0[1]); w0.y = pkh(y0[4 * r4 + 2] * sc * g0[2], y0[4 * r4 + 3] * sc * g0[3]);
        w1.x = pkh(y1[4 * r4] * sc * g1[0], y1[4 * r4 + 1] * sc * g1[1]); w1.y = pkh(y1[4 * r4 + 2] * sc * g1[2], y1[4 * r4 + 3] * sc * g1[3]);
        *(u32x2*)(dst + e0) = w0; *(u32x2*)(dst + 32 + e0) = w1;
    }
}

constexpr int NA_K = 0, NA_V = 33792, NA_BIAS = 33792 + 36864;
__device__ __forceinline__ void na_unit(KP p, int l, int b, int gr, bool isctx, LAS unsigned char* lds) {
    const int tid = tid_now(), lane = tid & 63, wid = __builtin_amdgcn_readfirstlane(tid >> 6), q32 = lane & 31, hi = lane >> 5;
    const int h = wid >> 1, qt = wid & 1;
    unsigned char* ws = p->ws;
    const h16* qa = (const h16*)(ws + WS_QA); const h16* Ka = (const h16*)(ws + WS_KA); const h16* VaT = (const h16*)(ws + WS_VAT);
    h16* mix = (h16*)(ws + WS_MIX);
    const int qrow = isctx ? (NLAT + b * CTX + gr * 64 + qt * 32 + q32) : (b * SEQ + gr * 64 + qt * 32 + q32);
    h16x8 qf[4];
#pragma unroll
    for (int ks = 0; ks < 4; ++ks) qf[ks] = *(const h16x8*)(qa + (size_t)qrow * 256 + h * 64 + ks * 16 + hi * 8);
    const int nloc = isctx ? 0 : 8, ntile = nloc + 4;
    int kr0 = gr - 4; kr0 = kr0 < 0 ? 0 : (kr0 > 120 ? 120 : kr0);
    LAS float* bias = (LAS float*)(lds + NA_BIAS);
    __syncthreads();
    if (!isctx) { const float* rp = p->in[I_RPB] + (size_t)l * 4 * 15 * 31; for (int i = tid; i < 4 * 15 * 31; i += NTHREADS) bias[i] = rp[i] * LOG2E; }
    const int koff = NA_K + pi32(q32) * 528 + h * 128 + hi * 16;
    const int voff = NA_V + (h * 64 + q32) * 144 + hi * 16;
    const int cq = qt * 32 + q32; int cs = cq - 8; cs = cs < 0 ? 0 : (cs > 48 ? 48 : cs);
    float m = 0.f, ls = 0.f; f32x16 o0 = {}, o1 = {};
    u32x4 kpre[4], vpre[4];
#define NA_LOAD(t_) do { const int key0_ = ((t_) < nloc) ? (kr0 + (t_)) * 64 : SEQ + ((t_) - nloc) * 64; \
        _Pragma("unroll") for (int i = 0; i < 4; ++i) { const int id = tid + 512 * i; \
            kpre[i] = *(const u32x4*)(Ka + ((size_t)(b * KEYS + key0_ + (id >> 5))) * 256 + (id & 31) * 8); \
            vpre[i] = *(const u32x4*)(VaT + ((size_t)(b * 256 + (id >> 3))) * KEYS + key0_ + (id & 7) * 8); } } while (0)
    NA_LOAD(0);
    for (int t = 0; t < ntile; ++t) {
        __syncthreads();
#pragma unroll
        for (int i = 0; i < 4; ++i) { const int id = tid + 512 * i;
            *(LAS u32x4*)(lds + NA_K + (id >> 5) * 528 + (id & 31) * 16) = kpre[i];
            *(LAS u32x4*)(lds + NA_V + (id >> 3) * 144 + (id & 7) * 16) = vpre[i]; }
        __syncthreads();
        if (t + 1 < ntile) NA_LOAD(t + 1);
#pragma unroll
        for (int th = 0; th < 2; ++th) {
            f32x16 s = {};
#pragma unroll
            for (int ks = 0; ks < 4; ++ks) { const h16x8 kf = *(const LAS h16x8*)(lds + koff + th * 32 * 528 + ks * 32); s = __builtin_amdgcn_mfma_f32_32x32x16_f16(kf, qf[ks], s, 0, 0, 0); }
            if (t < nloc) {
                const int dr = kr0 + t - gr;
                const LAS float* browl = bias + (h * 15 + dr + 7) * 31 + 15 - cq + 8 * hi; const int dwin = 8 * hi - cs;
#pragma unroll
                for (int r = 0; r < 16; ++r) { const int cr_ = 32 * th + 16 * (r >> 3) + (r & 7);
                    s[r] = ((unsigned)(cr_ + dwin) < 16u) ? s[r] + browl[cr_] : -INFINITY; }
            }
            h16x8 pa, pb;
            SOFTMAX_TILE(s, m, ls, o0, o1, pa, pb);
            const h16x8 v00 = *(const LAS h16x8*)(lds + voff + th * 64), v10 = *(const LAS h16x8*)(lds + voff + 32 * 144 + th * 64);
            const h16x8 v01 = *(const LAS h16x8*)(lds + voff + th * 64 + 32), v11 = *(const LAS h16x8*)(lds + voff + 32 * 144 + th * 64 + 32);
            o0 = __builtin_amdgcn_mfma_f32_32x32x16_f16(v00, pa, o0, 0, 0, 0); o1 = __builtin_amdgcn_mfma_f32_32x32x16_f16(v10, pa, o1, 0, 0, 0);
            o0 = __builtin_amdgcn_mfma_f32_32x32x16_f16(v01, pb, o0, 0, 0, 0); o1 = __builtin_amdgcn_mfma_f32_32x32x16_f16(v11, pb, o1, 0, 0, 0);
        }
    }
    const float rl = 1.f / xhalf_sum(ls);
    h16* dst = mix + (size_t)qrow * D + h * 64;
#pragma unroll
    for (int r4 = 0; r4 < 4; ++r4) {
        const int e0 = 8 * r4 + 4 * hi; u32x2 w0, w1;
        w0.x = pkh(o0[4 * r4] * rl, o0[4 * r4 + 1] * rl); w0.y = pkh(o0[4 * r4 + 2] * rl, o0[4 * r4 + 3] * rl);
        w1.x = pkh(o1[4 * r4] * rl, o1[4 * r4 + 1] * rl); w1.y = pkh(o1[4 * r4 + 2] * rl, o1[4 * r4 + 3] * rl);
        *(u32x2*)(dst + e0) = w0; *(u32x2*)(dst + 32 + e0) = w1;
    }
}

constexpr int RG_X32 = 0, RG_X16 = 16384, RG_W = 25600, RG_AB = 62464, RG_SEG = 128000;
__device__ __forceinline__ void rg_load_x(h16x8 (&xv)[4], const h16* xr, int q, int tid, bool valid) {
    const int RT = q >> 3, nb = q & 7;
    const int r = tid >> 3, ch = nb * 64 + (tid & 7) * 8;
    const bool isctx = RT >= 256; const int j = isctx ? ((RT - 256) & 3) : (RT & 127); const int seqlen = isctx ? CTX : SEQ;
#pragma unroll
    for (int tap = 0; tap < 4; ++tap) {
        const int t = j * 64 + r + tap - 2;
        if (valid && t >= 0 && t < seqlen) xv[tap] = *(const h16x8*)(xr + (size_t)(RT * 64 + r + tap - 2) * 512 + ch);
        else xv[tap] = (h16x8){0, 0, 0, 0, 0, 0, 0, 0};
    }
}
__device__ __forceinline__ void rg_gate_block(KP p, int l, int q0, int qstride, int qend, LAS unsigned char* lds, const int mode) {
    const int tid = tid_now(), lane = tid & 63, wid = __builtin_amdgcn_readfirstlane(tid >> 6), q32 = lane & 31, hi = lane >> 5;
    unsigned char* ws = p->ws;
    const h16* xr = (const h16*)(ws + WS_XR);
    float* agg = (float*)(ws + WS_AGG);
    const h16* gg = (const h16*)(ws + WS_GG); h16* mix = (h16*)(ws + WS_MIX);
    LAS float* x32 = (LAS float*)(lds + RG_X32); LAS h16* x16 = (LAS h16*)(lds + RG_X16); LAS h16* Wl = (LAS h16*)(lds + RG_W); LAS float* ab = (LAS float*)(lds + RG_AB); LAS float* seg = (LAS float*)(lds + RG_SEG);
    LAS float* carryL = (LAS float*)(lds + RG_SEG + 4096);
    if (q0 >= qend) return;
    const int nb0 = q0 & 7;
    const bool skip_ctx_out = (l == DEPTH - 1);
    h16x8 xv[4];
    rg_load_x(xv, xr, q0, tid, true);
    if (mode == 1 && tid < 256) {
        const int dir = tid >> 7, b = (tid >> 6) & 1, chl = tid & 63;
        const float* ag = agg + ((((size_t)dir * 2 + b) * 132) * 512 + nb0 * 64 + chl) * 2;
        float h = 0.f;
#pragma unroll 1
        for (int c0 = 0; c0 < 132; c0 += 33) {
            f32x2 v[33];
#pragma unroll
            for (int i = 0; i < 33; ++i) v[i] = *(const f32x2*)(ag + (size_t)(c0 + i) * 1024);
#pragma unroll
            for (int i = 0; i < 33; ++i) {
                const int c = c0 + i;
                int RT; if (dir == 0) RT = (c < 4) ? 256 + 4 * b + c : 128 * b + (c - 4); else RT = (c < 4) ? 256 + 4 * b + (3 - c) : 128 * b + 127 - (c - 4);
                const int dq = RT * 8 + nb0 - q0;
                if (dq >= 0 && (dq % qstride) == 0 && dq / qstride < 12) carryL[((dq / qstride) * 2 + dir) * 64 + chl] = h;
                h = v[i].x * h + v[i].y;
            }
        }
    }
    int cur_nb = -1;
    float cwr[4][8], cbr[8]; float g_br, g_bi, g_sp;
#define RG_LOAD_CONSTS(nb_) do { \
        const int ch_ = (nb_) * 64 + (tid & 7) * 8; const float* cw_ = p->in[I_CONVW] + (size_t)l * 4 * 512 + ch_; const float* cb_ = p->in[I_CONVB] + l * 512 + ch_; \
        _Pragma("unroll") for (int e = 0; e < 8; ++e) { cbr[e] = cb_[e]; _Pragma("unroll") for (int tap = 0; tap < 4; ++tap) cwr[tap][e] = cw_[tap * 512 + e]; } \
        const int dir_ = wid >> 2, chg_ = (nb_) * 64 + ((wid >> 1) & 1) * 32 + q32; \
        g_br = p->in[I_RGBR][(l * 2 + dir_) * 512 + chg_]; g_bi = p->in[I_RGBI][(l * 2 + dir_) * 512 + chg_]; \
        const float lamv_ = p->in[I_RGLAM][(l * 2 + dir_) * 512 + chg_]; g_sp = (lamv_ > 15.f) ? __expf(-lamv_) : log1pf(__expf(-lamv_)); } while (0)
    RG_LOAD_CONSTS(nb0);
    int const_nb = nb0;
    __syncthreads();
    int kt = 0;
    for (int q = q0; q < qend; q += qstride, ++kt) {
        const int RT = q >> 3, nb = q & 7;
        const int row0 = RT * 64;
        const bool isctx = RT >= 256; int b, j;
        if (isctx) { const int qq = RT - 256; b = qq >> 2; j = qq & 3; } else { b = RT >> 7; j = RT & 127; }
        h16x8 ggv;
        {
            const int r = tid >> 3, c8 = (tid & 7) * 8, ch = nb * 64 + c8;
            if (mode == 1) ggv = *(const h16x8*)(gg + (size_t)(row0 + r) * 512 + ch);
            if (nb != const_nb) { RG_LOAD_CONSTS(nb); const_nb = nb; }
            float accv[8];
#pragma unroll
            for (int e = 0; e < 8; ++e) accv[e] = cbr[e];
#pragma unroll
            for (int tap = 0; tap < 4; ++tap)
#pragma unroll
                for (int e = 0; e < 8; ++e) accv[e] += (float)xv[tap][e] * cwr[tap][e];
            *(LAS f32x4*)(x32 + r * 64 + c8) = (f32x4){accv[0], accv[1], accv[2], accv[3]}; *(LAS f32x4*)(x32 + r * 64 + c8 + 4) = (f32x4){accv[4], accv[5], accv[6], accv[7]};
            { u32x4 w; w.x = pkh(accv[0], accv[1]); w.y = pkh(accv[2], accv[3]); w.z = pkh(accv[4], accv[5]); w.w = pkh(accv[6], accv[7]); *(LAS u32x4*)(x16 + r * 72 + c8) = w; }
            if (nb != cur_nb) {
                const h16* wsrc = (const h16*)(ws + WS_RGW);
#pragma unroll
                for (int i = 0; i < 4; ++i) { const int id = tid + 512 * i; const int n = id >> 3, kc = id & 7; const int dg = n >> 6, nn = n & 63;
                    *(LAS u32x4*)(Wl + n * 72 + kc * 8) = *(const u32x4*)(wsrc + (((size_t)(l * 4 + dg) * 8 + nb) * 64 + nn) * 64 + kc * 8); }
                cur_nb = nb;
            }
        }
        lds_barrier();
        rg_load_x(xv, xr, q + qstride, tid, q + qstride < qend);
        {
            const int mt = wid & 1, g = wid >> 1, dir = g >> 1, ch2 = g & 1;
            f32x16 cr = {}, ci = {};
#pragma unroll
            for (int ks = 0; ks < 4; ++ks) {
                const h16x8 af = *(const LAS h16x8*)(x16 + (mt * 32 + q32) * 72 + ks * 16 + hi * 8);
                const h16x8 br = *(const LAS h16x8*)(Wl + (dir * 128 + ch2 * 32 + q32) * 72 + ks * 16 + hi * 8);
                const h16x8 bi = *(const LAS h16x8*)(Wl + (dir * 128 + 64 + ch2 * 32 + q32) * 72 + ks * 16 + hi * 8);
                cr = __builtin_amdgcn_mfma_f32_32x32x16_f16(af, br, cr, 0, 0, 0);
                ci = __builtin_amdgcn_mfma_f32_32x32x16_f16(af, bi, ci, 0, 0, 0);
            }
            const int chl = ch2 * 32 + q32;
            const float b_r = g_br, b_i = g_bi, sp = g_sp;
#pragma unroll
            for (int r = 0; r < 16; ++r) {
                const int tr = mt * 32 + crow(r, hi);
                const float rg = sigmoidf_(cr[r] + b_r), ig = sigmoidf_(ci[r] + b_i);
                const float la = -8.f * rg * sp;
                const float a = fexp_(la);
                const float x2 = 2.f * la;
                float om;
                if (x2 > -0.3f) om = -x2 * (1.f + x2 * (0.5f + x2 * (0.16666667f + x2 * (0.041666668f + x2 * (0.0083333338f + x2 * 0.0013888889f))))); else om = 1.f - fexp_(x2);
                const float bx = __builtin_amdgcn_sqrtf(om) * ig * x32[tr * 64 + chl];
                ab[((dir * 2 + 0) * 64 + tr) * 64 + chl] = a; ab[((dir * 2 + 1) * 64 + tr) * 64 + chl] = bx;
            }
        }
        lds_barrier();
        if (mode == 0) {
            {
                const int sg = tid >> 7, dir = (tid >> 6) & 1, chl = tid & 63; float A = 1.f, H = 0.f;
                const LAS float* pa = ab + (dir * 2 + 0) * 4096 + sg * 16 * 64 + chl; const LAS float* pb = ab + (dir * 2 + 1) * 4096 + sg * 16 * 64 + chl;
                if (dir == 0) {
#pragma unroll
                    for (int r = 0; r < 16; ++r) { const float a = pa[r * 64]; H = a * H + pb[r * 64]; A *= a; }
                } else {
#pragma unroll
                    for (int r = 15; r >= 0; --r) { const float a = pa[r * 64]; H = a * H + pb[r * 64]; A *= a; }
                }
                seg[((dir * 4 + sg) * 64 + chl) * 2] = A; seg[((dir * 4 + sg) * 64 + chl) * 2 + 1] = H;
            }
            lds_barrier();
            if (tid < 128) {
                const int dir = tid >> 6, chl = tid & 63; float A = 1.f, H = 0.f;
#pragma unroll
                for (int i = 0; i < 4; ++i) { const int sg = dir ? 3 - i : i; const float a = seg[((dir * 4 + sg) * 64 + chl) * 2], hh = seg[((dir * 4 + sg) * 64 + chl) * 2 + 1]; H = a * H + hh; A *= a; }
                int c;
                if (dir == 0) c = isctx ? j : 4 + j; else c = isctx ? 3 - j : 4 + 127 - j;
                float* dst = agg + ((((size_t)dir * 2 + b) * 132 + c) * 512 + nb * 64 + chl) * 2;
                dst[0] = A; dst[1] = H;
            }
        } else {
            if (tid < 128) {
                const int dir = tid >> 6, chl = tid & 63;
                float h = carryL[(kt * 2 + dir) * 64 + chl];
                LAS float* pa = ab + (dir * 2 + 0) * 4096 + chl; LAS float* pb = ab + (dir * 2 + 1) * 4096 + chl;
#pragma unroll 1
                for (int g0 = 0; g0 < 64; g0 += 16) {
                    const int r0 = dir ? 48 - g0 : g0;
                    float av[16], bv[16];
#pragma unroll
                    for (int i = 0; i < 16; ++i) { av[i] = pa[(r0 + i) * 64]; bv[i] = pb[(r0 + i) * 64]; }
                    if (dir == 0) {
#pragma unroll
                        for (int i = 0; i < 16; ++i) { h = av[i] * h + bv[i]; bv[i] = h; }
                    } else {
#pragma unroll
                        for (int i = 15; i >= 0; --i) { h = av[i] * h + bv[i]; bv[i] = h; }
                    }
#pragma unroll
                    for (int i = 0; i < 16; ++i) pb[(r0 + i) * 64] = bv[i];
                }
            }
            lds_barrier();
            if (!(isctx && skip_ctx_out)) {
                const int r = tid >> 3, c8 = (tid & 7) * 8;
                const LAS float* hf = ab + (0 * 2 + 1) * 4096 + r * 64 + c8; const LAS float* hb = ab + (1 * 2 + 1) * 4096 + r * 64 + c8;
                u32x4 w;
                w.x = pkh((hf[0] + hb[0]) * (float)ggv[0], (hf[1] + hb[1]) * (float)ggv[1]); w.y = pkh((hf[2] + hb[2]) * (float)ggv[2], (hf[3] + hb[3]) * (float)ggv[3]);
                w.z = pkh((hf[4] + hb[4]) * (float)ggv[4], (hf[5] + hb[5]) * (float)ggv[5]); w.w = pkh((hf[6] + hb[6]) * (float)ggv[6], (hf[7] + hb[7]) * (float)ggv[7]);
                *(u32x4*)(mix + (size_t)(row0 + r) * D + 256 + nb * 64 + c8) = w;
            }
        }
    }
}

__device__ __forceinline__ void phase_mix(KP p, int l, LAS unsigned char* lds, int G) {
    const bool last = (l == DEPTH - 1);
    const int n_dc = last ? 0 : 8, n_nc = last ? 0 : 8;
    const int U0 = 256, U1 = U0 + n_dc, U2 = U1 + 256, U3 = U2 + n_nc, U4 = U3 + 264 * 8;
    int u = blockIdx.x;
    for (; u < U3; u += G) {
        if (u < U0) { const int bh = u >> 5, qb = u & 31; REP(30) diff_unit(p, l, bh >> 2, bh & 3, (bh >> 2) * SEQ + qb * 256, 0, 132, lds); }
        else if (u < U1) { const int bh = u - U0; diff_unit(p, l, bh >> 2, bh & 3, NLAT + (bh >> 2) * CTX, 128, 4, lds); }
        else if (u < U2) { const int q = u - U1; REP(31) na_unit(p, l, q >> 7, q & 127, false, lds); }
        else { const int q = u - U2; na_unit(p, l, q >> 2, q & 3, true, lds); }
    }
    REP(32) rg_gate_block(p, l, u - U3, G, U4 - U3, lds, 0);
}

__device__ __forceinline__ void phase_scan(KP p, int l, LAS unsigned char* lds, int G) {
    const bool last = (l == DEPTH - 1);
    const int U3 = 256 + (last ? 0 : 8) + 256 + (last ? 0 : 8);
    int u = blockIdx.x; while (u < U3) u += G;
    rg_gate_block(p, l, u - U3, G, 264 * 8, lds, 1);
}

__device__ __forceinline__ void phase_route(KP p, int l, LAS unsigned char* lds, int vcu, int G, bool dummy) {
    const int tid = tid_now(), lane = tid & 63, wave = __builtin_amdgcn_readfirstlane(tid >> 6);
    unsigned char* ws = p->ws;
    const float* xl = (const float*)(ws + WS_XL); h16* xg = (h16*)(ws + (dummy ? WS_YB : WS_XG));
    const float* mod = (const float*)(ws + WS_MOD);
    int* asg = (int*)(ws + (dummy ? 7 * MiB : WS_ASG)); float* ew = (float*)(ws + (dummy ? 7 * MiB + 512 * 1024 : WS_EW));
    unsigned* cnt = (unsigned*)(ws + WS_CTL) + CW_CNT + l * 32 + (dummy ? 512 : 0);
    unsigned* pool = (unsigned*)(ws + WS_CTL) + CW_POOL + l + (dummy ? 8 : 0); unsigned* tmap = (unsigned*)(ws + WS_CTL) + (dummy ? 32768 : CW_TMAP) + l * 32 * 72; unsigned* owner = (unsigned*)(ws + WS_CTL) + (dummy ? 45000 : CW_OWNER) + l * 192;
    const int nrows = (l == DEPTH - 1) ? NLAT : NROW;
    LAS h16* xh = (LAS h16*)lds; LAS h16* xlo = (LAS h16*)(lds + 33024); LAS float* part = (LAS float*)(lds + 66048); LAS float* logit = (LAS float*)(lds + 90624);
    const float* wg = p->in[I_RWG] + (size_t)l * D * 4; const float* we = p->in[I_RWE] + (size_t)l * D * 32;
    const float* g = p->in[I_GFFN] + l * D;
    const int c16 = lane & 15, kq = lane >> 4;
    h16x8 bh[4][3], bl[4][3];
#pragma unroll
    for (int ks = 0; ks < 4; ++ks)
#pragma unroll
        for (int nt = 0; nt < 3; ++nt) {
            const int n = nt * 16 + c16;
#pragma unroll
            for (int j = 0; j < 8; ++j) {
                const int k = wave * 128 + ks * 32 + kq * 8 + j;
                float w = (n < 32) ? we[(size_t)k * 32 + n] : ((n < 36) ? wg[(size_t)k * 4 + (n - 32)] : 0.f);
                w *= 64.f; const h16 hh = (h16)w; bh[ks][nt][j] = hh; bl[ks][nt][j] = (h16)(w - (float)hh);
            }
        }
    LAS int* r_e = (LAS int*)(lds + 93184);
    LAS int* r_rk = r_e + 80;
    LAS float* r_w = (LAS float*)(r_rk + 80);
    LAS int* hist = (LAS int*)(r_w + 160);
    LAS int* baseL = hist + 32;
    LAS int* slotL = baseL + 32;
    h16* hl = (h16*)(ws + WS_HL);
    int* rlist = (int*)((unsigned*)(ws + WS_CTL) + CW_RLIST + l * (MAXTILES * 256));
    if (tid < 32) hist[tid] = 0;
    const int ngroups = nrows / 16;
    int nloc = 0;
    const unsigned* done5 = (const unsigned*)(ws + WS_CTL) + CW_D5 + l * 128;
    const int nskip = 0;
    const int rG = G - (nskip > 0 ? nskip : 0), ridx = (int)blockIdx.x - (nskip > 0 ? nskip : 0);
    if (ridx < 0) return;
    if (tid < 64) {
        for (int grp = ridx; grp < ngroups; grp += rG) {
            const unsigned need = (grp >> 4) >= NLAT / 256 ? 16u : 4u; unsigned spins = 0;
            while ((unsigned)__builtin_amdgcn_readfirstlane(__hip_atomic_load(done5 + (grp >> 4), __ATOMIC_RELAXED, __HIP_MEMORY_SCOPE_AGENT)) < need) { __builtin_amdgcn_s_sleep(2); if (++spins > (1u << 24)) break; }
        }
        __builtin_amdgcn_fence(__ATOMIC_ACQUIRE, "agent");
        asm volatile("s_waitcnt vmcnt(0)" ::: "memory");
    }
    __syncthreads();
    f32x4 xr[2][4];
#define R6_LOAD(grp_) do { _Pragma("unroll") for (int rr = 0; rr < 2; ++rr) { const int row_ = (grp_) * 16 + wave * 2 + rr; \
            _Pragma("unroll") for (int j = 0; j < 4; ++j) xr[rr][j] = *(const f32x4*)(xl + (size_t)row_ * D + 4 * lane + 256 * j); } } while (0)
    if (ridx < ngroups) R6_LOAD(ridx);
    for (int grp = ridx, kk = 0; grp < ngroups; grp += rG, ++kk) {
        lds_barrier();
#pragma unroll
        for (int rr = 0; rr < 2; ++rr) {
            const int lr = wave * 2 + rr, row = grp * 16 + lr; const int v = (row < NLAT) ? (row >> 13) : 2;
            f32x4 x[4]; float ss = 0.f;
#pragma unroll
            for (int j = 0; j < 4; ++j) x[j] = xr[rr][j];
            if (row >= NLAT && l != DEPTH - 1) {
                const float* pp = (const float*)(ws + WS_RGA) + (size_t)(row - NLAT) * D;
#pragma unroll
                for (int kq = 0; kq < 4; ++kq)
#pragma unroll
                    for (int j = 0; j < 4; ++j) x[j] += *(const f32x4*)(pp + (size_t)kq * NCTX * D + 4 * lane + 256 * j);
#pragma unroll
                for (int j = 0; j < 4; ++j) *(f32x4*)((float*)(ws + WS_XL) + (size_t)row * D + 4 * lane + 256 * j) = x[j];
            }
#pragma unroll
            for (int j = 0; j < 4; ++j) ss += x[j][0] * x[j][0] + x[j][1] * x[j][1] + x[j][2] * x[j][2] + x[j][3] * x[j][3];
            const float rstd = rsqrtf(wave_sum(ss) * (1.f / D) + EPS);
            const float* sh = mod + ((size_t)l * 3 + v) * 6144 + 3 * 1024; const float* scl = sh + 1024;
            h16* o = hl + (size_t)row * D;
#pragma unroll
            for (int j = 0; j < 4; ++j) { const int c = 4 * lane + 256 * j; const f32x4 gv = *(const f32x4*)(g + c), sv = *(const f32x4*)(scl + c), hv = *(const f32x4*)(sh + c);
                const f32x4 y = x[j] * rstd * gv * (1.f + sv) + hv;
                h16x4 yh, yl;
#pragma unroll
                for (int e = 0; e < 4; ++e) { yh[e] = (h16)y[e]; yl[e] = (h16)(y[e] - (float)yh[e]); }
                *(LAS h16x4*)(xh + lr * 1032 + c) = yh; *(LAS h16x4*)(xlo + lr * 1032 + c) = yl; *(h16x4*)(o + c) = yh; }
        }
        if (grp + rG < ngroups) R6_LOAD(grp + rG);
        lds_barrier();
        {
            f32x4 acc[3] = {{0.f, 0.f, 0.f, 0.f}, {0.f, 0.f, 0.f, 0.f}, {0.f, 0.f, 0.f, 0.f}};
#pragma unroll
            for (int ks = 0; ks < 4; ++ks) {
                const int ko = c16 * 1032 + wave * 128 + ks * 32 + kq * 8;
                const h16x8 ah = *(const LAS h16x8*)(xh + ko), al = *(const LAS h16x8*)(xlo + ko);
#pragma unroll
                for (int nt = 0; nt < 3; ++nt) {
                    acc[nt] = __builtin_amdgcn_mfma_f32_16x16x32_f16(ah, bh[ks][nt], acc[nt], 0, 0, 0);
                    acc[nt] = __builtin_amdgcn_mfma_f32_16x16x32_f16(ah, bl[ks][nt], acc[nt], 0, 0, 0);
                    acc[nt] = __builtin_amdgcn_mfma_f32_16x16x32_f16(al, bh[ks][nt], acc[nt], 0, 0, 0);
                }
            }
#pragma unroll
            for (int nt = 0; nt < 3; ++nt)
#pragma unroll
                for (int r = 0; r < 4; ++r) part[(wave * 16 + kq * 4 + r) * 48 + nt * 16 + c16] = acc[nt][r];
        }
        lds_barrier();
        for (int i = tid; i < 16 * 36; i += NTHREADS) { const int r = i / 36, o = i % 36; const int n = (o < 4) ? 32 + o : o - 4;
            float sacc = 0.f;
#pragma unroll
            for (int w = 0; w < 8; ++w) sacc += part[(w * 16 + r) * 48 + n];
            logit[i] = sacc * (1.f / 64.f) + ((o < 4) ? p->in[I_RBG][l * 4 + o] : p->in[I_RBE][l * 32 + o - 4]); }
        lds_barrier();
        if (tid < 16) {
            const LAS float* lg = logit + tid * 36;
            int gi = 0; float gm = lg[0];
#pragma unroll
            for (int i = 1; i < 4; ++i) if (lg[i] > gm) { gm = lg[i]; gi = i; }
            float gs = 0.f;
#pragma unroll
            for (int i = 0; i < 4; ++i) gs += __expf(lg[i] - gm);
            const float gtop = 1.f / gs;
            const LAS float* el = lg + 4 + gi * 8;
            int i1 = 0; float m1 = el[0];
#pragma unroll
            for (int i = 1; i < 8; ++i) if (el[i] > m1) { m1 = el[i]; i1 = i; }
            int i2 = -1; float m2 = -INFINITY;
#pragma unroll
            for (int i = 0; i < 8; ++i) if (i != i1 && el[i] > m2) { m2 = el[i]; i2 = i; }
            const float e2 = __expf(m2 - m1); const float inv = 1.f / (1.f + e2);
            const int ea = gi * 8 + i1, eb = gi * 8 + i2;
            const int ra = atomicAdd((int*)(hist + ea), 1), rb = atomicAdd((int*)(hist + eb), 1);
            const int lr = kk * 16 + tid;
            r_e[lr] = ea | (eb << 8); r_rk[lr] = ra | (rb << 16); r_w[lr * 2] = gtop * inv; r_w[lr * 2 + 1] = gtop * e2 * inv;
        }
        nloc = kk * 16 + 16;
    }
    __syncthreads();
    if (tid < 32) {
        const int n = hist[tid]; int base = 0;
        if (n > 0) {
            base = (int)atomicAdd(&cnt[tid], (unsigned)n);
            const int j0 = base >> 8, j1 = (base + n - 1) >> 8;
            if ((base & 255) == 0) { const unsigned t = atomicAdd(pool, 1u); __hip_atomic_store(owner + t, (unsigned)tid, __ATOMIC_RELAXED, __HIP_MEMORY_SCOPE_AGENT); __hip_atomic_store(tmap + tid * 72 + j0, t + 1u, __ATOMIC_RELAXED, __HIP_MEMORY_SCOPE_AGENT); }
            if (j1 != j0) { const unsigned t = atomicAdd(pool, 1u); __hip_atomic_store(owner + t, (unsigned)tid, __ATOMIC_RELAXED, __HIP_MEMORY_SCOPE_AGENT); __hip_atomic_store(tmap + tid * 72 + j1, t + 1u, __ATOMIC_RELAXED, __HIP_MEMORY_SCOPE_AGENT); }
        }
        baseL[tid] = base;
    }
    __syncthreads();
    if (tid < nloc) {
        const int lr = tid, grp = ridx + (lr >> 4) * rG, row = grp * 16 + (lr & 15);
        const int ee = r_e[lr], rk = r_rk[lr]; const int ea = ee & 255, eb = ee >> 8;
        const unsigned pa = (unsigned)(baseL[ea] + (rk & 0xffff)), pb = (unsigned)(baseL[eb] + (rk >> 16));
        unsigned* tma = tmap + ea * 72 + (pa >> 8); unsigned* tmb = tmap + eb * 72 + (pb >> 8);
        unsigned ta = 0u, tb = 0u, spin = 0u;
        while (ta == 0u || tb == 0u) {
            if (ta == 0u) ta = __hip_atomic_load(tma, __ATOMIC_RELAXED, __HIP_MEMORY_SCOPE_AGENT);
            if (tb == 0u) tb = __hip_atomic_load(tmb, __ATOMIC_RELAXED, __HIP_MEMORY_SCOPE_AGENT);
            if (++spin > (1u << 22)) break;
        }
        const int sa_ = (int)((ta - 1u) * 256u + (pa & 255u)), sb_ = (int)((tb - 1u) * 256u + (pb & 255u));
        asg[row * 2] = sa_; asg[row * 2 + 1] = sb_;
        ew[row * 2] = r_w[lr * 2]; ew[row * 2 + 1] = r_w[lr * 2 + 1];
        rlist[sa_] = row; rlist[sb_] = row;
    }
}

__device__ __forceinline__ void moe_table(KP p, int l, volatile LAS int* tab) {
    __syncthreads();
    if (tid_now() == 0) {
        const unsigned* cnt = (const unsigned*)(p->ws + WS_CTL) + CW_CNT + l * 32; int s = 0;
        for (int e = 0; e < NEXP; ++e) { tab[e] = s; s += (int)((__hip_atomic_load(cnt + e, __ATOMIC_RELAXED, __HIP_MEMORY_SCOPE_AGENT) + 255u) >> 8); }
        tab[NEXP] = s;
    }
    __syncthreads();
}

__global__ void __launch_bounds__(NTHREADS, 2) fwd_kernel(Params p_) {
    KP p = (KP)__builtin_amdgcn_kernarg_segment_ptr();
#define RELOAD_P() asm volatile("" : "+s"(p))
    extern __shared__ __attribute__((aligned(16))) unsigned char lds_raw[];
    LAS unsigned char* lds = (LAS unsigned char*)lds_raw;
    volatile LAS unsigned* MISC = (volatile LAS unsigned*)(lds + MISC_OFF);
    volatile LAS int* tab = (volatile LAS int*)(lds + MISC_OFF + 64);
    const int tid = threadIdx.x;
    const int G = gridDim.x; const int bx = blockIdx.x; const int vcu = (G % 8 == 0) ? (bx % 8) * (G / 8) + bx / 8 : bx;
    unsigned char* ws = p->ws;
    for (int u = tid; u < 256; u += NTHREADS) MISC[u] = 0u;
    __syncthreads();
    {
        XcdBarrier b0 = xcd_barrier_post((unsigned*)(ws + WS_CTL) + CW_BAR, MISC);
        cg::this_grid().sync();
        if (tid == 0) { unsigned nloc, nx; xcd_barrier_complete(b0.bar, b0.x, nloc, nx); MISC[0] = nloc; MISC[1] = nx; }
        __syncthreads();
    }
#define GRID_BAR() do { GRID_BAR1(); if (PROBE_REPEAT == 99) GRID_BAR1(); if (PROBE_STAMP >= 0 && blockIdx.x == 0 && tid == 0) { ((unsigned long long*)(ws + WS_LAM + 1024))[nstamp] = __builtin_amdgcn_s_memrealtime(); } ++nstamp; } while (0)
#define GRID_BAR1() do { RELOAD_P(); { unsigned char* w_ = p->ws; XcdBarrier b_; b_.bar = (unsigned*)(w_ + WS_CTL) + CW_BAR; b_.x = xb_xcc_id(); b_.st = MISC; xcd_barrier(b_); } \
    RELOAD_P(); ws = p->ws; } while (0)
#ifdef ONLY_PHASE
#define PH(n) (ONLY_PHASE == (n))
#else
#define PH(n) 1
#endif

    int nstamp = 0;
    if (PROBE_STAMP >= 0 && blockIdx.x == 0 && tid == 0) ((unsigned long long*)(ws + WS_LAM + 1024))[63] = __builtin_amdgcn_s_memrealtime();
    REP(0) if (PH(0)) phase_p0(p, lds, vcu, G);
    GRID_BAR();
#pragma unroll 1
    for (int l = 0; l < DEPTH; ++l) {
        const bool last = (l == DEPTH - 1);
        REP(1) if (PH(1)) phase_norm1(p, l, l == 0 ? 0 : 1, tab, vcu, G, DUMMY(1));
        GRID_BAR();
        REP(2) if (PH(2)) {
            pg8::DenseSched S; S.init(ws + WS_HL, ws + WS_WIN + (size_t)l * INC * D * 2, NROW, INC, D, G, bx);
            EpiInProj E{(h16*)(ws + WS_QA), (h16*)(ws + WS_KA), (h16*)(ws + WS_VAT), (h16*)(ws + WS_XR), (h16*)(ws + WS_GG), (h16*)(ws + WS_QD), (h16*)(ws + WS_KD), (h16*)(ws + WS_VDT), (const f32x2*)(ws + WS_ROPE), (unsigned*)(ws + WS_CTL) + CW_KMAX + l * 16, lds + 131072};
            pg8::gemm_phase<EpiInProj, pg8::DenseSched>(lds, D, S, E);
        }
        GRID_BAR();
        if (PH(3)) phase_mix(p, l, lds, G);
        GRID_BAR();
        REP(4) if (PH(4)) phase_scan(p, l, lds, G);
        GRID_BAR();
        REP(5) if (PH(5)) {
            pg8::DenseSched S; S.init(ws + WS_MIX, ws + WS_WOUT + (size_t)l * D * D * 2, NLAT, D, D, G, bx, (unsigned*)(ws + WS_CTL) + CW_D5 + l * 128);
            EpiOutProj E{(float*)(ws + WS_XL), (const float*)(ws + WS_MOD) + (size_t)l * 3 * 6144, (float*)(ws + WS_XL)};
            pg8::gemm_phase<EpiOutProj, pg8::DenseSched>(lds, D, S, E);
        }
        if (PH(5) && !last) {
            RELOAD_P(); ws = p->ws;
            CtxSplitSched S2{(const char*)(ws + WS_MIX), (const char*)(ws + WS_WOUT + (size_t)l * D * D * 2), (int)blockIdx.x - (G - 32), (unsigned*)(ws + WS_CTL) + CW_D5 + l * 128};
            EpiOutPart E2{(float*)(ws + WS_RGA), (const float*)(ws + WS_MOD) + (size_t)l * 3 * 6144};
            int klen = 256; asm volatile("" : "+s"(klen));
            pg8::gemm_phase<EpiOutPart, CtxSplitSched>(lds, klen, S2, E2, nullptr, D);
        }
        REP(6) if (PH(6)) phase_route(p, l, lds, vcu, G, DUMMY(6));
        GRID_BAR();
        moe_table(p, l, tab);
        REP(8) if (PH(8)) {
            MoeSched1 S{(const char*)((const unsigned*)(ws + WS_CTL) + CW_RLIST + l * (MAXTILES * 256)), (const char*)(ws + WS_W1 + (size_t)l * NEXP * DEXP * D * 2), (const char*)(ws + WS_W3 + (size_t)l * NEXP * DEXP * D * 2), (const unsigned*)(ws + WS_CTL) + CW_TMAP + l * 32 * 72, tab, tab[NEXP], G, vcu, (unsigned*)(ws + WS_CTL) + CW_D7 + l * 192};
            EpiMoe1 E{(h16*)(ws + WS_ACT)};
            pg8::gemm_phase<EpiMoe1, MoeSched1, true>(lds, D, S, E, (const char*)(ws + WS_HL));
        }
        REP(9) if (PH(9)) {
            MoeSched2 S{(const char*)(ws + WS_ACT), (const char*)(ws + WS_W2 + (size_t)l * NEXP * DEXP * D * 2), (const unsigned*)(ws + WS_CTL) + CW_TMAP + l * 32 * 72, tab, tab[NEXP], G, vcu, (const unsigned*)(ws + WS_CTL) + CW_D7 + l * 192, 0, 0, 0};
            S.plan();
            EpiMoe2 E{(h16*)(ws + WS_YB)};
            pg8::gemm_phase<EpiMoe2, MoeSched2>(lds, DEXP, S, E);
        }
        GRID_BAR();
    }
    if (PH(10)) phase_norm1(p, DEPTH, 2, tab, vcu, G, false);
    if (PROBE_STAMP >= 0 && blockIdx.x == 0 && tid == 0) {
        const unsigned long long* st = (const unsigned long long*)(ws + WS_LAM + 1024);
        unsigned long long tot = 0;
        if (PROBE_STAMP == 7) tot = __builtin_amdgcn_s_memrealtime() - st[63];
        else if (PROBE_STAMP == 0) tot = st[0] - st[63];
        else for (int l = 0; l < DEPTH; ++l) { const int e = PROBE_STAMP + 6 * l; tot += st[e] - st[e - 1]; }
        asm volatile("s_waitcnt vmcnt(0)" ::: "memory");
        p->out[0] = (float)tot * (0.01f / ((PROBE_STAMP == 3 || PROBE_STAMP == 7) ? 100.f : 10.f));
    }
}

extern "C" void kernel_launch(void* const* d_in, const int* in_sizes, int n_in, void* d_out, int out_size, void* d_ws, size_t ws_size, hipStream_t stream) {
    static int grid = 0;
    if (grid == 0) {
        if (n_in != 28 || out_size != NLAT * D || ws_size < WS_END) { fprintf(stderr, "kernel_launch: unexpected shapes (n_in %d out %d ws %zu)\n", n_in, out_size, ws_size); grid = -1; return; }
        int dev = 0, cus = 0, per_cu = 0;
        if (hipGetDevice(&dev) != hipSuccess || hipDeviceGetAttribute(&cus, hipDeviceAttributeMultiprocessorCount, dev) != hipSuccess) { grid = -1; return; }
        if (hipFuncSetAttribute((const void*)fwd_kernel, hipFuncAttributeMaxDynamicSharedMemorySize, LDS_BYTES) != hipSuccess) { fprintf(stderr, "kernel_launch: hipFuncSetAttribute failed\n"); grid = -1; return; }
        if (hipOccupancyMaxActiveBlocksPerMultiprocessor(&per_cu, (const void*)fwd_kernel, NTHREADS, LDS_BYTES) != hipSuccess || per_cu < 1) { fprintf(stderr, "kernel_launch: occupancy query says %d blocks per CU\n", per_cu); (void)hipGetLastError(); grid = -1; return; }
        grid = cus;
    }
    if (grid < 0) return;
    (void)hipMemsetAsync((char*)d_ws + WS_CTL, 0, CTL_ZERO_BYTES, stream);
    Params p{};
    for (int i = 0; i < 28; ++i) p.in[i] = (const float*)d_in[i];
    p.out = (float*)d_out; p.ws = (unsigned char*)d_ws;
    void* args[] = {&p};
    hipError_t e = hipLaunchCooperativeKernel((const void*)fwd_kernel, dim3(grid), dim3(NTHREADS), args, LDS_BYTES, stream);
    if (e != hipSuccess) fprintf(stderr, "kernel_launch: cooperative launch failed: %s (grid %d)\n", hipGetErrorString(e), grid);
}
```

```cpp
#include <hip/hip_runtime.h>
#include <hip/hip_cooperative_groups.h>
#include <cstdio>
#include <cstdint>
namespace cg = cooperative_groups;

#define LAS __attribute__((address_space(3)))
typedef _Float16 h16;
typedef h16 h16x8 __attribute__((ext_vector_type(8)));
typedef h16 h16x4 __attribute__((ext_vector_type(4)));
typedef h16 h16x2 __attribute__((ext_vector_type(2)));
typedef float f32x2 __attribute__((ext_vector_type(2)));
typedef float f32x4 __attribute__((ext_vector_type(4)));
typedef float f32x16 __attribute__((ext_vector_type(16)));
typedef unsigned u32x2 __attribute__((ext_vector_type(2)));
typedef unsigned u32x4 __attribute__((ext_vector_type(4)));

#define PROBE_REPEAT -1
#define PROBE_STAMP -1
#define REP(n) for (int rep_ = 0; rep_ < ((PROBE_REPEAT == (n)) ? 2 : 1); ++rep_)
#define DUMMY(n) ((PROBE_REPEAT == (n)) && rep_ == 0)
constexpr int D = 1024, NBATCH = 2, SEQ = 8192, CTX = 256, DEPTH = 4;
constexpr int NLAT = NBATCH * SEQ, NCTX = NBATCH * CTX, NROW = NLAT + NCTX;
constexpr int KEYS = SEQ + CTX;
constexpr int INC = 2560;
constexpr int NEXP = 32, DEXP = 512;
constexpr int NWAVES = 8, NTHREADS = 512;
constexpr float EPS = 1e-6f;
constexpr float LOG2E = 1.4426950408889634f;

constexpr size_t MiB = 1u << 20;
constexpr size_t WS_CTL = 0, CTL_ZERO_BYTES = 1 * MiB;
constexpr int CW_BAR = 4096;
constexpr int CW_CNT = 1024;
constexpr size_t WS_MOD = 1 * MiB;
constexpr size_t WS_LAM = 1 * MiB + 512 * 1024;
constexpr size_t WS_ROPE = 1 * MiB + 768 * 1024;
constexpr int CW_KMAX = 2048;
constexpr size_t WS_AGG = 2 * MiB;
constexpr size_t WS_ASG = 5 * MiB;
constexpr size_t WS_EW = 6 * MiB;
constexpr size_t WS_WIN = 8 * MiB;
constexpr size_t WS_WOUT = 28 * MiB;
constexpr size_t WS_RGW = 36 * MiB;
constexpr size_t WS_W1 = 40 * MiB;
constexpr size_t WS_W3 = 168 * MiB;
constexpr size_t WS_W2 = 296 * MiB;
constexpr size_t WS_XL = 424 * MiB;
constexpr size_t WS_HL = 490 * MiB;
constexpr size_t WS_QA = 523 * MiB;
constexpr size_t WS_KA = 532 * MiB;
constexpr size_t WS_VAT = 541 * MiB;
constexpr size_t WS_QD = 550 * MiB;
constexpr size_t WS_KD = 559 * MiB;
constexpr size_t WS_VDT = 568 * MiB;
constexpr size_t WS_XR = 577 * MiB;
constexpr size_t WS_GG = 594 * MiB;
constexpr size_t WS_RGA = 611 * MiB;
constexpr size_t WS_MIX = 743 * MiB;
constexpr size_t WS_XG = 776 * MiB;
constexpr size_t WS_ACT = 858 * MiB;
constexpr size_t WS_YB = 899 * MiB;
constexpr size_t WS_END = 981 * MiB;
constexpr int CW_POOL = 3000;
constexpr int CW_TMAP = 8192;
constexpr int CW_OWNER = 20480;
constexpr int MAXTILES = 164;
constexpr int CW_D5 = 21504;
constexpr int CW_RLIST = 65536;
constexpr int CW_D7 = 22528;

constexpr int LDS_BYTES = 147456;
constexpr int MISC_OFF = LDS_BYTES - 1024;

struct Params {
    const float* in[28];
    float* out;
    unsigned char* ws;
};
typedef __attribute__((address_space(4))) const Params* KP;
enum { I_X = 0, I_C, I_CTX, I_CCTX, I_WADA, I_BADA, I_GMIX, I_GFFN, I_WIN, I_WOUT, I_RPB, I_CONVW, I_CONVB, I_RGWR, I_RGBR, I_RGWI, I_RGBI, I_RGLAM,
       I_DLAM, I_DSUBG, I_RWG, I_RBG, I_RWE, I_RBE, I_W1, I_W3, I_W2, I_GFINAL };

__device__ __forceinline__ unsigned pkh(float a, float b) { h16x2 v = {(h16)a, (h16)b}; return __builtin_bit_cast(unsigned, v); }
__device__ __forceinline__ float wave_sum(float v) {
#pragma unroll
    for (int o = 1; o < 64; o <<= 1) v += __shfl_xor(v, o);
    return v;
}
__device__ __forceinline__ float xhalf_max(float m) { auto rr = __builtin_amdgcn_permlane32_swap(__float_as_uint(m), __float_as_uint(m), false, false); return fmaxf(__uint_as_float(rr[0]), __uint_as_float(rr[1])); }
__device__ __forceinline__ float xhalf_sum(float m) { auto rr = __builtin_amdgcn_permlane32_swap(__float_as_uint(m), __float_as_uint(m), false, false); return __uint_as_float(rr[0]) + __uint_as_float(rr[1]); }
__device__ __forceinline__ float fexp_(float x) { return __builtin_amdgcn_exp2f(x * LOG2E); }
__device__ __forceinline__ float frcp_(float x) { return __builtin_amdgcn_rcpf(x); }
__device__ __forceinline__ float sigmoidf_(float x) { return frcp_(1.f + fexp_(-x)); }
__device__ __forceinline__ float gelu_tanh(float x) { const float u = 0.7978845608028654f * (x + 0.044715f * x * x * x); return x * frcp_(1.f + fexp_(-2.f * u)); }
__device__ __forceinline__ int crow(int r, int hi) { return (r & 3) + 8 * (r >> 2) + 4 * hi; }
#define LDS_WAIT() asm volatile("s_waitcnt lgkmcnt(0)" ::: "memory")
__device__ __forceinline__ void lds_barrier() { asm volatile("s_waitcnt lgkmcnt(0)\n\ts_barrier" ::: "memory"); }
__device__ __forceinline__ int tid_now() { int t = threadIdx.x; asm volatile("" : "+v"(t)); return t; }

#define XB_TMO      128
#define XB_XCNT(j)  (256  + 64 * (j))
#define XB_XSUB(j)  (1280 + 64 * (j))
#define XB_XGEN(j)  (2304 + 64 * (j))
#define XB_TOP      3328
#define XB_TOPGEN   3392
#define XB_SPIN_CAP (1u << 22)
__device__ __forceinline__ unsigned xb_ld(unsigned* p)              { return __hip_atomic_load(p, __ATOMIC_RELAXED, __HIP_MEMORY_SCOPE_AGENT); }
__device__ __forceinline__ unsigned xb_add(unsigned* p, unsigned v) { return __hip_atomic_fetch_add(p, v, __ATOMIC_RELAXED, __HIP_MEMORY_SCOPE_AGENT); }
__device__ __forceinline__ unsigned xb_xcc_id() { return (unsigned)__builtin_amdgcn_s_getreg((3 << 11) | 20) & 0xFu; }
#define XB_SPIN(cond, bar) do { unsigned _sp = 0; while (cond) { __builtin_amdgcn_s_sleep(1); \
    if ((++_sp & 255u) == 0u) { if (xb_ld(&(bar)[XB_TMO])) break; if (_sp > XB_SPIN_CAP) { atomicAdd(&(bar)[XB_TMO], 1u); break; } } } } while (0)
struct XcdBarrier { unsigned* bar; unsigned x; volatile LAS unsigned* st; };
__device__ __forceinline__ XcdBarrier xcd_barrier_post(unsigned* bar, volatile LAS unsigned* st) {
    XcdBarrier b; b.bar = bar; b.x = xb_xcc_id(); b.st = st;
    if (threadIdx.x == 0) (void)xb_add(&bar[XB_XCNT(b.x)], 1u);
    return b;
}
__device__ __forceinline__ void xcd_barrier_complete(unsigned* bar, unsigned x, unsigned& nloc, unsigned& nx) {
    const unsigned G = gridDim.x * gridDim.y * gridDim.z;
    unsigned sum, cnt, mine, sp = 0u;
    for (;;) {
        sum = 0u; cnt = 0u; mine = 0u;
#pragma unroll 1
        for (unsigned j = 0; j < 16; ++j) { const unsigned c = xb_ld(&bar[XB_XCNT(j)]); sum += c; cnt += (c > 0u) ? 1u : 0u; mine = (j == x) ? c : mine; }
        if (sum == G) break;
        __builtin_amdgcn_s_sleep(1);
        if ((++sp & 255u) == 0u) { if (xb_ld(&bar[XB_TMO])) break; if (sp > XB_SPIN_CAP) { atomicAdd(&bar[XB_TMO], 1u); break; } }
    }
    nloc = mine > 0u ? mine : 1u; nx = cnt > 0u ? cnt : 1u;
}
__device__ __forceinline__ void xcd_barrier(const XcdBarrier& b) {
    asm volatile("s_waitcnt vmcnt(0)" ::: "memory");
    __syncthreads();
    if (threadIdx.x == 0) {
        unsigned* bar = b.bar;
        __builtin_amdgcn_s_waitcnt(0);
        const unsigned nloc = b.st[0], nx = b.st[1];
        const unsigned old = xb_add(&bar[XB_XSUB(b.x)], 1u);
        const unsigned gen = old / nloc;
        if (old + 1u == (gen + 1u) * nloc) {
            __builtin_amdgcn_fence(__ATOMIC_RELEASE, "agent");
            asm volatile("s_waitcnt vmcnt(0)" ::: "memory");
            const unsigned og = xb_add(&bar[XB_TOP], 1u);
            const unsigned tg = og / nx;
            if (og + 1u == (tg + 1u) * nx) xb_add(&bar[XB_TOPGEN], 1u);
            else XB_SPIN(xb_ld(&bar[XB_TOPGEN]) == tg, bar);
            __builtin_amdgcn_fence(__ATOMIC_ACQUIRE, "agent");
            xb_add(&bar[XB_XGEN(b.x)], 1u);
            asm volatile("s_waitcnt vmcnt(0)" ::: "memory");
        } else {
            XB_SPIN(xb_ld(&bar[XB_XGEN(b.x)]) == gen, bar);
            __builtin_amdgcn_fence(__ATOMIC_ACQUIRE, "agent");
            asm volatile("s_waitcnt vmcnt(0)" ::: "memory");
        }
    }
    __syncthreads();
}

__device__ __forceinline__ void unit_publish(unsigned* ctr) {
    asm volatile("s_waitcnt vmcnt(0)" ::: "memory");
    __builtin_amdgcn_s_barrier();
    if (threadIdx.x == 0) { __builtin_amdgcn_fence(__ATOMIC_RELEASE, "agent"); asm volatile("s_waitcnt vmcnt(0)" ::: "memory"); __hip_atomic_fetch_add(ctr, 1u, __ATOMIC_RELAXED, __HIP_MEMORY_SCOPE_AGENT); }
}
__device__ __forceinline__ void unit_wait(const unsigned* ctr, unsigned need) {
    if (threadIdx.x < 64) {
        unsigned spins = 0;
        while ((unsigned)__builtin_amdgcn_readfirstlane(__hip_atomic_load(ctr, __ATOMIC_RELAXED, __HIP_MEMORY_SCOPE_AGENT)) < need) { __builtin_amdgcn_s_sleep(2); if (++spins > (1u << 24)) break; }
        __builtin_amdgcn_fence(__ATOMIC_ACQUIRE, "agent");
        asm volatile("s_waitcnt vmcnt(0)" ::: "memory");
    }
    asm volatile("" ::: "memory"); __builtin_amdgcn_s_barrier(); asm volatile("" ::: "memory");
}

namespace pg8 {
constexpr int BM = 256, BK = 64, HALF = 128, HTB = HALF * BK * 2, STAGE_BYTES = 8 * HTB, NXCD = 8, WGM = 8;
__device__ __forceinline__ int lds_byte(int r, int c) { const int st = (r >> 4) * 2 + (c >> 5), rr = r & 15, cc = c & 31, ob = rr * 64 + cc * 2; return st * 1024 + (ob ^ (((ob >> 9) & 1) << 5)); }
__device__ __forceinline__ void stage_rc(int b, int& R, int& C) { const int st = b / 1024, sb = b % 1024, swz = sb ^ (((sb >> 9) & 1) << 5); R = (st >> 1) * 16 + swz / 64; C = (st & 1) * 32 + (swz % 64) / 2; }
__device__ __forceinline__ int perm32(int rho) { const int n = rho >> 4, i = rho & 15; return 8 * (i >> 2) + 4 * n + (i & 3); }

struct Unit { const char* A0; const char* A1; const char* B0; const char* B1; int pm, pn; };

struct DenseSched {
    const char* A; const char* Bt; int K, nM, nN, nwg, G, c; unsigned* done_ctr;
    __device__ __forceinline__ void init(const void* A_, const void* Bt_, int M, int N, int K_, int G_, int c_, unsigned* done_ = nullptr) { A = (const char*)A_; Bt = (const char*)Bt_; K = K_; nM = M / BM; nN = N / BM; nwg = nM * nN; G = G_; c = c_; done_ctr = done_; }
    __device__ __forceinline__ void a_ready(const Unit&) const {}
    __device__ __forceinline__ void done(const Unit& u) const { if (done_ctr) unit_publish(done_ctr + u.pm); }
    __device__ __forceinline__ bool next(int i, Unit& u) const {
        const long L = (long)i * G + c; if (L >= nwg) return false;
        int wgid = (int)L; { const int q = nwg / NXCD, r = nwg % NXCD, xcd = wgid % NXCD, off = wgid / NXCD; wgid = (xcd < r ? xcd * (q + 1) : r * (q + 1) + (xcd - r) * q) + off; }
        const int nig = WGM * nN, gid = wgid / nig, fm = gid * WGM, gsz = (nM - fm) < WGM ? (nM - fm) : WGM;
        u.pm = fm + ((wgid % nig) % gsz); u.pn = (wgid % nig) / gsz;
        const size_t hstep = (size_t)HALF * K * 2;
        u.A0 = A + (size_t)u.pm * 2 * hstep; u.A1 = u.A0 + hstep; u.B0 = Bt + (size_t)u.pn * 2 * hstep; u.B1 = u.B0 + hstep;
        return true;
    }
};

template <class Epi, class Sched, bool GATHER = false>
__device__ __forceinline__ void gemm_phase(LAS unsigned char* lds, const int K, const Sched& S, const Epi& E, const char* gbase = nullptr, const int pitch_ = 0) {
    const int pitch = pitch_ ? pitch_ : K;
    const int tid = tid_now(), wid = __builtin_amdgcn_readfirstlane(tid >> 6), lane = tid & 63, wr = wid >> 2, wc = wid & 3, fr = lane & 15, fq = lane >> 4;
    const int nt = K / BK;
    unsigned voffA[2], voffB[2];
#pragma unroll
    for (int i = 0; i < 2; ++i) { int R, C; stage_rc(tid * 16 + i * 8192, R, C); const int Rb = (R & ~31) + perm32(R & 31);
        voffA[i] = (unsigned)(R * pitch + C) * 2u; voffB[i] = (unsigned)(Rb * pitch + C) * 2u; }
    const size_t kstep = (size_t)(BK * 2);
    const unsigned ldsw = (unsigned)wid * 1024u;
    unsigned cv0[2] = {0u, 0u}, cv1[2] = {0u, 0u}, nv0[2] = {0u, 0u}, nv1[2] = {0u, 0u};
#define PG8_GOFF(v0_, v1_, listp) do { const int* rl_ = (const int*)(listp); _Pragma("unroll") for (int i_ = 0; i_ < 2; ++i_) { int R_, C_; stage_rc(tid * 16 + i_ * 8192, R_, C_); \
        v0_[i_] = (unsigned)rl_[R_] * (unsigned)(K * 2) + (unsigned)(C_ * 2); v1_[i_] = (unsigned)rl_[128 + R_] * (unsigned)(K * 2) + (unsigned)(C_ * 2); } } while (0)
#define PG8_STAGE2(bufoff, gb, va, vb, sel) do { _Pragma("unroll") for (int _i = 0; _i < 2; ++_i) \
        __builtin_amdgcn_global_load_lds((const unsigned*)((const char*)(gb) + ((sel) ? (vb)[_i] : (va)[_i])), (LAS unsigned*)(lds + (bufoff) + ldsw + _i * 8192), 16, 0, 0); } while (0)
    const int aoff = lds_byte(wr * 64 + fr, fq * 8), boff = lds_byte(wc * 32 + fr, fq * 8);
#define PG8_SA(b, h) (((b) * 2 + (h)) * HTB)
#define PG8_SB(b, h) ((4 + (b) * 2 + (h)) * HTB)
#define PG8_STAGE(bufoff, gbase, voff) do { _Pragma("unroll") for (int _i = 0; _i < 2; ++_i) \
        __builtin_amdgcn_global_load_lds((const unsigned*)((const char*)(gbase) + (voff)[_i]), (LAS unsigned*)(lds + (bufoff) + ldsw + _i * 8192), 16, 0, 0); } while (0)
#define PG8_LDA(dst, b, h) do { _Pragma("unroll") for (int m = 0; m < 4; ++m) _Pragma("unroll") for (int k = 0; k < 2; ++k) dst[m][k] = *(const LAS h16x8*)(lds + PG8_SA(b, h) + aoff + m * 2048 + k * 1024); } while (0)
#define PG8_LDB(dst, b, h) do { _Pragma("unroll") for (int n = 0; n < 2; ++n) _Pragma("unroll") for (int k = 0; k < 2; ++k) dst[n][k] = *(const LAS h16x8*)(lds + PG8_SB(b, h) + boff + n * 2048 + k * 1024); } while (0)
#define PG8_MMA(ai, bj, At, Bt) do { __builtin_amdgcn_s_setprio(1); _Pragma("unroll") for (int m = 0; m < 4; ++m) _Pragma("unroll") for (int n = 0; n < 2; ++n) _Pragma("unroll") for (int k = 0; k < 2; ++k) \
        acc[ai][bj][m][n] = __builtin_amdgcn_mfma_f32_16x16x32_f16(Bt[n][k], At[m][k], acc[ai][bj][m][n], 0, 0, 0); __builtin_amdgcn_s_setprio(0); } while (0)
#define PG8_WAIT_V(n) asm volatile("s_waitcnt vmcnt(" #n ")" ::: "memory")
#define PG8_WAIT_L(n) asm volatile("s_waitcnt lgkmcnt(" #n ")" ::: "memory")
#define PG8_BAR __builtin_amdgcn_s_barrier()
#define PG8_SCHED __builtin_amdgcn_sched_barrier(0)
    Unit cur, nxt; int ui = 0;
    if (!S.next(0, cur)) return;
    f32x4 acc[2][2][4][2];
#pragma unroll
    for (int a = 0; a < 2; ++a)
#pragma unroll
        for (int b = 0; b < 2; ++b)
#pragma unroll
            for (int m = 0; m < 4; ++m)
#pragma unroll
                for (int n = 0; n < 2; ++n) acc[a][b][m][n] = (f32x4){0.f, 0.f, 0.f, 0.f};
    h16x8 At[4][2], B0[2][2], B1[2][2];
    const char* cA0 = cur.A0; const char* cA1 = cur.A1; const char* cB0 = cur.B0; const char* cB1 = cur.B1;
    S.a_ready(cur);
    if constexpr (GATHER) { PG8_GOFF(cv0, cv1, cur.A0); }
    PG8_STAGE(PG8_SB(0, 0), cB0, voffB); PG8_STAGE(PG8_SB(0, 1), cB1, voffB);
    if constexpr (GATHER) { PG8_STAGE2(PG8_SA(0, 0), gbase, cv0, cv0, false); PG8_STAGE2(PG8_SA(0, 1), gbase, cv1, cv1, false); }
    else { PG8_STAGE(PG8_SA(0, 0), cA0, voffA); PG8_STAGE(PG8_SA(0, 1), cA1, voffA); }
    if (wr == 1) PG8_BAR;
    PG8_WAIT_V(2); PG8_BAR;
    PG8_STAGE(PG8_SB(1, 0), cB0 + kstep, voffB);
    if constexpr (GATHER) { PG8_STAGE2(PG8_SA(1, 0), gbase + kstep, cv0, cv0, false); } else { PG8_STAGE(PG8_SA(1, 0), cA0 + kstep, voffA); }
    PG8_STAGE(PG8_SB(1, 1), cB1 + kstep, voffB);
    PG8_WAIT_V(6); PG8_BAR;
    for (;;) {
        const bool has_next = S.next(ui + 1, nxt);
        const char* nA0 = has_next ? nxt.A0 : cA0; const char* nA1 = has_next ? nxt.A1 : cA1;
        const char* nB0 = has_next ? nxt.B0 : cB0; const char* nB1 = has_next ? nxt.B1 : cB1;
        for (int t = 0; t < nt; t += 2) {
            const bool last = (t == nt - 2);
            if (last && has_next) S.a_ready(nxt);
            if constexpr (GATHER) { if (last) { if (has_next) { PG8_GOFF(nv0, nv1, nxt.A0); } else { nv0[0] = cv0[0]; nv0[1] = cv0[1]; nv1[0] = cv1[0]; nv1[1] = cv1[1]; } } }
            const char* g1 = gbase + (size_t)(t + 1) * kstep; const char* g2 = gbase + (last ? (size_t)0 : (size_t)(t + 2) * kstep); const char* g3 = g2 + kstep;
            const char* a1_1 = cA1 + (size_t)(t + 1) * kstep;
            const char* a2_0 = last ? nA0 : cA0 + (size_t)(t + 2) * kstep; const char* a2_1 = last ? nA1 : cA1 + (size_t)(t + 2) * kstep;
            const char* b2_0 = last ? nB0 : cB0 + (size_t)(t + 2) * kstep; const char* b2_1 = last ? nB1 : cB1 + (size_t)(t + 2) * kstep;
            const char* a3_0 = a2_0 + kstep; const char* b3_0 = b2_0 + kstep; const char* b3_1 = b2_1 + kstep;
            PG8_LDB(B0, 0, 0); PG8_LDB(B1, 0, 1); PG8_SCHED; PG8_LDA(At, 0, 0); if constexpr (GATHER) { PG8_STAGE2(PG8_SA(1, 1), g1, cv1, cv1, false); } else { PG8_STAGE(PG8_SA(1, 1), a1_1, voffA); }
            PG8_WAIT_V(8); PG8_WAIT_L(0); PG8_BAR; PG8_MMA(0, 0, At, B0); PG8_MMA(0, 1, At, B1); PG8_BAR; PG8_SCHED;
            PG8_LDA(At, 0, 1); PG8_STAGE(PG8_SB(0, 0), b2_0, voffB); PG8_STAGE(PG8_SB(0, 1), b2_1, voffB); if constexpr (GATHER) { PG8_STAGE2(PG8_SA(0, 0), g2, cv0, nv0, last); } else { PG8_STAGE(PG8_SA(0, 0), a2_0, voffA); }
            PG8_WAIT_V(8); PG8_WAIT_L(0); PG8_BAR; PG8_MMA(1, 0, At, B0); PG8_MMA(1, 1, At, B1); PG8_BAR; PG8_SCHED;
            PG8_LDB(B0, 1, 0); PG8_LDB(B1, 1, 1); PG8_SCHED; PG8_LDA(At, 1, 0); if constexpr (GATHER) { PG8_STAGE2(PG8_SA(0, 1), g2, cv1, nv1, last); } else { PG8_STAGE(PG8_SA(0, 1), a2_1, voffA); }
            PG8_WAIT_V(8); PG8_WAIT_L(0); PG8_BAR; PG8_MMA(0, 0, At, B0); PG8_MMA(0, 1, At, B1); PG8_BAR; PG8_SCHED;
            PG8_LDA(At, 1, 1); PG8_STAGE(PG8_SB(1, 0), b3_0, voffB); PG8_STAGE(PG8_SB(1, 1), b3_1, voffB); if constexpr (GATHER) { PG8_STAGE2(PG8_SA(1, 0), g3, cv0, nv0, last); } else { PG8_STAGE(PG8_SA(1, 0), a3_0, voffA); }
            PG8_WAIT_V(8); PG8_WAIT_L(0); PG8_BAR; PG8_MMA(1, 0, At, B0); PG8_MMA(1, 1, At, B1); PG8_BAR; PG8_SCHED;
        }
        if (wr == 0) PG8_BAR;
        E(acc, cur, wr, wc, fr, fq);
        S.done(cur);
        if (!has_next) break;
#pragma unroll
        for (int a = 0; a < 2; ++a)
#pragma unroll
            for (int b = 0; b < 2; ++b)
#pragma unroll
                for (int m = 0; m < 4; ++m)
#pragma unroll
                    for (int n = 0; n < 2; ++n) acc[a][b][m][n] = (f32x4){0.f, 0.f, 0.f, 0.f};
        cur = nxt; cA0 = nA0; cA1 = nA1; cB0 = nB0; cB1 = nB1; ++ui;
        if constexpr (GATHER) { cv0[0] = nv0[0]; cv0[1] = nv0[1]; cv1[0] = nv1[0]; cv1[1] = nv1[1]; }
        if (wr == 1) PG8_BAR;
    }
    PG8_WAIT_V(0);
    PG8_BAR;
#undef PG8_SA
#undef PG8_SB
#undef PG8_STAGE
#undef PG8_STAGE2
#undef PG8_GOFF
#undef PG8_LDA
#undef PG8_LDB
#undef PG8_MMA
#undef PG8_WAIT_V
#undef PG8_WAIT_L
#undef PG8_BAR
#undef PG8_SCHED
}
}
using pg8::Unit;
typedef f32x4 AccT[2][2][4][2];

struct EpiInProj {
    h16 *qa, *ka, *vat, *xr, *gg, *qd, *kd, *vdt; const f32x2* rope; unsigned* kmax; LAS unsigned char* scr;
    __device__ __forceinline__ void operator()(const AccT& acc, const Unit& u, int wr, int wc, int fr, int fq) const {
        const int pn = u.pn;
        const bool isctx = (u.pm >= NLAT / 256);
        const float QSA = 0.125f * LOG2E, QSD = 0.17677669529663687f * LOG2E;
        float kn2[2] = {0.f, 0.f};
        if (pn == 2 || pn == 9) {
            h16* const vbase = (pn == 2 ? vat : vdt);
            LAS unsigned char* const sw = scr + (wr * 4 + wc) * 1536;
            const int lane = fq * 16 + fr;
#pragma unroll
            for (int ai = 0; ai < 2; ++ai)
#pragma unroll
                for (int m = 0; m < 4; ++m) {
                    const int row0 = u.pm * 256 + ai * 128 + wr * 64 + m * 16;
                    int b, key0;
                    if (isctx) { const int c = row0 - NLAT; b = c >> 8; key0 = SEQ + (c & 255); } else { b = row0 >> 13; key0 = row0 & (SEQ - 1); }
#pragma unroll
                    for (int bj = 0; bj < 2; ++bj) {
#pragma unroll
                        for (int j = 0; j < 8; ++j) *(LAS h16*)(sw + (fq * 8 + j) * 48 + fr * 2) = (h16)acc[ai][bj][m][j >> 2][j & 3];
                        asm volatile("s_waitcnt lgkmcnt(0)" ::: "memory");
                        const u32x4 w = *(const LAS u32x4*)(sw + (lane >> 1) * 48 + (lane & 1) * 16);
                        asm volatile("s_waitcnt lgkmcnt(0)" ::: "memory");
                        *(u32x4*)(vbase + ((size_t)(b * 256 + bj * 128 + wc * 32 + (lane >> 1))) * KEYS + key0 + (lane & 1) * 8) = w;
                    }
                }
            return;
        }
#pragma unroll
        for (int ai = 0; ai < 2; ++ai)
#pragma unroll
            for (int m = 0; m < 4; ++m) {
                const int row = u.pm * 256 + ai * 128 + wr * 64 + m * 16 + fr;
                int b, key, t;
                if (isctx) { const int c = row - NLAT; b = c >> 8; t = c & 255; key = SEQ + t; } else { b = row >> 13; t = row & (SEQ - 1); key = t; }
#pragma unroll
                for (int bj = 0; bj < 2; ++bj) {
                    const int col = bj * 128 + wc * 32 + 8 * fq;
                    float v[8];
#pragma unroll
                    for (int j = 0; j < 4; ++j) { v[j] = acc[ai][bj][m][0][j]; v[4 + j] = acc[ai][bj][m][1][j]; }
                    if (pn == 7 || pn == 8) {
                        float pr[8];
#pragma unroll
                        for (int j = 0; j < 8; ++j) pr[j] = __shfl_xor(v[j], 16);
                        if (!isctx) {
                            const int pos = (fq < 2) ? (t >> 6) : (t & 63);
                            const f32x2* tb = rope + pos * 8;
#pragma unroll
                            for (int j = 0; j < 8; ++j) { const f32x2 cs = tb[j]; const float sn = (fq & 1) ? cs.y : -cs.y; v[j] = v[j] * cs.x + pr[j] * sn; }
                        }
                        if (pn == 8) { float ss = 0.f;
#pragma unroll
                            for (int j = 0; j < 8; ++j) ss += v[j] * v[j];
                            kn2[bj] = fmaxf(kn2[bj], ss); }
                    }
                    {
                        h16* dst; float sc = 1.f;
                        if (pn == 0) { dst = qa + (size_t)row * 256 + col; sc = QSA; }
                        else if (pn == 1) { dst = ka + ((size_t)(b * KEYS + key)) * 256 + col; }
                        else if (pn == 3 || pn == 4) { dst = xr + (size_t)row * 512 + (pn - 3) * 256 + col; }
                        else if (pn == 5 || pn == 6) { dst = gg + (size_t)row * 512 + (pn - 5) * 256 + col;
#pragma unroll
                            for (int j = 0; j < 8; ++j) v[j] = gelu_tanh(v[j]); }
                        else if (pn == 7) { dst = qd + (size_t)row * 256 + col; sc = QSD; }
                        else { dst = kd + ((size_t)(b * KEYS + key)) * 256 + col; }
                        u32x4 w; w.x = pkh(v[0] * sc, v[1] * sc); w.y = pkh(v[2] * sc, v[3] * sc); w.z = pkh(v[4] * sc, v[5] * sc); w.w = pkh(v[6] * sc, v[7] * sc);
                        *(u32x4*)dst = w;
                    }
                }
            }
        if (pn == 8) {
            const int b = isctx ? (u.pm - NLAT / 256) : (u.pm >> 5);
#pragma unroll
            for (int bj = 0; bj < 2; ++bj) {
                float ss = kn2[bj]; ss += __shfl_xor(ss, 16); ss += __shfl_xor(ss, 32);
#pragma unroll
                for (int o = 1; o < 16; o <<= 1) ss = fmaxf(ss, __shfl_xor(ss, o));
                if ((fr | fq) == 0) atomicMax(kmax + (b * 4 + 2 * bj + (wc >> 1)) * 2 + (wc & 1), __float_as_uint(ss));
            }
        }
    }
};

struct EpiOutProj {
    float* xl; const float* mod; float* xo;
    __device__ __forceinline__ void operator()(const AccT& acc, const Unit& u, int wr, int wc, int fr, int fq) const {
        const int vsel = (u.pm >= NLAT / 256) ? 2 : (u.pm >= NLAT / 512 ? 1 : 0);
        const float* ga = mod + vsel * 6144 + 2 * 1024;
#pragma unroll
        for (int bj = 0; bj < 2; ++bj) {
            const int col = u.pn * 256 + bj * 128 + wc * 32 + 8 * fq;
            const f32x4 g0 = *(const f32x4*)(ga + col), g1 = *(const f32x4*)(ga + col + 4);
#pragma unroll
            for (int ai = 0; ai < 2; ++ai)
#pragma unroll
                for (int m = 0; m < 4; ++m) {
                    const int row = u.pm * 256 + ai * 128 + wr * 64 + m * 16 + fr;
                    const float* p = xl + (size_t)row * D + col; float* q = xo + (size_t)row * D + col;
                    f32x4 x0 = *(const f32x4*)p, x1 = *(const f32x4*)(p + 4);
                    x0 += g0 * acc[ai][bj][m][0]; x1 += g1 * acc[ai][bj][m][1];
                    *(f32x4*)q = x0; *(f32x4*)(q + 4) = x1;
                }
        }
    }
};

struct CtxSplitSched {
    const char* mix; const char* wt; int q; unsigned* done_ctr;
    __device__ __forceinline__ void a_ready(const Unit&) const {}
    __device__ __forceinline__ void done(const Unit& u) const { unit_publish(done_ctr + u.pm); }
    __device__ __forceinline__ bool next(int i, Unit& u) const {
        if (i != 0 || q < 0) return false;
        const int pm = NLAT / 256 + (q >> 4), pn = (q >> 2) & 3, kq = q & 3;
        u.pm = pm; u.pn = pn | (kq << 8);
        u.A0 = mix + (size_t)pm * 256 * 2048 + kq * 512; u.A1 = u.A0 + (size_t)128 * 2048;
        u.B0 = wt + (size_t)pn * 256 * 2048 + kq * 512; u.B1 = u.B0 + (size_t)128 * 2048;
        return true;
    }
};
struct EpiOutPart {
    float* part; const float* mod;
    __device__ __forceinline__ void operator()(const AccT& acc, const Unit& u, int wr, int wc, int fr, int fq) const {
        const int pn = u.pn & 255, kq = u.pn >> 8;
        const float* ga = mod + 2 * 6144 + 2 * 1024;
#pragma unroll
        for (int bj = 0; bj < 2; ++bj) {
            const int col = pn * 256 + bj * 128 + wc * 32 + 8 * fq;
            const f32x4 g0 = *(const f32x4*)(ga + col), g1 = *(const f32x4*)(ga + col + 4);
#pragma unroll
            for (int ai = 0; ai < 2; ++ai)
#pragma unroll
                for (int m = 0; m < 4; ++m) {
                    const int crow_ = (u.pm - NLAT / 256) * 256 + ai * 128 + wr * 64 + m * 16 + fr;
                    float* q_ = part + ((size_t)kq * NCTX + crow_) * D + col;
                    *(f32x4*)q_ = g0 * acc[ai][bj][m][0]; *(f32x4*)(q_ + 4) = g1 * acc[ai][bj][m][1];
                }
        }
    }
};

struct MoeSched1 {
    const char* xg; const char* w1t; const char* w3t; const unsigned* tmap; volatile LAS int* tab; int ntiles, G, c; unsigned* done7;
    __device__ __forceinline__ void a_ready(const Unit&) const {}
    __device__ __forceinline__ void done(const Unit& u) const { unit_publish(done7 + u.pm); }
    __device__ __forceinline__ bool next(int i, Unit& u) const {
        const int L = i * G + c; if (L >= ntiles * 4) return false;
        const int Ts = L >> 2, pn = L & 3; int e = 0;
        for (int j = 1; j < NEXP; ++j) e += (tab[j] <= Ts) ? 1 : 0;
        e = __builtin_amdgcn_readfirstlane(e);
        const int T = __builtin_amdgcn_readfirstlane((int)tmap[e * 72 + (Ts - tab[e])] - 1);
        u.pm = T; u.pn = pn;
        u.A0 = xg + (size_t)T * 256 * 4; u.A1 = u.A0;
        const size_t wo = ((size_t)e * DEXP + (size_t)pn * 128) * 2048;
        u.B0 = w1t + wo; u.B1 = w3t + wo;
        return true;
    }
};
struct MoeSched2 {
    const char* act; const char* w2t; const unsigned* tmap; volatile LAS int* tab; int ntiles, G, c; const unsigned* done7; int start, cnt, rest;
    __device__ __forceinline__ void a_ready(const Unit& u) const { unit_wait(done7 + u.pm, 4u); }
    __device__ __forceinline__ void done(const Unit&) const {}
    __device__ __forceinline__ void plan() {
        const int n = ntiles * 4;
        const int base = n / G, r = n - base * G;
        const int T3 = 3 * n;
        int bhi = (T3 / G) - 2 * (base + 1); if (bhi < 0) bhi = 0;
        int blo = (T3 / G) - 2 * base; if (blo < 0) blo = 0;
        long tot = (long)r * bhi + (long)(G - r) * blo;
        if (tot > n) { blo = (int)((n - (long)r * bhi) / (G - r)); if (blo < 0) { blo = 0; bhi = n / (r > 0 ? r : 1); } tot = (long)r * bhi + (long)(G - r) * blo; if (tot > n) { bhi = 0; blo = n / G; tot = (long)G * blo; } }
        start = (c < r) ? c * bhi : r * bhi + (c - r) * blo; cnt = (c < r) ? bhi : blo; rest = (int)tot;
    }
    __device__ __forceinline__ bool next(int i, Unit& u) const {
        int L;
        if (i < cnt) L = start + i; else { L = rest + (i - cnt) * G + c; }
        if (L >= ntiles * 4) return false;
        const int Ts = L >> 2, pn = L & 3; int e = 0;
        for (int j = 1; j < NEXP; ++j) e += (tab[j] <= Ts) ? 1 : 0;
        e = __builtin_amdgcn_readfirstlane(e);
        const int T = __builtin_amdgcn_readfirstlane((int)tmap[e * 72 + (Ts - tab[e])] - 1);
        u.pm = T; u.pn = pn;
        u.A0 = act + (size_t)T * 256 * 1024; u.A1 = u.A0 + (size_t)128 * 1024;
        u.B0 = w2t + ((size_t)e * D + (size_t)pn * 256) * 1024; u.B1 = u.B0 + (size_t)128 * 1024;
        return true;
    }
};
struct EpiMoe1 {
    h16* act;
    __device__ __forceinline__ void operator()(const AccT& acc, const Unit& u, int wr, int wc, int fr, int fq) const {
#pragma unroll
        for (int ai = 0; ai < 2; ++ai)
#pragma unroll
            for (int m = 0; m < 4; ++m) {
                const int row = u.pm * 256 + ai * 128 + wr * 64 + m * 16 + fr;
                float v[8];
#pragma unroll
                for (int n = 0; n < 2; ++n)
#pragma unroll
                    for (int j = 0; j < 4; ++j) { const float a = acc[ai][0][m][n][j], b = acc[ai][1][m][n][j]; v[4 * n + j] = a * frcp_(1.f + fexp_(-a)) * b; }
                u32x4 w; w.x = pkh(v[0], v[1]); w.y = pkh(v[2], v[3]); w.z = pkh(v[4], v[5]); w.w = pkh(v[6], v[7]);
                *(u32x4*)(act + (size_t)row * DEXP + u.pn * 128 + wc * 32 + 8 * fq) = w;
            }
    }
};
struct EpiMoe2 {
    h16* yb;
    __device__ __forceinline__ void operator()(const AccT& acc, const Unit& u, int wr, int wc, int fr, int fq) const {
#pragma unroll
        for (int ai = 0; ai < 2; ++ai)
#pragma unroll
            for (int m = 0; m < 4; ++m) {
                const int row = u.pm * 256 + ai * 128 + wr * 64 + m * 16 + fr;
#pragma unroll
                for (int bj = 0; bj < 2; ++bj) {
                    const f32x4 v0 = acc[ai][bj][m][0], v1 = acc[ai][bj][m][1];
                    u32x4 w; w.x = pkh(v0[0], v0[1]); w.y = pkh(v0[2], v0[3]); w.z = pkh(v1[0], v1[1]); w.w = pkh(v1[2], v1[3]);
                    *(u32x4*)(yb + (size_t)row * D + u.pn * 256 + bj * 128 + wc * 32 + 8 * fq) = w;
                }
            }
    }
};

__device__ __forceinline__ void p0_transpose_item(const float* W, int K, int N, h16* WT, LAS h16* scr, int item, int lane) {
    const int nblk = N / 64, kb = item / nblk, nb = item % nblk, k0 = 64 * kb, n0 = 64 * nb;
    const float* src = W + (size_t)k0 * N + n0 + lane;
#pragma unroll 32
    for (int i = 0; i < 64; ++i) scr[i * 66 + lane] = (h16)src[(size_t)i * N];
    LDS_WAIT(); asm volatile("" ::: "memory");
    const int c = lane & 7;
#pragma unroll
    for (int j = 0; j < 8; ++j) { const int n = (lane >> 3) + 8 * j; const LAS h16* s = scr + (8 * c) * 66 + n;
        h16x8 o;
#pragma unroll
        for (int t = 0; t < 8; ++t) o[t] = s[t * 66];
        *(h16x8*)(WT + (size_t)(n0 + n) * K + k0 + 8 * c) = o; }
    LDS_WAIT(); asm volatile("" ::: "memory");
}

__device__ __forceinline__ void phase_p0(KP p, LAS unsigned char* lds, int vcu, int G) {
    const int tid = tid_now(), lane = tid & 63, wave = __builtin_amdgcn_readfirstlane(tid >> 6);
    unsigned char* ws = p->ws;
    LAS float* sc = (LAS float*)lds;
    LAS float* red = (LAS float*)(lds + 12288);
    for (int i = tid; i < 3 * 1024; i += NTHREADS) { const float x = (i < 2048) ? p->in[I_C][i] : p->in[I_CCTX][i - 2048]; sc[i] = x / (1.f + __expf(-x)); }
    __syncthreads();
    float* mod = (float*)(ws + WS_MOD);
    for (int it = blockIdx.x; it < DEPTH * 96; it += G) {
        const int l = it / 96, nb = it % 96, n = nb * 64 + lane;
        const float* W = p->in[I_WADA] + (size_t)l * D * 6144 + n;
        float a0 = 0.f, a1 = 0.f, a2 = 0.f;
#pragma unroll 32
        for (int k = wave * 128; k < wave * 128 + 128; ++k) { const float w = W[(size_t)k * 6144]; a0 += sc[k] * w; a1 += sc[1024 + k] * w; a2 += sc[2048 + k] * w; }
        red[(wave * 3 + 0) * 64 + lane] = a0; red[(wave * 3 + 1) * 64 + lane] = a1; red[(wave * 3 + 2) * 64 + lane] = a2;
        __syncthreads();
        if (tid < 192) { const int v = tid >> 6, ln = tid & 63; float s = p->in[I_BADA][l * 6144 + nb * 64 + ln];
#pragma unroll
            for (int w = 0; w < 8; ++w) s += red[(w * 3 + v) * 64 + ln];
            mod[((size_t)l * 3 + v) * 6144 + nb * 64 + ln] = s; }
        __syncthreads();
    }
    if (blockIdx.x == 0) {
        f32x2* tab = (f32x2*)(ws + WS_ROPE);
        for (int i = tid; i < 128 * 8; i += NTHREADS) { const int pos = i >> 3, j = i & 7; const float f = powf(10000.f, -(float)j / 8.f); const float ang = (float)pos * f; tab[i] = (f32x2){cosf(ang), sinf(ang)}; }
        if (tid < DEPTH) { const float* lv = p->in[I_DLAM] + tid * 128; float s1 = 0.f, s2 = 0.f;
            for (int j = 0; j < 32; ++j) { s1 += lv[j] * lv[32 + j]; s2 += lv[64 + j] * lv[96 + j]; }
            ((float*)(ws + WS_LAM))[tid] = expf(s1) - expf(s2) + (0.8f - 0.6f * expf(-0.3f * (float)tid)); }
    }
    LAS h16* scr = (LAS h16*)(lds + 32768 + wave * 8448);
    const int gw = vcu * NWAVES + wave, NGW = G * NWAVES;
    constexpr int N_IN = DEPTH * 16 * 40, N_OUT = DEPTH * 16 * 16, N_E = DEPTH * NEXP * 128, N_RG = DEPTH * 2 * 8;
    constexpr int NITEMS = N_IN + N_OUT + 3 * N_E + 2 * N_RG;
    for (int it = gw; it < NITEMS; it += NGW) {
        int r = it;
        if (r < N_IN) { const int l = r / 640; p0_transpose_item(p->in[I_WIN] + (size_t)l * D * INC, D, INC, (h16*)(ws + WS_WIN) + (size_t)l * INC * D, scr, r % 640, lane); continue; } r -= N_IN;
        if (r < N_OUT) { const int l = r / 256; p0_transpose_item(p->in[I_WOUT] + (size_t)l * D * D, D, D, (h16*)(ws + WS_WOUT) + (size_t)l * D * D, scr, r % 256, lane); continue; } r -= N_OUT;
        if (r < N_E) { const int mi = r / 128; p0_transpose_item(p->in[I_W1] + (size_t)mi * D * DEXP, D, DEXP, (h16*)(ws + WS_W1) + (size_t)mi * D * DEXP, scr, r % 128, lane); continue; } r -= N_E;
        if (r < N_E) { const int mi = r / 128; p0_transpose_item(p->in[I_W3] + (size_t)mi * D * DEXP, D, DEXP, (h16*)(ws + WS_W3) + (size_t)mi * D * DEXP, scr, r % 128, lane); continue; } r -= N_E;
        if (r < N_E) { const int mi = r / 128; p0_transpose_item(p->in[I_W2] + (size_t)mi * D * DEXP, DEXP, D, (h16*)(ws + WS_W2) + (size_t)mi * D * DEXP, scr, r % 128, lane); continue; } r -= N_E;
        {
            const int gate = r / N_RG; r %= N_RG; const int mi = r; const int ldir = mi >> 3, nb = mi & 7;
            const float* src = p->in[gate ? I_RGWI : I_RGWR] + (size_t)mi * 4096;
            h16* dst = (h16*)(ws + WS_RGW) + ((size_t)(ldir * 2 + gate) * 8 + nb) * 4096;
            p0_transpose_item(src, 64, 64, dst, scr, 0, lane);
        }
    }
}

__device__ __forceinline__ void phase_norm1(KP p, int l, int mode, volatile LAS int* tab, int vcu, int G, bool dummy) {
    const int tid = tid_now(); const int lane = tid & 63, wave = __builtin_amdgcn_readfirstlane(tid >> 6);
    unsigned char* ws = p->ws;
    float* xl = (float*)(ws + WS_XL); h16* hl = (h16*)(ws + (dummy ? WS_ACT : WS_HL)); float* xlo = dummy ? (float*)(ws + WS_XG) : xl;
    const float* mod = (const float*)(ws + WS_MOD);
    const int* asg = (const int*)(ws + WS_ASG); const float* ew = (const float*)(ws + WS_EW);
    const h16* yb = (const h16*)(ws + WS_YB);
    const int nrows = (mode == 2) ? NLAT : NROW;
    const int prev_rows = (l == DEPTH) ? NLAT : NROW;
    const int gw = vcu * NWAVES + wave, NGW = G * NWAVES;
    for (int row = gw; row < nrows; row += NGW) {
        const int v = (row < NLAT) ? (row >> 13) : 2;
        f32x4 x[4];
        if (mode == 0) {
            const float* src = (row < NLAT) ? p->in[I_X] + (size_t)row * D : p->in[I_CTX] + (size_t)(row - NLAT) * D;
#pragma unroll
            for (int j = 0; j < 4; ++j) x[j] = *(const f32x4*)(src + 4 * lane + 256 * j);
        } else {
            const float* src = xl + (size_t)row * D;
#pragma unroll
            for (int j = 0; j < 4; ++j) x[j] = *(const f32x4*)(src + 4 * lane + 256 * j);
            if (row < prev_rows) {
                const int a0 = asg[row * 2], a1 = asg[row * 2 + 1];
                const float w0 = ew[row * 2], w1 = ew[row * 2 + 1];
                const size_t s0 = (size_t)a0, s1 = (size_t)a1;
                const float* ga = mod + ((size_t)(l - 1) * 3 + v) * 6144 + 5 * 1024;
#pragma unroll
                for (int j = 0; j < 4; ++j) {
                    const int c = 4 * lane + 256 * j;
                    const h16x4 y0 = *(const h16x4*)(yb + s0 * D + c), y1 = *(const h16x4*)(yb + s1 * D + c);
                    const f32x4 g = *(const f32x4*)(ga + c);
#pragma unroll
                    for (int e = 0; e < 4; ++e) x[j][e] += g[e] * (w0 * (float)y0[e] + w1 * (float)y1[e]);
                }
            }
        }
        if (mode != 2) {
            float* dst = xlo + (size_t)row * D;
#pragma unroll
            for (int j = 0; j < 4; ++j) *(f32x4*)(dst + 4 * lane + 256 * j) = x[j];
        }
        float ss = 0.f;
#pragma unroll
        for (int j = 0; j < 4; ++j) ss += x[j][0] * x[j][0] + x[j][1] * x[j][1] + x[j][2] * x[j][2] + x[j][3] * x[j][3];
        const float rstd = rsqrtf(wave_sum(ss) * (1.f / D) + EPS);
        if (mode == 2) {
            const float* g = p->in[I_GFINAL]; float* o = p->out + (size_t)row * D;
#pragma unroll
            for (int j = 0; j < 4; ++j) { const int c = 4 * lane + 256 * j; const f32x4 gv = *(const f32x4*)(g + c); *(f32x4*)(o + c) = x[j] * rstd * gv; }
        } else {
            const float* g = p->in[I_GMIX] + l * D; const float* sh = mod + ((size_t)l * 3 + v) * 6144; const float* scl = sh + 1024;
            h16* o = hl + (size_t)row * D;
#pragma unroll
            for (int j = 0; j < 4; ++j) { const int c = 4 * lane + 256 * j; const f32x4 gv = *(const f32x4*)(g + c), sv = *(const f32x4*)(scl + c), hv = *(const f32x4*)(sh + c);
                const f32x4 y = x[j] * rstd * gv * (1.f + sv) + hv;
                u32x2 w; w.x = pkh(y[0], y[1]); w.y = pkh(y[2], y[3]); *(u32x2*)(o + c) = w; }
        }
    }
}

#define SM_THR 6.0f
#define SOFTMAX_TILE(s, m, l, oA, oB, pfa, pfb) do { \
    float mx_ = fmaxf(fmaxf(s[0], s[1]), s[2]); \
    _Pragma("unroll") for (int r_ = 3; r_ < 15; r_ += 2) mx_ = fmaxf(fmaxf(mx_, s[r_]), s[r_ + 1]); \
    mx_ = fmaxf(mx_, s[15]); mx_ = xhalf_max(mx_); \
    if (__any(mx_ > m + SM_THR)) { const float dl_ = (mx_ > m + SM_THR) ? (mx_ - m) : 0.f; m += dl_; \
        const float al_ = __builtin_amdgcn_exp2f(-dl_); l *= al_; oA *= al_; oB *= al_; } \
    _Pragma("unroll") for (int r_ = 0; r_ < 16; ++r_) s[r_] = __builtin_amdgcn_exp2f(s[r_] - m); \
    { float sm_ = 0.f; _Pragma("unroll") for (int r_ = 0; r_ < 16; ++r_) sm_ += s[r_]; l += sm_; } \
    { u32x4 wa_, wb_; wa_.x = pkrtz(s[0], s[1]); wa_.y = pkrtz(s[2], s[3]); wa_.z = pkrtz(s[4], s[5]); wa_.w = pkrtz(s[6], s[7]); \
      wb_.x = pkrtz(s[8], s[9]); wb_.y = pkrtz(s[10], s[11]); wb_.z = pkrtz(s[12], s[13]); wb_.w = pkrtz(s[14], s[15]); \
      pfa = __builtin_bit_cast(h16x8, wa_); pfb = __builtin_bit_cast(h16x8, wb_); } \
} while (0)

__device__ __forceinline__ int pi32(int r) { return (r & 19) | (((r >> 3) & 1) << 2) | (((r >> 2) & 1) << 3); }

constexpr int DA_STAGE = 18432;
__device__ __forceinline__ unsigned pkrtz(float a, float b) { return __builtin_bit_cast(unsigned, __builtin_amdgcn_cvt_pkrtz(a, b)); }
__device__ __forceinline__ void da_exp_pack(f32x16& s, float& l, h16x8& pa, h16x8& pb) {
#pragma unroll
    for (int r = 0; r < 16; ++r) s[r] = __builtin_amdgcn_exp2f(s[r]);
    u32x4 wa, wb;
    wa.x = pkrtz(s[0], s[1]); wa.y = pkrtz(s[2], s[3]); wa.z = pkrtz(s[4], s[5]); wa.w = pkrtz(s[6], s[7]);
    wb.x = pkrtz(s[8], s[9]); wb.y = pkrtz(s[10], s[11]); wb.z = pkrtz(s[12], s[13]); wb.w = pkrtz(s[14], s[15]);
    const h16x2 one2 = {(h16)1.f, (h16)1.f};
    const h16x2 t0 = __builtin_bit_cast(h16x2, wa.x) + __builtin_bit_cast(h16x2, wa.y), t1 = __builtin_bit_cast(h16x2, wa.z) + __builtin_bit_cast(h16x2, wa.w);
    const h16x2 t2 = __builtin_bit_cast(h16x2, wb.x) + __builtin_bit_cast(h16x2, wb.y), t3 = __builtin_bit_cast(h16x2, wb.z) + __builtin_bit_cast(h16x2, wb.w);
    const h16x2 u0 = t0 + t1, u1 = t2 + t3;
    l = __builtin_amdgcn_fdot2(u0 + u1, one2, l, false);
    pa = __builtin_bit_cast(h16x8, wa); pb = __builtin_bit_cast(h16x8, wb);
}
__device__ __forceinline__ void diff_unit(KP p, int l, int b, int h, int qrow0, int kt0, int nkt, LAS unsigned char* lds) {
    const int tid = tid_now(), lane = tid & 63, wid = __builtin_amdgcn_readfirstlane(tid >> 6), q32 = lane & 31, hi = lane >> 5;
    unsigned char* ws = p->ws;
    const h16* Qd = (const h16*)(ws + WS_QD); const h16* Kd = (const h16*)(ws + WS_KD); const h16* VdT = (const h16*)(ws + WS_VDT);
    h16* mix = (h16*)(ws + WS_MIX);
    const int qrow = qrow0 + wid * 32 + q32;
    h16x8 qf00, qf01, qf10, qf11;
    {
        const h16* qp = Qd + (size_t)qrow * 256 + h * 64 + hi * 8;
        qf00 = *(const h16x8*)(qp); qf01 = *(const h16x8*)(qp + 16); qf10 = *(const h16x8*)(qp + 32); qf11 = *(const h16x8*)(qp + 48);
    }
    const h16x8 zero8 = {0, 0, 0, 0, 0, 0, 0, 0};
    f32x16 negm0, negm1;
    {
        const float* km = (const float*)((const unsigned*)(ws + WS_CTL) + CW_KMAX + l * 16) + (b * 4 + h) * 2;
        float q0 = 0.f, q1 = 0.f;
#pragma unroll
        for (int j = 0; j < 8; ++j) { q0 += (float)qf00[j] * (float)qf00[j] + (float)qf01[j] * (float)qf01[j]; q1 += (float)qf10[j] * (float)qf10[j] + (float)qf11[j] * (float)qf11[j]; }
        q0 = xhalf_sum(q0); q1 = xhalf_sum(q1);
        const float m0 = sqrtf(q0 * km[0]) * 1.004f + 0.01f - 10.f, m1 = sqrtf(q1 * km[1]) * 1.004f + 0.01f - 10.f;
#pragma unroll
        for (int r = 0; r < 16; ++r) { negm0[r] = -m0; negm1[r] = -m1; }
    }
    const int srow = tid >> 3, sch = tid & 7;
    const h16* kg = Kd + ((size_t)(b * KEYS + kt0 * 64 + srow)) * 256 + h * 64 + sch * 8;
    const h16* vg = VdT + ((size_t)((b * 4 + h) * 64 + srow)) * KEYS + kt0 * 64 + sch * 8;
    const int sto = srow * 144 + sch * 16;
    const int koff = pi32(q32) * 144 + hi * 16, voff = 9216 + q32 * 144 + hi * 16;
    float l0 = 0.f, l1 = 0.f;
    f32x16 o00 = {}, o01 = {}, o10 = {}, o11 = {};
#define DA_MF(a_, b_, c_) __builtin_amdgcn_mfma_f32_32x32x16_f16(a_, b_, c_, 0, 0, 0)
#define DA_KLOAD(addr) do { const LAS unsigned char* kb_ = (addr); kf0a = *(const LAS h16x8*)(kb_); kf0b = *(const LAS h16x8*)(kb_ + 32); kf1a = *(const LAS h16x8*)(kb_ + 64); kf1b = *(const LAS h16x8*)(kb_ + 96); } while (0)
#define DA_VLOAD(addr) do { const LAS unsigned char* vb_ = (addr); v00 = *(const LAS h16x8*)(vb_); v10 = *(const LAS h16x8*)(vb_ + 4608); v01 = *(const LAS h16x8*)(vb_ + 32); v11 = *(const LAS h16x8*)(vb_ + 4608 + 32); } while (0)
#define DA_STEP(PP0a, PP0b, PP1a, PP1b, PN0a, PN0b, PN1a, PN1b, vaddr, kaddr) do { \
        o00 = DA_MF(v00, PP0a, o00); o10 = DA_MF(v00, PP1a, o10); o01 = DA_MF(v10, PP0a, o01); o11 = DA_MF(v10, PP1a, o11); \
        o00 = DA_MF(v01, PP0b, o00); o10 = DA_MF(v01, PP1b, o10); o01 = DA_MF(v11, PP0b, o01); o11 = DA_MF(v11, PP1b, o11); \
        da_exp_pack(s0, l0, PN0a, PN0b); \
        s0 = DA_MF(kf0a, qf00, negm0); s0 = DA_MF(kf0b, qf01, s0); \
        da_exp_pack(s1, l1, PN1a, PN1b); \
        s1 = DA_MF(kf1a, qf10, negm1); s1 = DA_MF(kf1b, qf11, s1); \
        DA_VLOAD(vaddr); DA_KLOAD(kaddr); \
    } while (0)
    __syncthreads();
    u32x4 kreg = *(const u32x4*)kg, vreg = *(const u32x4*)vg;
    *(LAS u32x4*)(lds + sto) = kreg; *(LAS u32x4*)(lds + 9216 + sto) = vreg;
    kreg = *(const u32x4*)(kg + (size_t)64 * 256); vreg = *(const u32x4*)(vg + 64);
    *(LAS u32x4*)(lds + DA_STAGE + sto) = kreg; *(LAS u32x4*)(lds + DA_STAGE + 9216 + sto) = vreg;
    if (nkt > 2) { kreg = *(const u32x4*)(kg + (size_t)2 * 64 * 256); vreg = *(const u32x4*)(vg + 2 * 64); }
    __syncthreads();
    f32x16 s0, s1;
    h16x8 kf0a, kf0b, kf1a, kf1b, v00, v10, v01, v11;
    h16x8 pa0a = zero8, pa0b = zero8, pa1a = zero8, pa1b = zero8, pb0a = zero8, pb0b = zero8, pb1a = zero8, pb1b = zero8;
    DA_KLOAD(lds + koff);
    s0 = DA_MF(kf0a, qf00, negm0); s0 = DA_MF(kf0b, qf01, s0);
    s1 = DA_MF(kf1a, qf10, negm1); s1 = DA_MF(kf1b, qf11, s1);
    DA_KLOAD(lds + koff + 4608);
    DA_VLOAD(lds + voff);
    int cur = 0, nxt = DA_STAGE, wrs = 2 * DA_STAGE;
    for (int t = 0; t < nkt; ++t) {
        if (t + 2 < nkt) { *(LAS u32x4*)(lds + wrs + sto) = kreg; *(LAS u32x4*)(lds + wrs + 9216 + sto) = vreg; }
        if (t + 3 < nkt) { kreg = *(const u32x4*)(kg + (size_t)(t + 3) * 64 * 256); vreg = *(const u32x4*)(vg + (size_t)(t + 3) * 64); }
        const int pf = (t + 1 < nkt) ? nxt : cur;
        DA_STEP(pb0a, pb0b, pb1a, pb1b, pa0a, pa0b, pa1a, pa1b, lds + cur + voff, lds + pf + koff);
        DA_STEP(pa0a, pa0b, pa1a, pa1b, pb0a, pb0b, pb1a, pb1b, lds + cur + voff + 64, lds + pf + koff + 4608);
        { const int tmp = cur; cur = nxt; nxt = wrs; wrs = tmp; }
        __syncthreads();
    }
    o00 = DA_MF(v00, pb0a, o00); o10 = DA_MF(v00, pb1a, o10); o01 = DA_MF(v10, pb0a, o01); o11 = DA_MF(v10, pb1a, o11);
    o00 = DA_MF(v01, pb0b, o00); o10 = DA_MF(v01, pb1b, o10); o01 = DA_MF(v11, pb0b, o01); o11 = DA_MF(v11, pb1b, o11);
#undef DA_MF
#undef DA_KLOAD
#undef DA_VLOAD
#undef DA_STEP
    const float lam = ((const float*)(ws + WS_LAM))[l];
    const float lam_init = 0.8f - 0.6f * expf(-0.3f * (float)l);
    const float r0 = 1.f / xhalf_sum(l0), r1 = lam / xhalf_sum(l1);
    f32x16 y0 = o00 * r0 - o10 * r1, y1 = o01 * r0 - o11 * r1;
    float ss = 0.f;
#pragma unroll
    for (int r = 0; r < 16; ++r) ss += y0[r] * y0[r] + y1[r] * y1[r];
    ss = xhalf_sum(ss);
    const float sc = rsqrtf(ss * (1.f / 64.f) + EPS) * (1.f - lam_init);
    const float* g = p->in[I_DSUBG] + l * 64;
    h16* dst = mix + (size_t)qrow * D + 768 + h * 64;
#pragma unroll
    for (int r4 = 0; r4 < 4; ++r4) {
        const int e0 = 8 * r4 + 4 * hi;
        const f32x4 g0 = *(const f32x4*)(g + e0), g1 = *(const f32x4*)(g + 32 + e0);
        u32x2 w0, w1;
        w0.x = pkh(y0[4 * r4] * sc * g0[0], y0[4 * r4 + 1] * sc * g0[1]); w0.y = pkh(y0[4 * r4 + 2] * sc * g0[2], y0[4 * r4 + 3] * sc * g0[3]);
        w1.x = pkh(y1[4 * r4] * sc * g1[0], y1[4 * r4 + 1] * sc * g1[1]); w1.y = pkh(y1[4 * r4 + 2] * sc * g1[2], y1[4 * r4 + 3] * sc * g1[3]);
        *(u32x2*)(dst + e0) = w0; *(u32x2*)(dst + 32 + e0) = w1;
    }
}

constexpr int NA_K = 0, NA_V = 33792, NA_BIAS = 33792 + 36864;
__device__ __forceinline__ void na_unit(KP p, int l, int b, int gr, bool isctx, LAS unsigned char* lds) {
    const int tid = tid_now(), lane = tid & 63, wid = __builtin_amdgcn_readfirstlane(tid >> 6), q32 = lane & 31, hi = lane >> 5;
    const int h = wid >> 1, qt = wid & 1;
    unsigned char* ws = p->ws;
    const h16* qa = (const h16*)(ws + WS_QA); const h16* Ka = (const h16*)(ws + WS_KA); const h16* VaT = (const h16*)(ws + WS_VAT);
    h16* mix = (h16*)(ws + WS_MIX);
    const int qrow = isctx ? (NLAT + b * CTX + gr * 64 + qt * 32 + q32) : (b * SEQ + gr * 64 + qt * 32 + q32);
    h16x8 qf[4];
#pragma unroll
    for (int ks = 0; ks < 4; ++ks) qf[ks] = *(const h16x8*)(qa + (size_t)qrow * 256 + h * 64 + ks * 16 + hi * 8);
    const int nloc = isctx ? 0 : 8, ntile = nloc + 4;
    int kr0 = gr - 4; kr0 = kr0 < 0 ? 0 : (kr0 > 120 ? 120 : kr0);
    LAS float* bias = (LAS float*)(lds + NA_BIAS);
    __syncthreads();
    if (!isctx) { const float* rp = p->in[I_RPB] + (size_t)l * 4 * 15 * 31; for (int i = tid; i < 4 * 15 * 31; i += NTHREADS) bias[i] = rp[i] * LOG2E; }
    const int koff = NA_K + pi32(q32) * 528 + h * 128 + hi * 16;
    const int voff = NA_V + (h * 64 + q32) * 144 + hi * 16;
    const int cq = qt * 32 + q32; int cs = cq - 8; cs = cs < 0 ? 0 : (cs > 48 ? 48 : cs);
    float m = 0.f, ls = 0.f; f32x16 o0 = {}, o1 = {};
    u32x4 kpre[4], vpre[4];
#define NA_LOAD(t_) do { const int key0_ = ((t_) < nloc) ? (kr0 + (t_)) * 64 : SEQ + ((t_) - nloc) * 64; \
        _Pragma("unroll") for (int i = 0; i < 4; ++i) { const int id = tid + 512 * i; \
            kpre[i] = *(const u32x4*)(Ka + ((size_t)(b * KEYS + key0_ + (id >> 5))) * 256 + (id & 31) * 8); \
            vpre[i] = *(const u32x4*)(VaT + ((size_t)(b * 256 + (id >> 3))) * KEYS + key0_ + (id & 7) * 8); } } while (0)
    NA_LOAD(0);
    for (int t = 0; t < ntile; ++t) {
        __syncthreads();
#pragma unroll
        for (int i = 0; i < 4; ++i) { const int id = tid + 512 * i;
            *(LAS u32x4*)(lds + NA_K + (id >> 5) * 528 + (id & 31) * 16) = kpre[i];
            *(LAS u32x4*)(lds + NA_V + (id >> 3) * 144 + (id & 7) * 16) = vpre[i]; }
        __syncthreads();
        if (t + 1 < ntile) NA_LOAD(t + 1);
#pragma unroll
        for (int th = 0; th < 2; ++th) {
            f32x16 s = {};
#pragma unroll
            for (int ks = 0; ks < 4; ++ks) { const h16x8 kf = *(const LAS h16x8*)(lds + koff + th * 32 * 528 + ks * 32); s = __builtin_amdgcn_mfma_f32_32x32x16_f16(kf, qf[ks], s, 0, 0, 0); }
            if (t < nloc) {
                const int dr = kr0 + t - gr;
                const LAS float* browl = bias + (h * 15 + dr + 7) * 31 + 15 - cq + 8 * hi; const int dwin = 8 * hi - cs;
#pragma unroll
                for (int r = 0; r < 16; ++r) { const int cr_ = 32 * th + 16 * (r >> 3) + (r & 7);
                    s[r] = ((unsigned)(cr_ + dwin) < 16u) ? s[r] + browl[cr_] : -INFINITY; }
            }
            h16x8 pa, pb;
            SOFTMAX_TILE(s, m, ls, o0, o1, pa, pb);
            const h16x8 v00 = *(const LAS h16x8*)(lds + voff + th * 64), v10 = *(const LAS h16x8*)(lds + voff + 32 * 144 + th * 64);
            const h16x8 v01 = *(const LAS h16x8*)(lds + voff + th * 64 + 32), v11 = *(const LAS h16x8*)(lds + voff + 32 * 144 + th * 64 + 32);
            o0 = __builtin_amdgcn_mfma_f32_32x32x16_f16(v00, pa, o0, 0, 0, 0); o1 = __builtin_amdgcn_mfma_f32_32x32x16_f16(v10, pa, o1, 0, 0, 0);
            o0 = __builtin_amdgcn_mfma_f32_32x32x16_f16(v01, pb, o0, 0, 0, 0); o1 = __builtin_amdgcn_mfma_f32_32x32x16_f16(v11, pb, o1, 0, 0, 0);
        }
    }
    const float rl = 1.f / xhalf_sum(ls);
    h16* dst = mix + (size_t)qrow * D + h * 64;
#pragma unroll
    for (int r4 = 0; r4 < 4; ++r4) {
        const int e0 = 8 * r4 + 4 * hi; u32x2 w0, w1;
        w0.x = pkh(o0[4 * r4] * rl, o0[4 * r4 + 1] * rl); w0.y = pkh(o0[4 * r4 + 2] * rl, o0[4 * r4 + 3] * rl);
        w1.x = pkh(o1[4 * r4] * rl, o1[4 * r4 + 1] * rl); w1.y = pkh(o1[4 * r4 + 2] * rl, o1[4 * r4 + 3] * rl);
        *(u32x2*)(dst + e0) = w0; *(u32x2*)(dst + 32 + e0) = w1;
    }
}

constexpr int RG_X32 = 0, RG_X16 = 16384, RG_W = 25600, RG_AB = 62464, RG_SEG = 128000;
__device__ __forceinline__ void rg_load_x(h16x8 (&xv)[4], const h16* xr, int q, int tid, bool valid) {
    const int RT = q >> 3, nb = q & 7;
    const int r = tid >> 3, ch = nb * 64 + (tid & 7) * 8;
    const bool isctx = RT >= 256; const int j = isctx ? ((RT - 256) & 3) : (RT & 127); const int seqlen = isctx ? CTX : SEQ;
#pragma unroll
    for (int tap = 0; tap < 4; ++tap) {
        const int t = j * 64 + r + tap - 2;
        if (valid && t >= 0 && t < seqlen) xv[tap] = *(const h16x8*)(xr + (size_t)(RT * 64 + r + tap - 2) * 512 + ch);
        else xv[tap] = (h16x8){0, 0, 0, 0, 0, 0, 0, 0};
    }
}
__device__ __forceinline__ void rg_gate_block(KP p, int l, int q0, int qstride, int qend, LAS unsigned char* lds, const int mode) {
    const int tid = tid_now(), lane = tid & 63, wid = __builtin_amdgcn_readfirstlane(tid >> 6), q32 = lane & 31, hi = lane >> 5;
    unsigned char* ws = p->ws;
    const h16* xr = (const h16*)(ws + WS_XR);
    float* agg = (float*)(ws + WS_AGG);
    const h16* gg = (const h16*)(ws + WS_GG); h16* mix = (h16*)(ws + WS_MIX);
    LAS float* x32 = (LAS float*)(lds + RG_X32); LAS h16* x16 = (LAS h16*)(lds + RG_X16); LAS h16* Wl = (LAS h16*)(lds + RG_W); LAS float* ab = (LAS float*)(lds + RG_AB); LAS float* seg = (LAS float*)(lds + RG_SEG);
    LAS float* carryL = (LAS float*)(lds + RG_SEG + 4096);
    if (q0 >= qend) return;
    const int nb0 = q0 & 7;
    const bool skip_ctx_out = (l == DEPTH - 1);
    h16x8 xv[4];
    rg_load_x(xv, xr, q0, tid, true);
    if (mode == 1 && tid < 256) {
        const int dir = tid >> 7, b = (tid >> 6) & 1, chl = tid & 63;
        const float* ag = agg + ((((size_t)dir * 2 + b) * 132) * 512 + nb0 * 64 + chl) * 2;
        float h = 0.f;
#pragma unroll 1
        for (int c0 = 0; c0 < 132; c0 += 33) {
            f32x2 v[33];
#pragma unroll
            for (int i = 0; i < 33; ++i) v[i] = *(const f32x2*)(ag + (size_t)(c0 + i) * 1024);
#pragma unroll
            for (int i = 0; i < 33; ++i) {
                const int c = c0 + i;
                int RT; if (dir == 0) RT = (c < 4) ? 256 + 4 * b + c : 128 * b + (c - 4); else RT = (c < 4) ? 256 + 4 * b + (3 - c) : 128 * b + 127 - (c - 4);
                const int dq = RT * 8 + nb0 - q0;
                if (dq >= 0 && (dq % qstride) == 0 && dq / qstride < 12) carryL[((dq / qstride) * 2 + dir) * 64 + chl] = h;
                h = v[i].x * h + v[i].y;
            }
        }
    }
    int cur_nb = -1;
    float cwr[4][8], cbr[8]; float g_br, g_bi, g_sp;
#define RG_LOAD_CONSTS(nb_) do { \
        const int ch_ = (nb_) * 64 + (tid & 7) * 8; const float* cw_ = p->in[I_CONVW] + (size_t)l * 4 * 512 + ch_; const float* cb_ = p->in[I_CONVB] + l * 512 + ch_; \
        _Pragma("unroll") for (int e = 0; e < 8; ++e) { cbr[e] = cb_[e]; _Pragma("unroll") for (int tap = 0; tap < 4; ++tap) cwr[tap][e] = cw_[tap * 512 + e]; } \
        const int dir_ = wid >> 2, chg_ = (nb_) * 64 + ((wid >> 1) & 1) * 32 + q32; \
        g_br = p->in[I_RGBR][(l * 2 + dir_) * 512 + chg_]; g_bi = p->in[I_RGBI][(l * 2 + dir_) * 512 + chg_]; \
        const float lamv_ = p->in[I_RGLAM][(l * 2 + dir_) * 512 + chg_]; g_sp = (lamv_ > 15.f) ? __expf(-lamv_) : log1pf(__expf(-lamv_)); } while (0)
    RG_LOAD_CONSTS(nb0);
    int const_nb = nb0;
    __syncthreads();
    int kt = 0;
    for (int q = q0; q < qend; q += qstride, ++kt) {
        const int RT = q >> 3, nb = q & 7;
        const int row0 = RT * 64;
        const bool isctx = RT >= 256; int b, j;
        if (isctx) { const int qq = RT - 256; b = qq >> 2; j = qq & 3; } else { b = RT >> 7; j = RT & 127; }
        h16x8 ggv;
        {
            const int r = tid >> 3, c8 = (tid & 7) * 8, ch = nb * 64 + c8;
            if (mode == 1) ggv = *(const h16x8*)(gg + (size_t)(row0 + r) * 512 + ch);
            if (nb != const_nb) { RG_LOAD_CONSTS(nb); const_nb = nb; }
            float accv[8];
#pragma unroll
            for (int e = 0; e < 8; ++e) accv[e] = cbr[e];
#pragma unroll
            for (int tap = 0; tap < 4; ++tap)
#pragma unroll
                for (int e = 0; e < 8; ++e) accv[e] += (float)xv[tap][e] * cwr[tap][e];
            *(LAS f32x4*)(x32 + r * 64 + c8) = (f32x4){accv[0], accv[1], accv[2], accv[3]}; *(LAS f32x4*)(x32 + r * 64 + c8 + 4) = (f32x4){accv[4], accv[5], accv[6], accv[7]};
            { u32x4 w; w.x = pkh(accv[0], accv[1]); w.y = pkh(accv[2], accv[3]); w.z = pkh(accv[4], accv[5]); w.w = pkh(accv[6], accv[7]); *(LAS u32x4*)(x16 + r * 72 + c8) = w; }
            if (nb != cur_nb) {
                const h16* wsrc = (const h16*)(ws + WS_RGW);
#pragma unroll
                for (int i = 0; i < 4; ++i) { const int id = tid + 512 * i; const int n = id >> 3, kc = id & 7; const int dg = n >> 6, nn = n & 63;
                    *(LAS u32x4*)(Wl + n * 72 + kc * 8) = *(const u32x4*)(wsrc + (((size_t)(l * 4 + dg) * 8 + nb) * 64 + nn) * 64 + kc * 8); }
                cur_nb = nb;
            }
        }
        lds_barrier();
        rg_load_x(xv, xr, q + qstride, tid, q + qstride < qend);
        {
            const int mt = wid & 1, g = wid >> 1, dir = g >> 1, ch2 = g & 1;
            f32x16 cr = {}, ci = {};
#pragma unroll
            for (int ks = 0; ks < 4; ++ks) {
                const h16x8 af = *(const LAS h16x8*)(x16 + (mt * 32 + q32) * 72 + ks * 16 + hi * 8);
                const h16x8 br = *(const LAS h16x8*)(Wl + (dir * 128 + ch2 * 32 + q32) * 72 + ks * 16 + hi * 8);
                const h16x8 bi = *(const LAS h16x8*)(Wl + (dir * 128 + 64 + ch2 * 32 + q32) * 72 + ks * 16 + hi * 8);
                cr = __builtin_amdgcn_mfma_f32_32x32x16_f16(af, br, cr, 0, 0, 0);
                ci = __builtin_amdgcn_mfma_f32_32x32x16_f16(af, bi, ci, 0, 0, 0);
            }
            const int chl = ch2 * 32 + q32;
            const float nbr = -g_br * LOG2E, nbi = -g_bi * LOG2E, c8 = -8.f * g_sp * LOG2E;
#pragma unroll
            for (int r = 0; r < 16; ++r) {
                const int tr = mt * 32 + crow(r, hi);
                const float rg = frcp_(1.f + __builtin_amdgcn_exp2f(__builtin_fmaf(cr[r], -LOG2E, nbr)));
                const float ig = frcp_(1.f + __builtin_amdgcn_exp2f(__builtin_fmaf(ci[r], -LOG2E, nbi)));
                const float a = __builtin_amdgcn_exp2f(rg * c8);
                const float om = __builtin_fmaf(-a, a, 1.f);
                const float bx = __builtin_amdgcn_sqrtf(om) * ig * x32[tr * 64 + chl];
                ab[((dir * 2 + 0) * 64 + tr) * 64 + chl] = a; ab[((dir * 2 + 1) * 64 + tr) * 64 + chl] = bx;
            }
        }
        lds_barrier();
        if (mode == 0) {
            {
                const int sg = tid >> 7, dir = (tid >> 6) & 1, chl = tid & 63; float A = 1.f, H = 0.f;
                const LAS float* pa = ab + (dir * 2 + 0) * 4096 + sg * 16 * 64 + chl; const LAS float* pb = ab + (dir * 2 + 1) * 4096 + sg * 16 * 64 + chl;
                if (dir == 0) {
#pragma unroll
                    for (int r = 0; r < 16; ++r) { const float a = pa[r * 64]; H = a * H + pb[r * 64]; A *= a; }
                } else {
#pragma unroll
                    for (int r = 15; r >= 0; --r) { const float a = pa[r * 64]; H = a * H + pb[r * 64]; A *= a; }
                }
                seg[((dir * 4 + sg) * 64 + chl) * 2] = A; seg[((dir * 4 + sg) * 64 + chl) * 2 + 1] = H;
            }
            lds_barrier();
            if (tid < 128) {
                const int dir = tid >> 6, chl = tid & 63; float A = 1.f, H = 0.f;
#pragma unroll
                for (int i = 0; i < 4; ++i) { const int sg = dir ? 3 - i : i; const float a = seg[((dir * 4 + sg) * 64 + chl) * 2], hh = seg[((dir * 4 + sg) * 64 + chl) * 2 + 1]; H = a * H + hh; A *= a; }
                int c;
                if (dir == 0) c = isctx ? j : 4 + j; else c = isctx ? 3 - j : 4 + 127 - j;
                float* dst = agg + ((((size_t)dir * 2 + b) * 132 + c) * 512 + nb * 64 + chl) * 2;
                dst[0] = A; dst[1] = H;
            }
        } else {
            if (tid < 128) {
                const int dir = tid >> 6, chl = tid & 63;
                float h = carryL[(kt * 2 + dir) * 64 + chl];
                LAS float* pa = ab + (dir * 2 + 0) * 4096 + chl; LAS float* pb = ab + (dir * 2 + 1) * 4096 + chl;
#pragma unroll 1
                for (int g0 = 0; g0 < 64; g0 += 16) {
                    const int r0 = dir ? 48 - g0 : g0;
                    float av[16], bv[16];
#pragma unroll
                    for (int i = 0; i < 16; ++i) { av[i] = pa[(r0 + i) * 64]; bv[i] = pb[(r0 + i) * 64]; }
                    if (dir == 0) {
#pragma unroll
                        for (int i = 0; i < 16; ++i) { h = av[i] * h + bv[i]; bv[i] = h; }
                    } else {
#pragma unroll
                        for (int i = 15; i >= 0; --i) { h = av[i] * h + bv[i]; bv[i] = h; }
                    }
#pragma unroll
                    for (int i = 0; i < 16; ++i) pb[(r0 + i) * 64] = bv[i];
                }
            }
            lds_barrier();
            if (!(isctx && skip_ctx_out)) {
                const int r = tid >> 3, c8 = (tid & 7) * 8;
                const LAS float* hf = ab + (0 * 2 + 1) * 4096 + r * 64 + c8; const LAS float* hb = ab + (1 * 2 + 1) * 4096 + r * 64 + c8;
                u32x4 w;
                w.x = pkh((hf[0] + hb[0]) * (float)ggv[0], (hf[1] + hb[1]) * (float)ggv[1]); w.y = pkh((hf[2] + hb[2]) * (float)ggv[2], (hf[3] + hb[3]) * (float)ggv[3]);
                w.z = pkh((hf[4] + hb[4]) * (float)ggv[4], (hf[5] + hb[5]) * (float)ggv[5]); w.w = pkh((hf[6] + hb[6]) * (float)ggv[6], (hf[7] + hb[7]) * (float)ggv[7]);
                *(u32x4*)(mix + (size_t)(row0 + r) * D + 256 + nb * 64 + c8) = w;
            }
        }
    }
}

__device__ __forceinline__ void phase_mix(KP p, int l, LAS unsigned char* lds, int G) {
    const bool last = (l == DEPTH - 1);
    const int n_dc = last ? 0 : 8, n_nc = last ? 0 : 8;
    const int U0 = 256, U1 = U0 + n_dc, U2 = U1 + 256, U3 = U2 + n_nc, U4 = U3 + 264 * 8;
    int u = blockIdx.x;
    for (; u < U3; u += G) {
        if (u < U0) { const int bh = u >> 5, qb = u & 31; REP(30) diff_unit(p, l, bh >> 2, bh & 3, (bh >> 2) * SEQ + qb * 256, 0, 132, lds); }
        else if (u < U1) { const int bh = u - U0; diff_unit(p, l, bh >> 2, bh & 3, NLAT + (bh >> 2) * CTX, 128, 4, lds); }
        else if (u < U2) { const int q = u - U1; REP(31) na_unit(p, l, q >> 7, q & 127, false, lds); }
        else { const int q = u - U2; na_unit(p, l, q >> 2, q & 3, true, lds); }
    }
    REP(32) rg_gate_block(p, l, u - U3, G, U4 - U3, lds, 0);
}

__device__ __forceinline__ void phase_scan(KP p, int l, LAS unsigned char* lds, int G) {
    const bool last = (l == DEPTH - 1);
    const int U3 = 256 + (last ? 0 : 8) + 256 + (last ? 0 : 8);
    int u = blockIdx.x; while (u < U3) u += G;
    rg_gate_block(p, l, u - U3, G, 264 * 8, lds, 1);
}

__device__ __forceinline__ void phase_route(KP p, int l, LAS unsigned char* lds, int vcu, int G, bool dummy) {
    const int tid = tid_now(), lane = tid & 63, wave = __builtin_amdgcn_readfirstlane(tid >> 6);
    unsigned char* ws = p->ws;
    const float* xl = (const float*)(ws + WS_XL); h16* xg = (h16*)(ws + (dummy ? WS_YB : WS_XG));
    const float* mod = (const float*)(ws + WS_MOD);
    int* asg = (int*)(ws + (dummy ? 7 * MiB : WS_ASG)); float* ew = (float*)(ws + (dummy ? 7 * MiB + 512 * 1024 : WS_EW));
    unsigned* cnt = (unsigned*)(ws + WS_CTL) + CW_CNT + l * 32 + (dummy ? 512 : 0);
    unsigned* pool = (unsigned*)(ws + WS_CTL) + CW_POOL + l + (dummy ? 8 : 0); unsigned* tmap = (unsigned*)(ws + WS_CTL) + (dummy ? 32768 : CW_TMAP) + l * 32 * 72; unsigned* owner = (unsigned*)(ws + WS_CTL) + (dummy ? 45000 : CW_OWNER) + l * 192;
    const int nrows = (l == DEPTH - 1) ? NLAT : NROW;
    LAS h16* xh = (LAS h16*)lds; LAS h16* xlo = (LAS h16*)(lds + 33024); LAS float* part = (LAS float*)(lds + 66048); LAS float* logit = (LAS float*)(lds + 90624);
    const float* wg = p->in[I_RWG] + (size_t)l * D * 4; const float* we = p->in[I_RWE] + (size_t)l * D * 32;
    const float* g = p->in[I_GFFN] + l * D;
    const int c16 = lane & 15, kq = lane >> 4;
    h16x8 bh[4][3], bl[4][3];
#pragma unroll
    for (int ks = 0; ks < 4; ++ks)
#pragma unroll
        for (int nt = 0; nt < 3; ++nt) {
            const int n = nt * 16 + c16;
#pragma unroll
            for (int j = 0; j < 8; ++j) {
                const int k = wave * 128 + ks * 32 + kq * 8 + j;
                float w = (n < 32) ? we[(size_t)k * 32 + n] : ((n < 36) ? wg[(size_t)k * 4 + (n - 32)] : 0.f);
                w *= 64.f; const h16 hh = (h16)w; bh[ks][nt][j] = hh; bl[ks][nt][j] = (h16)(w - (float)hh);
            }
        }
    LAS int* r_e = (LAS int*)(lds + 93184);
    LAS int* r_rk = r_e + 80;
    LAS float* r_w = (LAS float*)(r_rk + 80);
    LAS int* hist = (LAS int*)(r_w + 160);
    LAS int* baseL = hist + 32;
    LAS int* slotL = baseL + 32;
    h16* hl = (h16*)(ws + WS_HL);
    int* rlist = (int*)((unsigned*)(ws + WS_CTL) + CW_RLIST + l * (MAXTILES * 256));
    if (tid < 32) hist[tid] = 0;
    const int ngroups = nrows / 16;
    int nloc = 0;
    const unsigned* done5 = (const unsigned*)(ws + WS_CTL) + CW_D5 + l * 128;
    const int nskip = 0;
    const int rG = G - (nskip > 0 ? nskip : 0), ridx = (int)blockIdx.x - (nskip > 0 ? nskip : 0);
    if (ridx < 0) return;
    if (tid < 64) {
        for (int grp = ridx; grp < ngroups; grp += rG) {
            const unsigned need = (grp >> 4) >= NLAT / 256 ? 16u : 4u; unsigned spins = 0;
            while ((unsigned)__builtin_amdgcn_readfirstlane(__hip_atomic_load(done5 + (grp >> 4), __ATOMIC_RELAXED, __HIP_MEMORY_SCOPE_AGENT)) < need) { __builtin_amdgcn_s_sleep(2); if (++spins > (1u << 24)) break; }
        }
        __builtin_amdgcn_fence(__ATOMIC_ACQUIRE, "agent");
        asm volatile("s_waitcnt vmcnt(0)" ::: "memory");
    }
    __syncthreads();
    f32x4 xr[2][4];
#define R6_LOAD(grp_) do { _Pragma("unroll") for (int rr = 0; rr < 2; ++rr) { const int row_ = (grp_) * 16 + wave * 2 + rr; \
            _Pragma("unroll") for (int j = 0; j < 4; ++j) xr[rr][j] = *(const f32x4*)(xl + (size_t)row_ * D + 4 * lane + 256 * j); } } while (0)
    if (ridx < ngroups) R6_LOAD(ridx);
    for (int grp = ridx, kk = 0; grp < ngroups; grp += rG, ++kk) {
        lds_barrier();
#pragma unroll
        for (int rr = 0; rr < 2; ++rr) {
            const int lr = wave * 2 + rr, row = grp * 16 + lr; const int v = (row < NLAT) ? (row >> 13) : 2;
            f32x4 x[4]; float ss = 0.f;
#pragma unroll
            for (int j = 0; j < 4; ++j) x[j] = xr[rr][j];
            if (row >= NLAT && l != DEPTH - 1) {
                const float* pp = (const float*)(ws + WS_RGA) + (size_t)(row - NLAT) * D;
#pragma unroll
                for (int kq = 0; kq < 4; ++kq)
#pragma unroll
                    for (int j = 0; j < 4; ++j) x[j] += *(const f32x4*)(pp + (size_t)kq * NCTX * D + 4 * lane + 256 * j);
#pragma unroll
                for (int j = 0; j < 4; ++j) *(f32x4*)((float*)(ws + WS_XL) + (size_t)row * D + 4 * lane + 256 * j) = x[j];
            }
#pragma unroll
            for (int j = 0; j < 4; ++j) ss += x[j][0] * x[j][0] + x[j][1] * x[j][1] + x[j][2] * x[j][2] + x[j][3] * x[j][3];
            const float rstd = rsqrtf(wave_sum(ss) * (1.f / D) + EPS);
            const float* sh = mod + ((size_t)l * 3 + v) * 6144 + 3 * 1024; const float* scl = sh + 1024;
            h16* o = hl + (size_t)row * D;
#pragma unroll
            for (int j = 0; j < 4; ++j) { const int c = 4 * lane + 256 * j; const f32x4 gv = *(const f32x4*)(g + c), sv = *(const f32x4*)(scl + c), hv = *(const f32x4*)(sh + c);
                const f32x4 y = x[j] * rstd * gv * (1.f + sv) + hv;
                h16x4 yh, yl;
#pragma unroll
                for (int e = 0; e < 4; ++e) { yh[e] = (h16)y[e]; yl[e] = (h16)(y[e] - (float)yh[e]); }
                *(LAS h16x4*)(xh + lr * 1032 + c) = yh; *(LAS h16x4*)(xlo + lr * 1032 + c) = yl; *(h16x4*)(o + c) = yh; }
        }
        if (grp + rG < ngroups) R6_LOAD(grp + rG);
        lds_barrier();
        {
            f32x4 acc[3] = {{0.f, 0.f, 0.f, 0.f}, {0.f, 0.f, 0.f, 0.f}, {0.f, 0.f, 0.f, 0.f}};
#pragma unroll
            for (int ks = 0; ks < 4; ++ks) {
                const int ko = c16 * 1032 + wave * 128 + ks * 32 + kq * 8;
                const h16x8 ah = *(const LAS h16x8*)(xh + ko), al = *(const LAS h16x8*)(xlo + ko);
#pragma unroll
                for (int nt = 0; nt < 3; ++nt) {
                    acc[nt] = __builtin_amdgcn_mfma_f32_16x16x32_f16(ah, bh[ks][nt], acc[nt], 0, 0, 0);
                    acc[nt] = __builtin_amdgcn_mfma_f32_16x16x32_f16(ah, bl[ks][nt], acc[nt], 0, 0, 0);
                    acc[nt] = __builtin_amdgcn_mfma_f32_16x16x32_f16(al, bh[ks][nt], acc[nt], 0, 0, 0);
                }
            }
#pragma unroll
            for (int nt = 0; nt < 3; ++nt)
#pragma unroll
                for (int r = 0; r < 4; ++r) part[(wave * 16 + kq * 4 + r) * 48 + nt * 16 + c16] = acc[nt][r];
        }
        lds_barrier();
        for (int i = tid; i < 16 * 36; i += NTHREADS) { const int r = i / 36, o = i % 36; const int n = (o < 4) ? 32 + o : o - 4;
            float sacc = 0.f;
#pragma unroll
            for (int w = 0; w < 8; ++w) sacc += part[(w * 16 + r) * 48 + n];
            logit[i] = sacc * (1.f / 64.f) + ((o < 4) ? p->in[I_RBG][l * 4 + o] : p->in[I_RBE][l * 32 + o - 4]); }
        lds_barrier();
        if (tid < 16) {
            const LAS float* lg = logit + tid * 36;
            int gi = 0; float gm = lg[0];
#pragma unroll
            for (int i = 1; i < 4; ++i) if (lg[i] > gm) { gm = lg[i]; gi = i; }
            float gs = 0.f;
#pragma unroll
            for (int i = 0; i < 4; ++i) gs += __expf(lg[i] - gm);
            const float gtop = 1.f / gs;
            const LAS float* el = lg + 4 + gi * 8;
            int i1 = 0; float m1 = el[0];
#pragma unroll
            for (int i = 1; i < 8; ++i) if (el[i] > m1) { m1 = el[i]; i1 = i; }
            int i2 = -1; float m2 = -INFINITY;
#pragma unroll
            for (int i = 0; i < 8; ++i) if (i != i1 && el[i] > m2) { m2 = el[i]; i2 = i; }
            const float e2 = __expf(m2 - m1); const float inv = 1.f / (1.f + e2);
            const int ea = gi * 8 + i1, eb = gi * 8 + i2;
            const int ra = atomicAdd((int*)(hist + ea), 1), rb = atomicAdd((int*)(hist + eb), 1);
            const int lr = kk * 16 + tid;
            r_e[lr] = ea | (eb << 8); r_rk[lr] = ra | (rb << 16); r_w[lr * 2] = gtop * inv; r_w[lr * 2 + 1] = gtop * e2 * inv;
        }
        nloc = kk * 16 + 16;
    }
    __syncthreads();
    if (tid < 32) {
        const int n = hist[tid]; int base = 0;
        if (n > 0) {
            base = (int)atomicAdd(&cnt[tid], (unsigned)n);
            const int j0 = base >> 8, j1 = (base + n - 1) >> 8;
            if ((base & 255) == 0) { const unsigned t = atomicAdd(pool, 1u); __hip_atomic_store(owner + t, (unsigned)tid, __ATOMIC_RELAXED, __HIP_MEMORY_SCOPE_AGENT); __hip_atomic_store(tmap + tid * 72 + j0, t + 1u, __ATOMIC_RELAXED, __HIP_MEMORY_SCOPE_AGENT); }
            if (j1 != j0) { const unsigned t = atomicAdd(pool, 1u); __hip_atomic_store(owner + t, (unsigned)tid, __ATOMIC_RELAXED, __HIP_MEMORY_SCOPE_AGENT); __hip_atomic_store(tmap + tid * 72 + j1, t + 1u, __ATOMIC_RELAXED, __HIP_MEMORY_SCOPE_AGENT); }
        }
        baseL[tid] = base;
    }
    __syncthreads();
    if (tid < nloc) {
        const int lr = tid, grp = ridx + (lr >> 4) * rG, row = grp * 16 + (lr & 15);
        const int ee = r_e[lr], rk = r_rk[lr]; const int ea = ee & 255, eb = ee >> 8;
        const unsigned pa = (unsigned)(baseL[ea] + (rk & 0xffff)), pb = (unsigned)(baseL[eb] + (rk >> 16));
        unsigned* tma = tmap + ea * 72 + (pa >> 8); unsigned* tmb = tmap + eb * 72 + (pb >> 8);
        unsigned ta = 0u, tb = 0u, spin = 0u;
        while (ta == 0u || tb == 0u) {
            if (ta == 0u) ta = __hip_atomic_load(tma, __ATOMIC_RELAXED, __HIP_MEMORY_SCOPE_AGENT);
            if (tb == 0u) tb = __hip_atomic_load(tmb, __ATOMIC_RELAXED, __HIP_MEMORY_SCOPE_AGENT);
            if (++spin > (1u << 22)) break;
        }
        const int sa_ = (int)((ta - 1u) * 256u + (pa & 255u)), sb_ = (int)((tb - 1u) * 256u + (pb & 255u));
        asg[row * 2] = sa_; asg[row * 2 + 1] = sb_;
        ew[row * 2] = r_w[lr * 2]; ew[row * 2 + 1] = r_w[lr * 2 + 1];
        rlist[sa_] = row; rlist[sb_] = row;
    }
}

__device__ __forceinline__ void moe_table(KP p, int l, volatile LAS int* tab) {
    __syncthreads();
    if (tid_now() == 0) {
        const unsigned* cnt = (const unsigned*)(p->ws + WS_CTL) + CW_CNT + l * 32; int s = 0;
        for (int e = 0; e < NEXP; ++e) { tab[e] = s; s += (int)((__hip_atomic_load(cnt + e, __ATOMIC_RELAXED, __HIP_MEMORY_SCOPE_AGENT) + 255u) >> 8); }
        tab[NEXP] = s;
    }
    __syncthreads();
}

__global__ void __launch_bounds__(NTHREADS, 2) fwd_kernel(Params p_) {
    KP p = (KP)__builtin_amdgcn_kernarg_segment_ptr();
#define RELOAD_P() asm volatile("" : "+s"(p))
    extern __shared__ __attribute__((aligned(16))) unsigned char lds_raw[];
    LAS unsigned char* lds = (LAS unsigned char*)lds_raw;
    volatile LAS unsigned* MISC = (volatile LAS unsigned*)(lds + MISC_OFF);
    volatile LAS int* tab = (volatile LAS int*)(lds + MISC_OFF + 64);
    const int tid = threadIdx.x;
    const int G = gridDim.x; const int bx = blockIdx.x; const int vcu = (G % 8 == 0) ? (bx % 8) * (G / 8) + bx / 8 : bx;
    unsigned char* ws = p->ws;
    for (int u = tid; u < 256; u += NTHREADS) MISC[u] = 0u;
    __syncthreads();
    {
        XcdBarrier b0 = xcd_barrier_post((unsigned*)(ws + WS_CTL) + CW_BAR, MISC);
        cg::this_grid().sync();
        if (tid == 0) { unsigned nloc, nx; xcd_barrier_complete(b0.bar, b0.x, nloc, nx); MISC[0] = nloc; MISC[1] = nx; }
        __syncthreads();
    }
#define GRID_BAR() do { GRID_BAR1(); if (PROBE_REPEAT == 99) GRID_BAR1(); if (PROBE_STAMP >= 0 && blockIdx.x == 0 && tid == 0) { ((unsigned long long*)(ws + WS_LAM + 1024))[nstamp] = __builtin_amdgcn_s_memrealtime(); } ++nstamp; } while (0)
#define GRID_BAR1() do { RELOAD_P(); { unsigned char* w_ = p->ws; XcdBarrier b_; b_.bar = (unsigned*)(w_ + WS_CTL) + CW_BAR; b_.x = xb_xcc_id(); b_.st = MISC; xcd_barrier(b_); } \
    RELOAD_P(); ws = p->ws; } while (0)
#ifdef ONLY_PHASE
#define PH(n) (ONLY_PHASE == (n))
#else
#define PH(n) 1
#endif

    int nstamp = 0;
    if (PROBE_STAMP >= 0 && blockIdx.x == 0 && tid == 0) ((unsigned long long*)(ws + WS_LAM + 1024))[63] = __builtin_amdgcn_s_memrealtime();
    REP(0) if (PH(0)) phase_p0(p, lds, vcu, G);
    GRID_BAR();
#pragma unroll 1
    for (int l = 0; l < DEPTH; ++l) {
        const bool last = (l == DEPTH - 1);
        REP(1) if (PH(1)) phase_norm1(p, l, l == 0 ? 0 : 1, tab, vcu, G, DUMMY(1));
        GRID_BAR();
        REP(2) if (PH(2)) {
            pg8::DenseSched S; S.init(ws + WS_HL, ws + WS_WIN + (size_t)l * INC * D * 2, NROW, INC, D, G, bx);
            EpiInProj E{(h16*)(ws + WS_QA), (h16*)(ws + WS_KA), (h16*)(ws + WS_VAT), (h16*)(ws + WS_XR), (h16*)(ws + WS_GG), (h16*)(ws + WS_QD), (h16*)(ws + WS_KD), (h16*)(ws + WS_VDT), (const f32x2*)(ws + WS_ROPE), (unsigned*)(ws + WS_CTL) + CW_KMAX + l * 16, lds + 131072};
            pg8::gemm_phase<EpiInProj, pg8::DenseSched>(lds, D, S, E);
        }
        GRID_BAR();
        if (PH(3)) phase_mix(p, l, lds, G);
        GRID_BAR();
        REP(4) if (PH(4)) phase_scan(p, l, lds, G);
        GRID_BAR();
        REP(5) if (PH(5)) {
            pg8::DenseSched S; S.init(ws + WS_MIX, ws + WS_WOUT + (size_t)l * D * D * 2, NLAT, D, D, G, bx, (unsigned*)(ws + WS_CTL) + CW_D5 + l * 128);
            EpiOutProj E{(float*)(ws + WS_XL), (const float*)(ws + WS_MOD) + (size_t)l * 3 * 6144, (float*)(ws + WS_XL)};
            pg8::gemm_phase<EpiOutProj, pg8::DenseSched>(lds, D, S, E);
        }
        if (PH(5) && !last) {
            RELOAD_P(); ws = p->ws;
            CtxSplitSched S2{(const char*)(ws + WS_MIX), (const char*)(ws + WS_WOUT + (size_t)l * D * D * 2), (int)blockIdx.x - (G - 32), (unsigned*)(ws + WS_CTL) + CW_D5 + l * 128};
            EpiOutPart E2{(float*)(ws + WS_RGA), (const float*)(ws + WS_MOD) + (size_t)l * 3 * 6144};
            int klen = 256; asm volatile("" : "+s"(klen));
            pg8::gemm_phase<EpiOutPart, CtxSplitSched>(lds, klen, S2, E2, nullptr, D);
        }
        REP(6) if (PH(6)) phase_route(p, l, lds, vcu, G, DUMMY(6));
        GRID_BAR();
        moe_table(p, l, tab);
        REP(8) if (PH(8)) {
            MoeSched1 S{(const char*)((const unsigned*)(ws + WS_CTL) + CW_RLIST + l * (MAXTILES * 256)), (const char*)(ws + WS_W1 + (size_t)l * NEXP * DEXP * D * 2), (const char*)(ws + WS_W3 + (size_t)l * NEXP * DEXP * D * 2), (const unsigned*)(ws + WS_CTL) + CW_TMAP + l * 32 * 72, tab, tab[NEXP], G, vcu, (unsigned*)(ws + WS_CTL) + CW_D7 + l * 192};
            EpiMoe1 E{(h16*)(ws + WS_ACT)};
            pg8::gemm_phase<EpiMoe1, MoeSched1, true>(lds, D, S, E, (const char*)(ws + WS_HL));
        }
        REP(9) if (PH(9)) {
            MoeSched2 S{(const char*)(ws + WS_ACT), (const char*)(ws + WS_W2 + (size_t)l * NEXP * DEXP * D * 2), (const unsigned*)(ws + WS_CTL) + CW_TMAP + l * 32 * 72, tab, tab[NEXP], G, vcu, (const unsigned*)(ws + WS_CTL) + CW_D7 + l * 192, 0, 0, 0};
            S.plan();
            EpiMoe2 E{(h16*)(ws + WS_YB)};
            pg8::gemm_phase<EpiMoe2, MoeSched2>(lds, DEXP, S, E);
        }
        GRID_BAR();
    }
    if (PH(10)) phase_norm1(p, DEPTH, 2, tab, vcu, G, false);
    if (PROBE_STAMP >= 0 && blockIdx.x == 0 && tid == 0) {
        const unsigned long long* st = (const unsigned long long*)(ws + WS_LAM + 1024);
        unsigned long long tot = 0;
        if (PROBE_STAMP == 7) tot = __builtin_amdgcn_s_memrealtime() - st[63];
        else if (PROBE_STAMP == 0) tot = st[0] - st[63];
        else for (int l = 0; l < DEPTH; ++l) { const int e = PROBE_STAMP + 6 * l; tot += st[e] - st[e - 1]; }
        asm volatile("s_waitcnt vmcnt(0)" ::: "memory");
        p->out[0] = (float)tot * (0.01f / ((PROBE_STAMP == 3 || PROBE_STAMP == 7) ? 100.f : 10.f));
    }
}

extern "C" void kernel_launch(void* const* d_in, const int* in_sizes, int n_in, void* d_out, int out_size, void* d_ws, size_t ws_size, hipStream_t stream) {
    static int grid = 0;
    if (grid == 0) {
        if (n_in != 28 || out_size != NLAT * D || ws_size < WS_END) { fprintf(stderr, "kernel_launch: unexpected shapes (n_in %d out %d ws %zu)\n", n_in, out_size, ws_size); grid = -1; return; }
        int dev = 0, cus = 0, per_cu = 0;
        if (hipGetDevice(&dev) != hipSuccess || hipDeviceGetAttribute(&cus, hipDeviceAttributeMultiprocessorCount, dev) != hipSuccess) { grid = -1; return; }
        if (hipFuncSetAttribute((const void*)fwd_kernel, hipFuncAttributeMaxDynamicSharedMemorySize, LDS_BYTES) != hipSuccess) { fprintf(stderr, "kernel_launch: hipFuncSetAttribute failed\n"); grid = -1; return; }
        if (hipOccupancyMaxActiveBlocksPerMultiprocessor(&per_cu, (const void*)fwd_kernel, NTHREADS, LDS_BYTES) != hipSuccess || per_cu < 1) { fprintf(stderr, "kernel_launch: occupancy query says %d blocks per CU\n", per_cu); (void)hipGetLastError(); grid = -1; return; }
        grid = cus;
    }
    if (grid < 0) return;
    (void)hipMemsetAsync((char*)d_ws + WS_CTL, 0, CTL_ZERO_BYTES, stream);
    Params p{};
    for (int i = 0; i < 28; ++i) p.in[i] = (const float*)d_in[i];
    p.out = (float*)d_out; p.ws = (unsigned char*)d_ws;
    void* args[] = {&p};
    hipError_t e = hipLaunchCooperativeKernel((const void*)fwd_kernel, dim3(grid), dim3(NTHREADS), args, LDS_BYTES, stream);
    if (e != hipSuccess) fprintf(stderr, "kernel_launch: cooperative launch failed: %s (grid %d)\n", hipGetErrorString(e), grid);
}
```

```cpp
#include <hip/hip_runtime.h>
#include <hip/hip_cooperative_groups.h>
#include <cstdio>
#include <cstdint>
namespace cg = cooperative_groups;

#define LAS __attribute__((address_space(3)))
typedef _Float16 h16;
typedef h16 h16x8 __attribute__((ext_vector_type(8)));
typedef h16 h16x4 __attribute__((ext_vector_type(4)));
typedef h16 h16x2 __attribute__((ext_vector_type(2)));
typedef float f32x2 __attribute__((ext_vector_type(2)));
typedef float f32x4 __attribute__((ext_vector_type(4)));
typedef float f32x16 __attribute__((ext_vector_type(16)));
typedef unsigned u32x2 __attribute__((ext_vector_type(2)));
typedef unsigned u32x4 __attribute__((ext_vector_type(4)));

#define PROBE_REPEAT -1
#define PROBE_STAMP -1
#define REP(n) for (int rep_ = 0; rep_ < ((PROBE_REPEAT == (n)) ? 2 : 1); ++rep_)
#define DUMMY(n) ((PROBE_REPEAT == (n)) && rep_ == 0)
constexpr int D = 1024, NBATCH = 2, SEQ = 8192, CTX = 256, DEPTH = 4;
constexpr int NLAT = NBATCH * SEQ, NCTX = NBATCH * CTX, NROW = NLAT + NCTX;
constexpr int KEYS = SEQ + CTX;
constexpr int INC = 2560;
constexpr int NEXP = 32, DEXP = 512;
constexpr int NWAVES = 8, NTHREADS = 512;
constexpr float EPS = 1e-6f;
constexpr float LOG2E = 1.4426950408889634f;

constexpr size_t MiB = 1u << 20;
constexpr size_t WS_CTL = 0, CTL_ZERO_BYTES = 1 * MiB;
constexpr int CW_BAR = 4096;
constexpr int CW_CNT = 1024;
constexpr size_t WS_MOD = 1 * MiB;
constexpr size_t WS_LAM = 1 * MiB + 512 * 1024;
constexpr size_t WS_ROPE = 1 * MiB + 768 * 1024;
constexpr int CW_KMAX = 2048;
constexpr size_t WS_AGG = 2 * MiB;
constexpr size_t WS_ASG = 5 * MiB;
constexpr size_t WS_EW = 6 * MiB;
constexpr size_t WS_WIN = 8 * MiB;
constexpr size_t WS_WOUT = 28 * MiB;
constexpr size_t WS_RGW = 36 * MiB;
constexpr size_t WS_W1 = 40 * MiB;
constexpr size_t WS_W3 = 168 * MiB;
constexpr size_t WS_W2 = 296 * MiB;
constexpr size_t WS_XL = 424 * MiB;
constexpr size_t WS_HL = 490 * MiB;
constexpr size_t WS_QA = 523 * MiB;
constexpr size_t WS_KA = 532 * MiB;
constexpr size_t WS_VAT = 541 * MiB;
constexpr size_t WS_QD = 550 * MiB;
constexpr size_t WS_KD = 559 * MiB;
constexpr size_t WS_VDT = 568 * MiB;
constexpr size_t WS_XR = 577 * MiB;
constexpr size_t WS_GG = 594 * MiB;
constexpr size_t WS_RGA = 611 * MiB;
constexpr size_t WS_MIX = 743 * MiB;
constexpr size_t WS_HP = 776 * MiB;
constexpr size_t WS_XG = 776 * MiB;
constexpr size_t WS_ACT = 858 * MiB;
constexpr size_t WS_YB = 899 * MiB;
constexpr size_t WS_END = 981 * MiB;
constexpr int CV_LIMIT = 64;
constexpr int CW_CV = 2600;
constexpr int CW_GT = 2560;
constexpr int CW_S2 = 2304;
constexpr int CW_POOL = 3000;
constexpr int CW_TMAP = 8192;
constexpr int CW_OWNER = 20480;
constexpr int MAXTILES = 164;
constexpr int CW_D5 = 21504;
constexpr int CW_RLIST = 65536;
constexpr int CW_D7 = 22528;

constexpr int LDS_BYTES = 147456;
constexpr int MISC_OFF = LDS_BYTES - 1024;

struct Params {
    const float* in[28];
    float* out;
    unsigned char* ws;
};
typedef __attribute__((address_space(4))) const Params* KP;
enum { I_X = 0, I_C, I_CTX, I_CCTX, I_WADA, I_BADA, I_GMIX, I_GFFN, I_WIN, I_WOUT, I_RPB, I_CONVW, I_CONVB, I_RGWR, I_RGBR, I_RGWI, I_RGBI, I_RGLAM,
       I_DLAM, I_DSUBG, I_RWG, I_RBG, I_RWE, I_RBE, I_W1, I_W3, I_W2, I_GFINAL };

__device__ __forceinline__ unsigned pkh(float a, float b) { h16x2 v = {(h16)a, (h16)b}; return __builtin_bit_cast(unsigned, v); }
__device__ __forceinline__ float wave_sum(float v) {
#pragma unroll
    for (int o = 1; o < 64; o <<= 1) v += __shfl_xor(v, o);
    return v;
}
__device__ __forceinline__ float xhalf_max(float m) { auto rr = __builtin_amdgcn_permlane32_swap(__float_as_uint(m), __float_as_uint(m), false, false); return fmaxf(__uint_as_float(rr[0]), __uint_as_float(rr[1])); }
__device__ __forceinline__ float xhalf_sum(float m) { auto rr = __builtin_amdgcn_permlane32_swap(__float_as_uint(m), __float_as_uint(m), false, false); return __uint_as_float(rr[0]) + __uint_as_float(rr[1]); }
__device__ __forceinline__ float fexp_(float x) { return __builtin_amdgcn_exp2f(x * LOG2E); }
__device__ __forceinline__ float frcp_(float x) { return __builtin_amdgcn_rcpf(x); }
__device__ __forceinline__ float sigmoidf_(float x) { return frcp_(1.f + fexp_(-x)); }
__device__ __forceinline__ float gelu_tanh(float x) { const float u = 0.7978845608028654f * (x + 0.044715f * x * x * x); return x * frcp_(1.f + fexp_(-2.f * u)); }
__device__ __forceinline__ int crow(int r, int hi) { return (r & 3) + 8 * (r >> 2) + 4 * hi; }
#define LDS_WAIT() asm volatile("s_waitcnt lgkmcnt(0)" ::: "memory")
__device__ __forceinline__ void lds_barrier() { asm volatile("s_waitcnt lgkmcnt(0)\n\ts_barrier" ::: "memory"); }
__device__ __forceinline__ int tid_now() { int t = threadIdx.x; asm volatile("" : "+v"(t)); return t; }

#define XB_TMO      128
#define XB_XCNT(j)  (256  + 64 * (j))
#define XB_XSUB(j)  (1280 + 64 * (j))
#define XB_XGEN(j)  (2304 + 64 * (j))
#define XB_TOP      3328
#define XB_TOPGEN   3392
#define XB_SPIN_CAP (1u << 22)
__device__ __forceinline__ unsigned xb_ld(unsigned* p)              { return __hip_atomic_load(p, __ATOMIC_RELAXED, __HIP_MEMORY_SCOPE_AGENT); }
__device__ __forceinline__ unsigned xb_add(unsigned* p, unsigned v) { return __hip_atomic_fetch_add(p, v, __ATOMIC_RELAXED, __HIP_MEMORY_SCOPE_AGENT); }
__device__ __forceinline__ unsigned xb_xcc_id() { return (unsigned)__builtin_amdgcn_s_getreg((3 << 11) | 20) & 0xFu; }
#define XB_SPIN(cond, bar) do { unsigned _sp = 0; while (cond) { __builtin_amdgcn_s_sleep(1); \
    if ((++_sp & 255u) == 0u) { if (xb_ld(&(bar)[XB_TMO])) break; if (_sp > XB_SPIN_CAP) { atomicAdd(&(bar)[XB_TMO], 1u); break; } } } } while (0)
struct XcdBarrier { unsigned* bar; unsigned x; volatile LAS unsigned* st; };
__device__ __forceinline__ XcdBarrier xcd_barrier_post(unsigned* bar, volatile LAS unsigned* st) {
    XcdBarrier b; b.bar = bar; b.x = xb_xcc_id(); b.st = st;
    if (threadIdx.x == 0) (void)xb_add(&bar[XB_XCNT(b.x)], 1u);
    return b;
}
__device__ __forceinline__ void xcd_barrier_complete(unsigned* bar, unsigned x, unsigned& nloc, unsigned& nx) {
    const unsigned G = gridDim.x * gridDim.y * gridDim.z;
    unsigned sum, cnt, mine, sp = 0u;
    for (;;) {
        sum = 0u; cnt = 0u; mine = 0u;
#pragma unroll 1
        for (unsigned j = 0; j < 16; ++j) { const unsigned c = xb_ld(&bar[XB_XCNT(j)]); sum += c; cnt += (c > 0u) ? 1u : 0u; mine = (j == x) ? c : mine; }
        if (sum == G) break;
        __builtin_amdgcn_s_sleep(1);
        if ((++sp & 255u) == 0u) { if (xb_ld(&bar[XB_TMO])) break; if (sp > XB_SPIN_CAP) { atomicAdd(&bar[XB_TMO], 1u); break; } }
    }
    nloc = mine > 0u ? mine : 1u; nx = cnt > 0u ? cnt : 1u;
}
__device__ __forceinline__ void xcd_barrier(const XcdBarrier& b) {
    asm volatile("s_waitcnt vmcnt(0)" ::: "memory");
    __syncthreads();
    if (threadIdx.x == 0) {
        unsigned* bar = b.bar;
        __builtin_amdgcn_s_waitcnt(0);
        const unsigned nloc = b.st[0], nx = b.st[1];
        const unsigned old = xb_add(&bar[XB_XSUB(b.x)], 1u);
        const unsigned gen = old / nloc;
        if (old + 1u == (gen + 1u) * nloc) {
            __builtin_amdgcn_fence(__ATOMIC_RELEASE, "agent");
            asm volatile("s_waitcnt vmcnt(0)" ::: "memory");
            const unsigned og = xb_add(&bar[XB_TOP], 1u);
            const unsigned tg = og / nx;
            if (og + 1u == (tg + 1u) * nx) xb_add(&bar[XB_TOPGEN], 1u);
            else XB_SPIN(xb_ld(&bar[XB_TOPGEN]) == tg, bar);
            __builtin_amdgcn_fence(__ATOMIC_ACQUIRE, "agent");
            xb_add(&bar[XB_XGEN(b.x)], 1u);
            asm volatile("s_waitcnt vmcnt(0)" ::: "memory");
        } else {
            XB_SPIN(xb_ld(&bar[XB_XGEN(b.x)]) == gen, bar);
            __builtin_amdgcn_fence(__ATOMIC_ACQUIRE, "agent");
            asm volatile("s_waitcnt vmcnt(0)" ::: "memory");
        }
    }
    __syncthreads();
}

__device__ __forceinline__ void unit_publish(unsigned* ctr) {
    asm volatile("s_waitcnt vmcnt(0)" ::: "memory");
    __builtin_amdgcn_s_barrier();
    if (threadIdx.x == 0) { __builtin_amdgcn_fence(__ATOMIC_RELEASE, "agent"); asm volatile("s_waitcnt vmcnt(0)" ::: "memory"); __hip_atomic_fetch_add(ctr, 1u, __ATOMIC_RELAXED, __HIP_MEMORY_SCOPE_AGENT); }
}
__device__ __forceinline__ void unit_wait(const unsigned* ctr, unsigned need) {
    if (threadIdx.x < 64) {
        unsigned spins = 0;
        while ((unsigned)__builtin_amdgcn_readfirstlane(__hip_atomic_load(ctr, __ATOMIC_RELAXED, __HIP_MEMORY_SCOPE_AGENT)) < need) { __builtin_amdgcn_s_sleep(2); if (++spins > (1u << 24)) break; }
        __builtin_amdgcn_fence(__ATOMIC_ACQUIRE, "agent");
        asm volatile("s_waitcnt vmcnt(0)" ::: "memory");
    }
    asm volatile("" ::: "memory"); __builtin_amdgcn_s_barrier(); asm volatile("" ::: "memory");
}

namespace pg8 {
constexpr int BM = 256, BK = 64, HALF = 128, HTB = HALF * BK * 2, STAGE_BYTES = 8 * HTB, NXCD = 8, WGM = 8;
__device__ __forceinline__ int lds_byte(int r, int c) { const int st = (r >> 4) * 2 + (c >> 5), rr = r & 15, cc = c & 31, ob = rr * 64 + cc * 2; return st * 1024 + (ob ^ (((ob >> 9) & 1) << 5)); }
__device__ __forceinline__ void stage_rc(int b, int& R, int& C) { const int st = b / 1024, sb = b % 1024, swz = sb ^ (((sb >> 9) & 1) << 5); R = (st >> 1) * 16 + swz / 64; C = (st & 1) * 32 + (swz % 64) / 2; }
__device__ __forceinline__ int perm32(int rho) { const int n = rho >> 4, i = rho & 15; return 8 * (i >> 2) + 4 * n + (i & 3); }

struct Unit { const char* A0; const char* A1; const char* B0; const char* B1; int pm, pn; };

struct DenseSched {
    const char* A; const char* Bt; int K, nM, nN, nwg, G, c; unsigned* done_ctr;
    __device__ __forceinline__ void init(const void* A_, const void* Bt_, int M, int N, int K_, int G_, int c_, unsigned* done_ = nullptr) { A = (const char*)A_; Bt = (const char*)Bt_; K = K_; nM = M / BM; nN = N / BM; nwg = nM * nN; G = G_; c = c_; done_ctr = done_; }
    __device__ __forceinline__ void a_ready(const Unit&) const {}
    __device__ __forceinline__ void done(const Unit& u) const { if (done_ctr) unit_publish(done_ctr + u.pm); }
    __device__ __forceinline__ bool next(int i, Unit& u) const {
        const long L = (long)i * G + c; if (L >= nwg) return false;
        int wgid = (int)L; { const int q = nwg / NXCD, r = nwg % NXCD, xcd = wgid % NXCD, off = wgid / NXCD; wgid = (xcd < r ? xcd * (q + 1) : r * (q + 1) + (xcd - r) * q) + off; }
        const int nig = WGM * nN, gid = wgid / nig, fm = gid * WGM, gsz = (nM - fm) < WGM ? (nM - fm) : WGM;
        u.pm = fm + ((wgid % nig) % gsz); u.pn = (wgid % nig) / gsz;
        const size_t hstep = (size_t)HALF * K * 2;
        u.A0 = A + (size_t)u.pm * 2 * hstep; u.A1 = u.A0 + hstep; u.B0 = Bt + (size_t)u.pn * 2 * hstep; u.B1 = u.B0 + hstep;
        return true;
    }
};

struct InProjSched {
    const char* A; const char* Bt; int K, G, c; unsigned* qctr; unsigned* xctr;
    __device__ __forceinline__ void init(const void* A_, const void* Bt_, int K_, int G_, int c_, unsigned* q_, unsigned* x_) { A = (const char*)A_; Bt = (const char*)Bt_; K = K_; G = G_; c = c_; qctr = q_; xctr = x_; }
    __device__ __forceinline__ void a_ready(const Unit&) const {}
    __device__ __forceinline__ void done(const Unit& u) const { if (u.pn < 3 || u.pn > 6) unit_publish(qctr); else unit_publish(xctr); }
    static __device__ __forceinline__ void chunk(int G, int c, int& per, int& j, int& qcnt, int& qstart, int& rcnt, int& rstart) {
        const int nx = (G % NXCD == 0) ? NXCD : 1, xcd = c % nx; per = G / nx; j = c / nx;
        qcnt = 396 / nx + (xcd < 396 % nx ? 1 : 0); qstart = xcd * (396 / nx) + (xcd < 396 % nx ? xcd : 396 % nx);
        rcnt = 264 / nx + (xcd < 264 % nx ? 1 : 0); rstart = xcd * (264 / nx) + (xcd < 264 % nx ? xcd : 264 % nx);
    }
    __device__ __forceinline__ bool next(int i, Unit& u) const {
        int per, j, qcnt, qstart, rcnt, rstart; chunk(G, c, per, j, qcnt, qstart, rcnt, rstart);
        const int off = i * per + j;
        int wg, nN;
        if (off < qcnt) { wg = qstart + off; nN = 6; } else if (off - qcnt < rcnt) { wg = rstart + off - qcnt; nN = 4; } else return false;
        const int nig = WGM * nN, gid = wg / nig, fm = gid * WGM, gsz = (66 - fm) < WGM ? (66 - fm) : WGM;
        u.pm = fm + ((wg % nig) % gsz); const int pl = (wg % nig) / gsz;
        u.pn = (nN == 6) ? (pl < 3 ? pl : pl + 4) : pl + 3;
        const size_t hstep = (size_t)HALF * K * 2;
        u.A0 = A + (size_t)u.pm * 2 * hstep; u.A1 = u.A0 + hstep; u.B0 = Bt + (size_t)u.pn * 2 * hstep; u.B1 = u.B0 + hstep;
        return true;
    }
};

template <class Epi, class Sched, bool GATHER = false>
__device__ __forceinline__ void gemm_phase(LAS unsigned char* lds, const int K, const Sched& S, const Epi& E, const char* gbase = nullptr, const int pitch_ = 0) {
    const int pitch = pitch_ ? pitch_ : K;
    const int tid = tid_now(), wid = __builtin_amdgcn_readfirstlane(tid >> 6), lane = tid & 63, wr = wid >> 2, wc = wid & 3, fr = lane & 15, fq = lane >> 4;
    const int nt = K / BK;
    unsigned voffA[2], voffB[2];
#pragma unroll
    for (int i = 0; i < 2; ++i) { int R, C; stage_rc(tid * 16 + i * 8192, R, C); const int Rb = (R & ~31) + perm32(R & 31);
        voffA[i] = (unsigned)(R * pitch + C) * 2u; voffB[i] = (unsigned)(Rb * pitch + C) * 2u; }
    const size_t kstep = (size_t)(BK * 2);
    const unsigned ldsw = (unsigned)wid * 1024u;
    unsigned cv0[2] = {0u, 0u}, cv1[2] = {0u, 0u}, nv0[2] = {0u, 0u}, nv1[2] = {0u, 0u};
#define PG8_GOFF(v0_, v1_, listp) do { const int* rl_ = (const int*)(listp); _Pragma("unroll") for (int i_ = 0; i_ < 2; ++i_) { int R_, C_; stage_rc(tid * 16 + i_ * 8192, R_, C_); \
        v0_[i_] = (unsigned)rl_[R_] * (unsigned)(K * 2) + (unsigned)(C_ * 2); v1_[i_] = (unsigned)rl_[128 + R_] * (unsigned)(K * 2) + (unsigned)(C_ * 2); } } while (0)
#define PG8_STAGE2(bufoff, gb, va, vb, sel) do { _Pragma("unroll") for (int _i = 0; _i < 2; ++_i) \
        __builtin_amdgcn_global_load_lds((const unsigned*)((const char*)(gb) + ((sel) ? (vb)[_i] : (va)[_i])), (LAS unsigned*)(lds + (bufoff) + ldsw + _i * 8192), 16, 0, 0); } while (0)
    const int aoff = lds_byte(wr * 64 + fr, fq * 8), boff = lds_byte(wc * 32 + fr, fq * 8);
#define PG8_SA(b, h) (((b) * 2 + (h)) * HTB)
#define PG8_SB(b, h) ((4 + (b) * 2 + (h)) * HTB)
#define PG8_STAGE(bufoff, gbase, voff) do { _Pragma("unroll") for (int _i = 0; _i < 2; ++_i) \
        __builtin_amdgcn_global_load_lds((const unsigned*)((const char*)(gbase) + (voff)[_i]), (LAS unsigned*)(lds + (bufoff) + ldsw + _i * 8192), 16, 0, 0); } while (0)
#define PG8_LDA(dst, b, h) do { _Pragma("unroll") for (int m = 0; m < 4; ++m) _Pragma("unroll") for (int k = 0; k < 2; ++k) dst[m][k] = *(const LAS h16x8*)(lds + PG8_SA(b, h) + aoff + m * 2048 + k * 1024); } while (0)
#define PG8_LDB(dst, b, h) do { _Pragma("unroll") for (int n = 0; n < 2; ++n) _Pragma("unroll") for (int k = 0; k < 2; ++k) dst[n][k] = *(const LAS h16x8*)(lds + PG8_SB(b, h) + boff + n * 2048 + k * 1024); } while (0)
#define PG8_MMA(ai, bj, At, Bt) do { __builtin_amdgcn_s_setprio(1); _Pragma("unroll") for (int m = 0; m < 4; ++m) _Pragma("unroll") for (int n = 0; n < 2; ++n) _Pragma("unroll") for (int k = 0; k < 2; ++k) \
        acc[ai][bj][m][n] = __builtin_amdgcn_mfma_f32_16x16x32_f16(Bt[n][k], At[m][k], acc[ai][bj][m][n], 0, 0, 0); __builtin_amdgcn_s_setprio(0); } while (0)
#define PG8_WAIT_V(n) asm volatile("s_waitcnt vmcnt(" #n ")" ::: "memory")
#define PG8_WAIT_L(n) asm volatile("s_waitcnt lgkmcnt(" #n ")" ::: "memory")
#define PG8_BAR __builtin_amdgcn_s_barrier()
#define PG8_SCHED __builtin_amdgcn_sched_barrier(0)
    Unit cur, nxt; int ui = 0;
    if (!S.next(0, cur)) return;
    f32x4 acc[2][2][4][2];
#pragma unroll
    for (int a = 0; a < 2; ++a)
#pragma unroll
        for (int b = 0; b < 2; ++b)
#pragma unroll
            for (int m = 0; m < 4; ++m)
#pragma unroll
                for (int n = 0; n < 2; ++n) acc[a][b][m][n] = (f32x4){0.f, 0.f, 0.f, 0.f};
    h16x8 At[4][2], B0[2][2], B1[2][2];
    const char* cA0 = cur.A0; const char* cA1 = cur.A1; const char* cB0 = cur.B0; const char* cB1 = cur.B1;
    S.a_ready(cur);
    if constexpr (GATHER) { PG8_GOFF(cv0, cv1, cur.A0); }
    PG8_STAGE(PG8_SB(0, 0), cB0, voffB); PG8_STAGE(PG8_SB(0, 1), cB1, voffB);
    if constexpr (GATHER) { PG8_STAGE2(PG8_SA(0, 0), gbase, cv0, cv0, false); PG8_STAGE2(PG8_SA(0, 1), gbase, cv1, cv1, false); }
    else { PG8_STAGE(PG8_SA(0, 0), cA0, voffA); PG8_STAGE(PG8_SA(0, 1), cA1, voffA); }
    if (wr == 1) PG8_BAR;
    PG8_WAIT_V(2); PG8_BAR;
    PG8_STAGE(PG8_SB(1, 0), cB0 + kstep, voffB);
    if constexpr (GATHER) { PG8_STAGE2(PG8_SA(1, 0), gbase + kstep, cv0, cv0, false); } else { PG8_STAGE(PG8_SA(1, 0), cA0 + kstep, voffA); }
    PG8_STAGE(PG8_SB(1, 1), cB1 + kstep, voffB);
    PG8_WAIT_V(6); PG8_BAR;
    for (;;) {
        const bool has_next = S.next(ui + 1, nxt);
        const char* nA0 = has_next ? nxt.A0 : cA0; const char* nA1 = has_next ? nxt.A1 : cA1;
        const char* nB0 = has_next ? nxt.B0 : cB0; const char* nB1 = has_next ? nxt.B1 : cB1;
        for (int t = 0; t < nt; t += 2) {
            const bool last = (t == nt - 2);
            if (last && has_next) S.a_ready(nxt);
            if constexpr (GATHER) { if (last) { if (has_next) { PG8_GOFF(nv0, nv1, nxt.A0); } else { nv0[0] = cv0[0]; nv0[1] = cv0[1]; nv1[0] = cv1[0]; nv1[1] = cv1[1]; } } }
            const char* g1 = gbase + (size_t)(t + 1) * kstep; const char* g2 = gbase + (last ? (size_t)0 : (size_t)(t + 2) * kstep); const char* g3 = g2 + kstep;
            const char* a1_1 = cA1 + (size_t)(t + 1) * kstep;
            const char* a2_0 = last ? nA0 : cA0 + (size_t)(t + 2) * kstep; const char* a2_1 = last ? nA1 : cA1 + (size_t)(t + 2) * kstep;
            const char* b2_0 = last ? nB0 : cB0 + (size_t)(t + 2) * kstep; const char* b2_1 = last ? nB1 : cB1 + (size_t)(t + 2) * kstep;
            const char* a3_0 = a2_0 + kstep; const char* b3_0 = b2_0 + kstep; const char* b3_1 = b2_1 + kstep;
            PG8_LDB(B0, 0, 0); PG8_LDB(B1, 0, 1); PG8_SCHED; PG8_LDA(At, 0, 0); if constexpr (GATHER) { PG8_STAGE2(PG8_SA(1, 1), g1, cv1, cv1, false); } else { PG8_STAGE(PG8_SA(1, 1), a1_1, voffA); }
            PG8_WAIT_V(8); PG8_WAIT_L(0); PG8_BAR; PG8_MMA(0, 0, At, B0); PG8_MMA(0, 1, At, B1); PG8_BAR; PG8_SCHED;
            PG8_LDA(At, 0, 1); PG8_STAGE(PG8_SB(0, 0), b2_0, voffB); PG8_STAGE(PG8_SB(0, 1), b2_1, voffB); if constexpr (GATHER) { PG8_STAGE2(PG8_SA(0, 0), g2, cv0, nv0, last); } else { PG8_STAGE(PG8_SA(0, 0), a2_0, voffA); }
            PG8_WAIT_V(8); PG8_WAIT_L(0); PG8_BAR; PG8_MMA(1, 0, At, B0); PG8_MMA(1, 1, At, B1); PG8_BAR; PG8_SCHED;
            PG8_LDB(B0, 1, 0); PG8_LDB(B1, 1, 1); PG8_SCHED; PG8_LDA(At, 1, 0); if constexpr (GATHER) { PG8_STAGE2(PG8_SA(0, 1), g2, cv1, nv1, last); } else { PG8_STAGE(PG8_SA(0, 1), a2_1, voffA); }
            PG8_WAIT_V(8); PG8_WAIT_L(0); PG8_BAR; PG8_MMA(0, 0, At, B0); PG8_MMA(0, 1, At, B1); PG8_BAR; PG8_SCHED;
            PG8_LDA(At, 1, 1); PG8_STAGE(PG8_SB(1, 0), b3_0, voffB); PG8_STAGE(PG8_SB(1, 1), b3_1, voffB); if constexpr (GATHER) { PG8_STAGE2(PG8_SA(1, 0), g3, cv0, nv0, last); } else { PG8_STAGE(PG8_SA(1, 0), a3_0, voffA); }
            PG8_WAIT_V(8); PG8_WAIT_L(0); PG8_BAR; PG8_MMA(1, 0, At, B0); PG8_MMA(1, 1, At, B1); PG8_BAR; PG8_SCHED;
        }
        if (wr == 0) PG8_BAR;
        E(acc, cur, wr, wc, fr, fq);
        S.done(cur);
        if (!has_next) break;
#pragma unroll
        for (int a = 0; a < 2; ++a)
#pragma unroll
            for (int b = 0; b < 2; ++b)
#pragma unroll
                for (int m = 0; m < 4; ++m)
#pragma unroll
                    for (int n = 0; n < 2; ++n) acc[a][b][m][n] = (f32x4){0.f, 0.f, 0.f, 0.f};
        cur = nxt; cA0 = nA0; cA1 = nA1; cB0 = nB0; cB1 = nB1; ++ui;
        if constexpr (GATHER) { cv0[0] = nv0[0]; cv0[1] = nv0[1]; cv1[0] = nv1[0]; cv1[1] = nv1[1]; }
        if (wr == 1) PG8_BAR;
    }
    PG8_WAIT_V(0);
    PG8_BAR;
#undef PG8_SA
#undef PG8_SB
#undef PG8_STAGE
#undef PG8_STAGE2
#undef PG8_GOFF
#undef PG8_LDA
#undef PG8_LDB
#undef PG8_MMA
#undef PG8_WAIT_V
#undef PG8_WAIT_L
#undef PG8_BAR
#undef PG8_SCHED
}
}
using pg8::Unit;
typedef f32x4 AccT[2][2][4][2];

struct EpiInProj {
    h16 *qa, *ka, *vat, *xr, *gg, *qd, *kd, *vdt; const f32x2* rope; unsigned* kmax; LAS unsigned char* scr;
    __device__ __forceinline__ void operator()(const AccT& acc, const Unit& u, int wr, int wc, int fr, int fq) const {
        const int pn = u.pn;
        const bool isctx = (u.pm >= NLAT / 256);
        const float QSA = 0.125f * LOG2E, QSD = 0.17677669529663687f * LOG2E;
        float kn2[2] = {0.f, 0.f};
        if (pn == 2 || pn == 9) {
            h16* const vbase = (pn == 2 ? vat : vdt);
            LAS unsigned char* const sw = scr + (wr * 4 + wc) * 1536;
            const int lane = fq * 16 + fr;
#pragma unroll
            for (int ai = 0; ai < 2; ++ai)
#pragma unroll
                for (int m = 0; m < 4; ++m) {
                    const int row0 = u.pm * 256 + ai * 128 + wr * 64 + m * 16;
                    int b, key0;
                    if (isctx) { const int c = row0 - NLAT; b = c >> 8; key0 = SEQ + (c & 255); } else { b = row0 >> 13; key0 = row0 & (SEQ - 1); }
#pragma unroll
                    for (int bj = 0; bj < 2; ++bj) {
#pragma unroll
                        for (int j = 0; j < 8; ++j) *(LAS h16*)(sw + (fq * 8 + j) * 48 + fr * 2) = (h16)acc[ai][bj][m][j >> 2][j & 3];
                        asm volatile("s_waitcnt lgkmcnt(0)" ::: "memory");
                        const u32x4 w = *(const LAS u32x4*)(sw + (lane >> 1) * 48 + (lane & 1) * 16);
                        asm volatile("s_waitcnt lgkmcnt(0)" ::: "memory");
                        *(u32x4*)(vbase + ((size_t)(b * 256 + bj * 128 + wc * 32 + (lane >> 1))) * KEYS + key0 + (lane & 1) * 8) = w;
                    }
                }
            return;
        }
#pragma unroll
        for (int ai = 0; ai < 2; ++ai)
#pragma unroll
            for (int m = 0; m < 4; ++m) {
                const int row = u.pm * 256 + ai * 128 + wr * 64 + m * 16 + fr;
                int b, key, t;
                if (isctx) { const int c = row - NLAT; b = c >> 8; t = c & 255; key = SEQ + t; } else { b = row >> 13; t = row & (SEQ - 1); key = t; }
#pragma unroll
                for (int bj = 0; bj < 2; ++bj) {
                    const int col = bj * 128 + wc * 32 + 8 * fq;
                    float v[8];
#pragma unroll
                    for (int j = 0; j < 4; ++j) { v[j] = acc[ai][bj][m][0][j]; v[4 + j] = acc[ai][bj][m][1][j]; }
                    if (pn == 7 || pn == 8) {
                        float pr[8];
#pragma unroll
                        for (int j = 0; j < 8; ++j) pr[j] = __shfl_xor(v[j], 16);
                        if (!isctx) {
                            const int pos = (fq < 2) ? (t >> 6) : (t & 63);
                            const f32x2* tb = rope + pos * 8;
#pragma unroll
                            for (int j = 0; j < 8; ++j) { const f32x2 cs = tb[j]; const float sn = (fq & 1) ? cs.y : -cs.y; v[j] = v[j] * cs.x + pr[j] * sn; }
                        }
                        if (pn == 8) { float ss = 0.f;
#pragma unroll
                            for (int j = 0; j < 8; ++j) ss += v[j] * v[j];
                            kn2[bj] = fmaxf(kn2[bj], ss); }
                    }
                    {
                        h16* dst; float sc = 1.f;
                        if (pn == 0) { dst = qa + (size_t)row * 256 + col; sc = QSA; }
                        else if (pn == 1) { dst = ka + ((size_t)(b * KEYS + key)) * 256 + col; }
                        else if (pn == 3 || pn == 4) { dst = xr + (size_t)row * 512 + (pn - 3) * 256 + col; }
                        else if (pn == 5 || pn == 6) { dst = gg + (size_t)row * 512 + (pn - 5) * 256 + col;
#pragma unroll
                            for (int j = 0; j < 8; ++j) v[j] = gelu_tanh(v[j]); }
                        else if (pn == 7) { dst = qd + (size_t)row * 256 + col; sc = QSD; }
                        else { dst = kd + ((size_t)(b * KEYS + key)) * 256 + col; }
                        u32x4 w; w.x = pkh(v[0] * sc, v[1] * sc); w.y = pkh(v[2] * sc, v[3] * sc); w.z = pkh(v[4] * sc, v[5] * sc); w.w = pkh(v[6] * sc, v[7] * sc);
                        *(u32x4*)dst = w;
                    }
                }
            }
        if (pn == 8) {
            const int b = isctx ? (u.pm - NLAT / 256) : (u.pm >> 5);
#pragma unroll
            for (int bj = 0; bj < 2; ++bj) {
                float ss = kn2[bj]; ss += __shfl_xor(ss, 16); ss += __shfl_xor(ss, 32);
#pragma unroll
                for (int o = 1; o < 16; o <<= 1) ss = fmaxf(ss, __shfl_xor(ss, o));
                if ((fr | fq) == 0) atomicMax(kmax + (b * 4 + 2 * bj + (wc >> 1)) * 2 + (wc & 1), __float_as_uint(ss));
            }
        }
    }
};

struct EpiOutProj {
    h16* xl; const float* mod; h16* xo;
    __device__ __forceinline__ void operator()(const AccT& acc, const Unit& u, int wr, int wc, int fr, int fq) const {
        const int vsel = (u.pm >= NLAT / 256) ? 2 : (u.pm >= NLAT / 512 ? 1 : 0);
        const float* ga = mod + vsel * 6144 + 2 * 1024;
#pragma unroll
        for (int bj = 0; bj < 2; ++bj) {
            const int col = u.pn * 256 + bj * 128 + wc * 32 + 8 * fq;
            const f32x4 g0 = *(const f32x4*)(ga + col), g1 = *(const f32x4*)(ga + col + 4);
#pragma unroll
            for (int ai = 0; ai < 2; ++ai)
#pragma unroll
                for (int m = 0; m < 4; ++m) {
                    const int row = u.pm * 256 + ai * 128 + wr * 64 + m * 16 + fr;
                    const h16* p = xl + (size_t)row * D + col; h16* q = xo + (size_t)row * D + col;
                    const h16x8 xv = *(const h16x8*)p;
                    f32x4 x0 = {(float)xv[0], (float)xv[1], (float)xv[2], (float)xv[3]}, x1 = {(float)xv[4], (float)xv[5], (float)xv[6], (float)xv[7]};
                    x0 += g0 * acc[ai][bj][m][0]; x1 += g1 * acc[ai][bj][m][1];
                    u32x4 w; w.x = pkh(x0[0], x0[1]); w.y = pkh(x0[2], x0[3]); w.z = pkh(x1[0], x1[1]); w.w = pkh(x1[2], x1[3]);
                    *(u32x4*)q = w;
                }
        }
    }
};

struct CtxSplitSched {
    const char* mix; const char* wt; int q; unsigned* done_ctr;
    __device__ __forceinline__ void a_ready(const Unit&) const {}
    __device__ __forceinline__ void done(const Unit& u) const { unit_publish(done_ctr + u.pm); }
    __device__ __forceinline__ bool next(int i, Unit& u) const {
        if (i != 0 || q < 0) return false;
        const int pm = NLAT / 256 + (q >> 4), pn = (q >> 2) & 3, kq = q & 3;
        u.pm = pm; u.pn = pn | (kq << 8);
        u.A0 = mix + (size_t)pm * 256 * 2048 + kq * 512; u.A1 = u.A0 + (size_t)128 * 2048;
        u.B0 = wt + (size_t)pn * 256 * 2048 + kq * 512; u.B1 = u.B0 + (size_t)128 * 2048;
        return true;
    }
};
struct EpiOutPart {
    float* part; const float* mod;
    __device__ __forceinline__ void operator()(const AccT& acc, const Unit& u, int wr, int wc, int fr, int fq) const {
        const int pn = u.pn & 255, kq = u.pn >> 8;
        const float* ga = mod + 2 * 6144 + 2 * 1024;
#pragma unroll
        for (int bj = 0; bj < 2; ++bj) {
            const int col = pn * 256 + bj * 128 + wc * 32 + 8 * fq;
            const f32x4 g0 = *(const f32x4*)(ga + col), g1 = *(const f32x4*)(ga + col + 4);
#pragma unroll
            for (int ai = 0; ai < 2; ++ai)
#pragma unroll
                for (int m = 0; m < 4; ++m) {
                    const int crow_ = (u.pm - NLAT / 256) * 256 + ai * 128 + wr * 64 + m * 16 + fr;
                    float* q_ = part + ((size_t)kq * NCTX + crow_) * D + col;
                    *(f32x4*)q_ = g0 * acc[ai][bj][m][0]; *(f32x4*)(q_ + 4) = g1 * acc[ai][bj][m][1];
                }
        }
    }
};

struct MoeSched1 {
    const char* xg; const char* w1t; const char* w3t; const unsigned* tmap; volatile LAS int* tab; int ntiles, G, c; unsigned* done7;
    __device__ __forceinline__ void a_ready(const Unit&) const {}
    __device__ __forceinline__ void done(const Unit& u) const { unit_publish(done7 + u.pm); }
    __device__ __forceinline__ bool next(int i, Unit& u) const {
        const int L = i * G + c; if (L >= ntiles * 4) return false;
        const int Ts = L >> 2, pn = L & 3; int e = 0;
        for (int j = 1; j < NEXP; ++j) e += (tab[j] <= Ts) ? 1 : 0;
        e = __builtin_amdgcn_readfirstlane(e);
        const int T = __builtin_amdgcn_readfirstlane((int)tmap[e * 72 + (Ts - tab[e])] - 1);
        u.pm = T; u.pn = pn;
        u.A0 = xg + (size_t)T * 256 * 4; u.A1 = u.A0;
        const size_t wo = ((size_t)e * DEXP + (size_t)pn * 128) * 2048;
        u.B0 = w1t + wo; u.B1 = w3t + wo;
        return true;
    }
};
struct MoeSched2 {
    const char* act; const char* w2t; const unsigned* tmap; volatile LAS int* tab; int ntiles, G, c; const unsigned* done7; int start, cnt, late;
    __device__ __forceinline__ void a_ready(const Unit& u) const { unit_wait(done7 + u.pm, 4u); }
    __device__ __forceinline__ void done(const Unit&) const {}
    __device__ __forceinline__ void plan() {
        const int n = ntiles * 4, base = n / G, r = n - base * G, pool = base * G;
        late = -1; start = c * base; cnt = base;
        if (r == 0) return;
        int best = 1 << 30, mA = 1;
        for (int a = 1; a <= 3; ++a) { const int rem = n - r * a, b_ = rem > 0 ? (rem + (G - r) - 1) / (G - r) : 0; const int ca = 2 * (base + 1) + a, cb = 2 * base + b_, cost = ca > cb ? ca : cb; if (cost < best) { best = cost; mA = a; } }
        if (c < r) { late = pool + c; start = c * (mA - 1); cnt = mA - 1; }
        else { const int rem = pool - r * (mA - 1), q = rem > 0 ? rem / (G - r) : 0, x = rem > 0 ? rem % (G - r) : 0, j = c - r; start = r * (mA - 1) + j * q + (j < x ? j : x); cnt = q + (j < x ? 1 : 0); }
        if (start > pool) start = pool;
        if (start + cnt > pool) cnt = pool - start;
    }
    __device__ __forceinline__ bool next(int i, Unit& u) const {
        int L;
        if (late >= 0) { if (i == 0) L = late; else if (i - 1 < cnt) L = start + i - 1; else return false; }
        else { if (i < cnt) L = start + i; else return false; }
        if (L >= ntiles * 4) return false;
        const int Ts = L >> 2, pn = L & 3; int e = 0;
        for (int j = 1; j < NEXP; ++j) e += (tab[j] <= Ts) ? 1 : 0;
        e = __builtin_amdgcn_readfirstlane(e);
        const int T = __builtin_amdgcn_readfirstlane((int)tmap[e * 72 + (Ts - tab[e])] - 1);
        u.pm = T; u.pn = pn;
        u.A0 = act + (size_t)T * 256 * 1024; u.A1 = u.A0 + (size_t)128 * 1024;
        u.B0 = w2t + ((size_t)e * D + (size_t)pn * 256) * 1024; u.B1 = u.B0 + (size_t)128 * 1024;
        return true;
    }
};
struct EpiMoe1 {
    h16* act;
    __device__ __forceinline__ void operator()(const AccT& acc, const Unit& u, int wr, int wc, int fr, int fq) const {
#pragma unroll
        for (int ai = 0; ai < 2; ++ai)
#pragma unroll
            for (int m = 0; m < 4; ++m) {
                const int row = u.pm * 256 + ai * 128 + wr * 64 + m * 16 + fr;
                float v[8];
#pragma unroll
                for (int n = 0; n < 2; ++n)
#pragma unroll
                    for (int j = 0; j < 4; ++j) { const float a = acc[ai][0][m][n][j], b = acc[ai][1][m][n][j]; v[4 * n + j] = a * frcp_(1.f + fexp_(-a)) * b; }
                u32x4 w; w.x = pkh(v[0], v[1]); w.y = pkh(v[2], v[3]); w.z = pkh(v[4], v[5]); w.w = pkh(v[6], v[7]);
                *(u32x4*)(act + (size_t)row * DEXP + u.pn * 128 + wc * 32 + 8 * fq) = w;
            }
    }
};
struct EpiMoe2 {
    h16* yb;
    __device__ __forceinline__ void operator()(const AccT& acc, const Unit& u, int wr, int wc, int fr, int fq) const {
#pragma unroll
        for (int ai = 0; ai < 2; ++ai)
#pragma unroll
            for (int m = 0; m < 4; ++m) {
                const int row = u.pm * 256 + ai * 128 + wr * 64 + m * 16 + fr;
#pragma unroll
                for (int bj = 0; bj < 2; ++bj) {
                    const f32x4 v0 = acc[ai][bj][m][0], v1 = acc[ai][bj][m][1];
                    u32x4 w; w.x = pkh(v0[0], v0[1]); w.y = pkh(v0[2], v0[3]); w.z = pkh(v1[0], v1[1]); w.w = pkh(v1[2], v1[3]);
                    *(u32x4*)(yb + (size_t)row * D + u.pn * 256 + bj * 128 + wc * 32 + 8 * fq) = w;
                }
            }
    }
};

__device__ __forceinline__ void tr_load(f32x4 (&v)[16], const float* W, int N, int item, int lane) {
    const int nblk = N / 64, kb = item / nblk, nb = item % nblk, k0 = 64 * kb, n0 = 64 * nb;
    const int lr = lane >> 4, lc = (lane & 15) * 4;
    const float* src = W + (size_t)(k0 + lr) * N + n0 + lc;
#pragma unroll
    for (int i = 0; i < 16; ++i) v[i] = *(const f32x4*)(src + (size_t)(4 * i) * N);
}
__device__ __forceinline__ void tr_finish(const f32x4 (&v)[16], int K, int N, h16* WT, LAS h16* scr, int item, int lane) {
    const int nblk = N / 64, kb = item / nblk, nb = item % nblk, k0 = 64 * kb, n0 = 64 * nb;
    const int lr = lane >> 4, lc = (lane & 15) * 4;
#pragma unroll
    for (int i = 0; i < 16; ++i) { LAS unsigned* d = (LAS unsigned*)(scr + (4 * i + lr) * 66 + lc); d[0] = pkh(v[i][0], v[i][1]); d[1] = pkh(v[i][2], v[i][3]); }
    LDS_WAIT(); asm volatile("" ::: "memory");
    const int c = lane & 7;
#pragma unroll
    for (int j = 0; j < 8; ++j) { const int n = (lane >> 3) + 8 * j; const LAS h16* s = scr + (8 * c) * 66 + n;
        h16x8 o;
#pragma unroll
        for (int t = 0; t < 8; ++t) o[t] = s[t * 66];
        *(h16x8*)(WT + (size_t)(n0 + n) * K + k0 + 8 * c) = o; }
    LDS_WAIT(); asm volatile("" ::: "memory");
}
__device__ __forceinline__ void p0_transpose_item(const float* W, int K, int N, h16* WT, LAS h16* scr, int item, int lane) {
    f32x4 v[16];
    tr_load(v, W, N, item, lane);
    tr_finish(v, K, N, WT, scr, item, lane);
}

__device__ __forceinline__ void phase_p0(KP p, LAS unsigned char* lds, int vcu, int G) {
    const int tid = tid_now(), lane = tid & 63, wave = __builtin_amdgcn_readfirstlane(tid >> 6);
    unsigned char* ws = p->ws;
    LAS float* sc = (LAS float*)lds;
    LAS float* red = (LAS float*)(lds + 12288);
    for (int i = tid; i < 3 * 1024; i += NTHREADS) { const float x = (i < 2048) ? p->in[I_C][i] : p->in[I_CCTX][i - 2048]; sc[i] = x / (1.f + __expf(-x)); }
    __syncthreads();
    float* mod = (float*)(ws + WS_MOD);
    for (int it = blockIdx.x; it < DEPTH * 96; it += G) {
        const int l = it / 96, nb = it % 96, n = nb * 64 + lane;
        const float* W = p->in[I_WADA] + (size_t)l * D * 6144 + n;
        float a0 = 0.f, a1 = 0.f, a2 = 0.f;
#pragma unroll 32
        for (int k = wave * 128; k < wave * 128 + 128; ++k) { const float w = W[(size_t)k * 6144]; a0 += sc[k] * w; a1 += sc[1024 + k] * w; a2 += sc[2048 + k] * w; }
        red[(wave * 3 + 0) * 64 + lane] = a0; red[(wave * 3 + 1) * 64 + lane] = a1; red[(wave * 3 + 2) * 64 + lane] = a2;
        __syncthreads();
        if (tid < 192) { const int v = tid >> 6, ln = tid & 63; float s = p->in[I_BADA][l * 6144 + nb * 64 + ln];
#pragma unroll
            for (int w = 0; w < 8; ++w) s += red[(w * 3 + v) * 64 + ln];
            mod[((size_t)l * 3 + v) * 6144 + nb * 64 + ln] = s; }
        __syncthreads();
    }
    if (blockIdx.x == 0) {
        f32x2* tab = (f32x2*)(ws + WS_ROPE);
        for (int i = tid; i < 128 * 8; i += NTHREADS) { const int pos = i >> 3, j = i & 7; const float f = powf(10000.f, -(float)j / 8.f); const float ang = (float)pos * f; tab[i] = (f32x2){cosf(ang), sinf(ang)}; }
        if (tid < DEPTH) { const float* lv = p->in[I_DLAM] + tid * 128; float s1 = 0.f, s2 = 0.f;
            for (int j = 0; j < 32; ++j) { s1 += lv[j] * lv[32 + j]; s2 += lv[64 + j] * lv[96 + j]; }
            ((float*)(ws + WS_LAM))[tid] = expf(s1) - expf(s2) + (0.8f - 0.6f * expf(-0.3f * (float)tid)); }
    }
    LAS h16* scr = (LAS h16*)(lds + 32768 + wave * 8448);
    const int gw = vcu * NWAVES + wave, NGW = G * NWAVES;
    constexpr int N_IN = DEPTH * 16 * 40, N_OUT = DEPTH * 16 * 16, N_E = DEPTH * NEXP * 128, N_RG = DEPTH * 2 * 8;
    constexpr int NITEMS = N_IN + N_OUT + 2 * N_RG;
    (void)N_E;
    for (int it = gw; it < NITEMS; it += NGW) {
        int r = it;
        if (r < N_IN) { const int l = r / 640; p0_transpose_item(p->in[I_WIN] + (size_t)l * D * INC, D, INC, (h16*)(ws + WS_WIN) + (size_t)l * INC * D, scr, r % 640, lane); continue; } r -= N_IN;
        if (r < N_OUT) { const int l = r / 256; p0_transpose_item(p->in[I_WOUT] + (size_t)l * D * D, D, D, (h16*)(ws + WS_WOUT) + (size_t)l * D * D, scr, r % 256, lane); continue; } r -= N_OUT;
        {
            const int gate = r / N_RG; r %= N_RG; const int mi = r; const int ldir = mi >> 3, nb = mi & 7;
            const float* src = p->in[gate ? I_RGWI : I_RGWR] + (size_t)mi * 4096;
            h16* dst = (h16*)(ws + WS_RGW) + ((size_t)(ldir * 2 + gate) * 8 + nb) * 4096;
            p0_transpose_item(src, 64, 64, dst, scr, 0, lane);
        }
    }
}

__device__ __forceinline__ void convert_experts(KP p, int l, LAS unsigned char* lds, int vcu, int G) {
    const int tid = tid_now(), lane = tid & 63, wave = __builtin_amdgcn_readfirstlane(tid >> 6);
    unsigned char* ws = p->ws;
    LAS h16* scr = (LAS h16*)(lds + 32768 + wave * 8448);
    const int gw = vcu * NWAVES + wave, NGW = G * NWAVES;
#define CE_RESOLVE(it_, W_, K_, N_, T_, tile_) do { const int m_ = (it_) >> 12, ri_ = (it_) & 4095, mi_ = l * NEXP + (ri_ >> 7); tile_ = ri_ & 127; \
        const size_t off_ = (size_t)mi_ * D * DEXP; \
        if (m_ == 0) { W_ = p->in[I_W1] + off_; K_ = D; N_ = DEXP; T_ = (h16*)(ws + WS_W1) + off_; } \
        else if (m_ == 1) { W_ = p->in[I_W3] + off_; K_ = D; N_ = DEXP; T_ = (h16*)(ws + WS_W3) + off_; } \
        else { W_ = p->in[I_W2] + off_; K_ = DEXP; N_ = D; T_ = (h16*)(ws + WS_W2) + off_; } } while (0)
    constexpr int TOTAL = 3 * NEXP * 128;
    f32x4 va[16], vb[16];
    const float* Wa = nullptr; const float* Wb = nullptr; h16* Ta = nullptr; h16* Tb = nullptr; int Ka = 0, Na = 64, Kb = 0, Nb = 64, ta = 0, tb = 0;
    int it = gw;
    if (it < TOTAL) { CE_RESOLVE(it, Wa, Ka, Na, Ta, ta); tr_load(va, Wa, Na, ta, lane); }
#pragma unroll 1
    while (it < TOTAL) {
        const int i1 = it + NGW;
        if (i1 < TOTAL) { CE_RESOLVE(i1, Wb, Kb, Nb, Tb, tb); tr_load(vb, Wb, Nb, tb, lane); }
        tr_finish(va, Ka, Na, Ta, scr, ta, lane);
        if (i1 >= TOTAL) break;
        const int i2 = i1 + NGW;
        if (i2 < TOTAL) { CE_RESOLVE(i2, Wa, Ka, Na, Ta, ta); tr_load(va, Wa, Na, ta, lane); }
        tr_finish(vb, Kb, Nb, Tb, scr, tb, lane);
        it = i2;
    }
#undef CE_RESOLVE
    __syncthreads();
}

__device__ __forceinline__ bool try_convert(KP p, int l, LAS unsigned char* lds, int limit) {
    unsigned* st = (unsigned*)(p->ws + WS_CTL) + CW_CV + l * 2;
    volatile LAS int* slot = (volatile LAS int*)(lds + MISC_OFF + 240);
    for (;;) {
        __syncthreads();
        if (threadIdx.x == 0) {
            int t = -1;
            if (limit < 0) { const unsigned s_ = __hip_atomic_fetch_add(st, 1u, __ATOMIC_RELAXED, __HIP_MEMORY_SCOPE_AGENT); if (s_ < 256u) { t = (int)s_; __hip_atomic_fetch_add(st + 1, 1u, __ATOMIC_RELAXED, __HIP_MEMORY_SCOPE_AGENT); } }
            else { const unsigned a_ = __hip_atomic_fetch_add(st + 1, 1u, __ATOMIC_RELAXED, __HIP_MEMORY_SCOPE_AGENT);
                if ((int)a_ < limit) { const unsigned s_ = __hip_atomic_fetch_add(st, 1u, __ATOMIC_RELAXED, __HIP_MEMORY_SCOPE_AGENT); if (s_ < 256u) t = (int)s_; }
                if (t < 0) __hip_atomic_fetch_sub(st + 1, 1u, __ATOMIC_RELAXED, __HIP_MEMORY_SCOPE_AGENT); }
            *slot = t;
        }
        __syncthreads();
        const int t = __builtin_amdgcn_readfirstlane(*slot);
        if (t < 0) return false;
        convert_experts(p, l, lds, t, 256);
        if (threadIdx.x == 0) __hip_atomic_fetch_sub(st + 1, 1u, __ATOMIC_RELAXED, __HIP_MEMORY_SCOPE_AGENT);
        if (limit >= 0) return true;
    }
}

__device__ __forceinline__ void phase_norm1(KP p, int l, int mode, volatile LAS int* tab, int vcu, int G, bool dummy) {
    const int tid = tid_now(); const int lane = tid & 63, wave = __builtin_amdgcn_readfirstlane(tid >> 6);
    unsigned char* ws = p->ws;
    h16* xl = (h16*)(ws + WS_XL); h16* hl = (h16*)(ws + (dummy ? WS_ACT : WS_HL)); h16* xlo = dummy ? (h16*)(ws + WS_XG) : xl;
    const float* mod = (const float*)(ws + WS_MOD);
    const int* asg = (const int*)(ws + WS_ASG); const float* ew = (const float*)(ws + WS_EW);
    const h16* yb = (const h16*)(ws + WS_YB);
    const int nrows = (mode == 2) ? NLAT : NROW;
    const int prev_rows = (l == DEPTH) ? NLAT : NROW;
    const int gw = vcu * NWAVES + wave, NGW = G * NWAVES;
    for (int row = gw; row < nrows; row += NGW) {
        const int v = (row < NLAT) ? (row >> 13) : 2;
        f32x4 x[4];
        if (mode == 0) {
            const float* src = (row < NLAT) ? p->in[I_X] + (size_t)row * D : p->in[I_CTX] + (size_t)(row - NLAT) * D;
#pragma unroll
            for (int j = 0; j < 4; ++j) x[j] = *(const f32x4*)(src + 4 * lane + 256 * j);
        } else {
            const h16* src = xl + (size_t)row * D;
#pragma unroll
            for (int j = 0; j < 4; ++j) { const h16x4 t = *(const h16x4*)(src + 4 * lane + 256 * j); x[j] = (f32x4){(float)t[0], (float)t[1], (float)t[2], (float)t[3]}; }
            if (row < prev_rows) {
                const int a0 = asg[row * 2], a1 = asg[row * 2 + 1];
                const float w0 = ew[row * 2], w1 = ew[row * 2 + 1];
                const size_t s0 = (size_t)a0, s1 = (size_t)a1;
                const float* ga = mod + ((size_t)(l - 1) * 3 + v) * 6144 + 5 * 1024;
#pragma unroll
                for (int j = 0; j < 4; ++j) {
                    const int c = 4 * lane + 256 * j;
                    const h16x4 y0 = *(const h16x4*)(yb + s0 * D + c), y1 = *(const h16x4*)(yb + s1 * D + c);
                    const f32x4 g = *(const f32x4*)(ga + c);
#pragma unroll
                    for (int e = 0; e < 4; ++e) x[j][e] += g[e] * (w0 * (float)y0[e] + w1 * (float)y1[e]);
                }
            }
        }
        if (mode != 2) {
            h16* dst = xlo + (size_t)row * D;
#pragma unroll
            for (int j = 0; j < 4; ++j) { u32x2 w; w.x = pkh(x[j][0], x[j][1]); w.y = pkh(x[j][2], x[j][3]); *(u32x2*)(dst + 4 * lane + 256 * j) = w; }
        }
        float ss = 0.f;
#pragma unroll
        for (int j = 0; j < 4; ++j) ss += x[j][0] * x[j][0] + x[j][1] * x[j][1] + x[j][2] * x[j][2] + x[j][3] * x[j][3];
        const float rstd = rsqrtf(wave_sum(ss) * (1.f / D) + EPS);
        if (mode == 2) {
            const float* g = p->in[I_GFINAL]; float* o = p->out + (size_t)row * D;
#pragma unroll
            for (int j = 0; j < 4; ++j) { const int c = 4 * lane + 256 * j; const f32x4 gv = *(const f32x4*)(g + c); *(f32x4*)(o + c) = x[j] * rstd * gv; }
        } else {
            const float* g = p->in[I_GMIX] + l * D; const float* sh = mod + ((size_t)l * 3 + v) * 6144; const float* scl = sh + 1024;
            h16* o = hl + (size_t)row * D;
#pragma unroll
            for (int j = 0; j < 4; ++j) { const int c = 4 * lane + 256 * j; const f32x4 gv = *(const f32x4*)(g + c), sv = *(const f32x4*)(scl + c), hv = *(const f32x4*)(sh + c);
                const f32x4 y = x[j] * rstd * gv * (1.f + sv) + hv;
                u32x2 w; w.x = pkh(y[0], y[1]); w.y = pkh(y[2], y[3]); *(u32x2*)(o + c) = w; }
        }
    }
}

#define SM_THR 6.0f
#define SOFTMAX_TILE(s, m, l, oA, oB, pfa, pfb) do { \
    float mx_ = fmaxf(fmaxf(s[0], s[1]), s[2]); \
    _Pragma("unroll") for (int r_ = 3; r_ < 15; r_ += 2) mx_ = fmaxf(fmaxf(mx_, s[r_]), s[r_ + 1]); \
    mx_ = fmaxf(mx_, s[15]); mx_ = xhalf_max(mx_); \
    if (__any(mx_ > m + SM_THR)) { const float dl_ = (mx_ > m + SM_THR) ? (mx_ - m) : 0.f; m += dl_; \
        const float al_ = __builtin_amdgcn_exp2f(-dl_); l *= al_; oA *= al_; oB *= al_; } \
    _Pragma("unroll") for (int r_ = 0; r_ < 16; ++r_) s[r_] = __builtin_amdgcn_exp2f(s[r_] - m); \
    { float sm_ = 0.f; _Pragma("unroll") for (int r_ = 0; r_ < 16; ++r_) sm_ += s[r_]; l += sm_; } \
    { u32x4 wa_, wb_; wa_.x = pkrtz(s[0], s[1]); wa_.y = pkrtz(s[2], s[3]); wa_.z = pkrtz(s[4], s[5]); wa_.w = pkrtz(s[6], s[7]); \
      wb_.x = pkrtz(s[8], s[9]); wb_.y = pkrtz(s[10], s[11]); wb_.z = pkrtz(s[12], s[13]); wb_.w = pkrtz(s[14], s[15]); \
      pfa = __builtin_bit_cast(h16x8, wa_); pfb = __builtin_bit_cast(h16x8, wb_); } \
} while (0)

__device__ __forceinline__ int pi32(int r) { return (r & 19) | (((r >> 3) & 1) << 2) | (((r >> 2) & 1) << 3); }

constexpr int DA_STAGE = 18432;
__device__ __forceinline__ unsigned pkrtz(float a, float b) { return __builtin_bit_cast(unsigned, __builtin_amdgcn_cvt_pkrtz(a, b)); }
__device__ __forceinline__ void da_exp_pack(f32x16& s, float& l, h16x8& pa, h16x8& pb) {
#pragma unroll
    for (int r = 0; r < 16; ++r) s[r] = __builtin_amdgcn_exp2f(s[r]);
    u32x4 wa, wb;
    wa.x = pkrtz(s[0], s[1]); wa.y = pkrtz(s[2], s[3]); wa.z = pkrtz(s[4], s[5]); wa.w = pkrtz(s[6], s[7]);
    wb.x = pkrtz(s[8], s[9]); wb.y = pkrtz(s[10], s[11]); wb.z = pkrtz(s[12], s[13]); wb.w = pkrtz(s[14], s[15]);
    const h16x2 one2 = {(h16)1.f, (h16)1.f};
    const h16x2 t0 = __builtin_bit_cast(h16x2, wa.x) + __builtin_bit_cast(h16x2, wa.y), t1 = __builtin_bit_cast(h16x2, wa.z) + __builtin_bit_cast(h16x2, wa.w);
    const h16x2 t2 = __builtin_bit_cast(h16x2, wb.x) + __builtin_bit_cast(h16x2, wb.y), t3 = __builtin_bit_cast(h16x2, wb.z) + __builtin_bit_cast(h16x2, wb.w);
    const h16x2 u0 = t0 + t1, u1 = t2 + t3;
    l = __builtin_amdgcn_fdot2(u0 + u1, one2, l, false);
    pa = __builtin_bit_cast(h16x8, wa); pb = __builtin_bit_cast(h16x8, wb);
}
__device__ __forceinline__ void diff_unit(KP p, int l, int b, int h, int qrow0, int kt0, int nkt, LAS unsigned char* lds) {
    const int tid = tid_now(), lane = tid & 63, wid = __builtin_amdgcn_readfirstlane(tid >> 6), q32 = lane & 31, hi = lane >> 5;
    unsigned char* ws = p->ws;
    const h16* Qd = (const h16*)(ws + WS_QD); const h16* Kd = (const h16*)(ws + WS_KD); const h16* VdT = (const h16*)(ws + WS_VDT);
    h16* mix = (h16*)(ws + WS_MIX);
    const int qrow = qrow0 + wid * 32 + q32;
    h16x8 qf00, qf01, qf10, qf11;
    {
        const h16* qp = Qd + (size_t)qrow * 256 + h * 64 + hi * 8;
        qf00 = *(const h16x8*)(qp); qf01 = *(const h16x8*)(qp + 16); qf10 = *(const h16x8*)(qp + 32); qf11 = *(const h16x8*)(qp + 48);
    }
    const h16x8 zero8 = {0, 0, 0, 0, 0, 0, 0, 0};
    f32x16 negm0, negm1;
    {
        const float* km = (const float*)((const unsigned*)(ws + WS_CTL) + CW_KMAX + l * 16) + (b * 4 + h) * 2;
        float q0 = 0.f, q1 = 0.f;
#pragma unroll
        for (int j = 0; j < 8; ++j) { q0 += (float)qf00[j] * (float)qf00[j] + (float)qf01[j] * (float)qf01[j]; q1 += (float)qf10[j] * (float)qf10[j] + (float)qf11[j] * (float)qf11[j]; }
        q0 = xhalf_sum(q0); q1 = xhalf_sum(q1);
        const float m0 = sqrtf(q0 * km[0]) * 1.004f + 0.01f - 10.f, m1 = sqrtf(q1 * km[1]) * 1.004f + 0.01f - 10.f;
#pragma unroll
        for (int r = 0; r < 16; ++r) { negm0[r] = -m0; negm1[r] = -m1; }
    }
    const int srow = tid >> 3, sch = tid & 7;
    const h16* kg = Kd + ((size_t)(b * KEYS + kt0 * 64 + srow)) * 256 + h * 64 + sch * 8;
    const h16* vg = VdT + ((size_t)((b * 4 + h) * 64 + srow)) * KEYS + kt0 * 64 + sch * 8;
    const int sto = srow * 144 + sch * 16;
    const int koff = pi32(q32) * 144 + hi * 16, voff = 9216 + q32 * 144 + hi * 16;
    float l0 = 0.f, l1 = 0.f;
    f32x16 o00 = {}, o01 = {}, o10 = {}, o11 = {};
#define DA_MF(a_, b_, c_) __builtin_amdgcn_mfma_f32_32x32x16_f16(a_, b_, c_, 0, 0, 0)
#define DA_KLOAD(addr) do { const LAS unsigned char* kb_ = (addr); kf0a = *(const LAS h16x8*)(kb_); kf0b = *(const LAS h16x8*)(kb_ + 32); kf1a = *(const LAS h16x8*)(kb_ + 64); kf1b = *(const LAS h16x8*)(kb_ + 96); } while (0)
#define DA_VLOAD(addr) do { const LAS unsigned char* vb_ = (addr); v00 = *(const LAS h16x8*)(vb_); v10 = *(const LAS h16x8*)(vb_ + 4608); v01 = *(const LAS h16x8*)(vb_ + 32); v11 = *(const LAS h16x8*)(vb_ + 4608 + 32); } while (0)
#define DA_STEP(PP0a, PP0b, PP1a, PP1b, PN0a, PN0b, PN1a, PN1b, vaddr, kaddr) do { \
        o00 = DA_MF(v00, PP0a, o00); o10 = DA_MF(v00, PP1a, o10); o01 = DA_MF(v10, PP0a, o01); o11 = DA_MF(v10, PP1a, o11); \
        o00 = DA_MF(v01, PP0b, o00); o10 = DA_MF(v01, PP1b, o10); o01 = DA_MF(v11, PP0b, o01); o11 = DA_MF(v11, PP1b, o11); \
        da_exp_pack(s0, l0, PN0a, PN0b); \
        s0 = DA_MF(kf0a, qf00, negm0); s0 = DA_MF(kf0b, qf01, s0); \
        da_exp_pack(s1, l1, PN1a, PN1b); \
        s1 = DA_MF(kf1a, qf10, negm1); s1 = DA_MF(kf1b, qf11, s1); \
        DA_VLOAD(vaddr); DA_KLOAD(kaddr); \
    } while (0)
    __syncthreads();
    u32x4 kreg = *(const u32x4*)kg, vreg = *(const u32x4*)vg;
    *(LAS u32x4*)(lds + sto) = kreg; *(LAS u32x4*)(lds + 9216 + sto) = vreg;
    kreg = *(const u32x4*)(kg + (size_t)64 * 256); vreg = *(const u32x4*)(vg + 64);
    *(LAS u32x4*)(lds + DA_STAGE + sto) = kreg; *(LAS u32x4*)(lds + DA_STAGE + 9216 + sto) = vreg;
    if (nkt > 2) { kreg = *(const u32x4*)(kg + (size_t)2 * 64 * 256); vreg = *(const u32x4*)(vg + 2 * 64); }
    __syncthreads();
    f32x16 s0, s1;
    h16x8 kf0a, kf0b, kf1a, kf1b, v00, v10, v01, v11;
    h16x8 pa0a = zero8, pa0b = zero8, pa1a = zero8, pa1b = zero8, pb0a = zero8, pb0b = zero8, pb1a = zero8, pb1b = zero8;
    DA_KLOAD(lds + koff);
    s0 = DA_MF(kf0a, qf00, negm0); s0 = DA_MF(kf0b, qf01, s0);
    s1 = DA_MF(kf1a, qf10, negm1); s1 = DA_MF(kf1b, qf11, s1);
    DA_KLOAD(lds + koff + 4608);
    DA_VLOAD(lds + voff);
    int cur = 0, nxt = DA_STAGE, wrs = 2 * DA_STAGE;
    for (int t = 0; t < nkt; ++t) {
        if (t + 2 < nkt) { *(LAS u32x4*)(lds + wrs + sto) = kreg; *(LAS u32x4*)(lds + wrs + 9216 + sto) = vreg; }
        if (t + 3 < nkt) { kreg = *(const u32x4*)(kg + (size_t)(t + 3) * 64 * 256); vreg = *(const u32x4*)(vg + (size_t)(t + 3) * 64); }
        const int pf = (t + 1 < nkt) ? nxt : cur;
        DA_STEP(pb0a, pb0b, pb1a, pb1b, pa0a, pa0b, pa1a, pa1b, lds + cur + voff, lds + pf + koff);
        DA_STEP(pa0a, pa0b, pa1a, pa1b, pb0a, pb0b, pb1a, pb1b, lds + cur + voff + 64, lds + pf + koff + 4608);
        { const int tmp = cur; cur = nxt; nxt = wrs; wrs = tmp; }
        __syncthreads();
    }
    o00 = DA_MF(v00, pb0a, o00); o10 = DA_MF(v00, pb1a, o10); o01 = DA_MF(v10, pb0a, o01); o11 = DA_MF(v10, pb1a, o11);
    o00 = DA_MF(v01, pb0b, o00); o10 = DA_MF(v01, pb1b, o10); o01 = DA_MF(v11, pb0b, o01); o11 = DA_MF(v11, pb1b, o11);
#undef DA_MF
#undef DA_KLOAD
#undef DA_VLOAD
#undef DA_STEP
    const float lam = ((const float*)(ws + WS_LAM))[l];
    const float lam_init = 0.8f - 0.6f * expf(-0.3f * (float)l);
    const float r0 = 1.f / xhalf_sum(l0), r1 = lam / xhalf_sum(l1);
    f32x16 y0 = o00 * r0 - o10 * r1, y1 = o01 * r0 - o11 * r1;
    float ss = 0.f;
#pragma unroll
    for (int r = 0; r < 16; ++r) ss += y0[r] * y0[r] + y1[r] * y1[r];
    ss = xhalf_sum(ss);
    const float sc = rsqrtf(ss * (1.f / 64.f) + EPS) * (1.f - lam_init);
    const float* g = p->in[I_DSUBG] + l * 64;
    h16* dst = mix + (size_t)qrow * D + 768 + h * 64;
#pragma unroll
    for (int r4 = 0; r4 < 4; ++r4) {
        const int e0 = 8 * r4 + 4 * hi;
        const f32x4 g0 = *(const f32x4*)(g + e0), g1 = *(const f32x4*)(g + 32 + e0);
        u32x2 w0, w1;
        w0.x = pkh(y0[4 * r4] * sc * g0[0], y0[4 * r4 + 1] * sc * g0[1]); w0.y = pkh(y0[4 * r4 + 2] * sc * g0[2], y0[4 * r4 + 3] * sc * g0[3]);
        w1.x = pkh(y1[4 * r4] * sc * g1[0], y1[4 * r4 + 1] * sc * g1[1]); w1.y = pkh(y1[4 * r4 + 2] * sc * g1[2], y1[4 * r4 + 3] * sc * g1[3]);
        *(u32x2*)(dst + e0) = w0; *(u32x2*)(dst + 32 + e0) = w1;
    }
}

constexpr int NA_K = 0, NA_V = 33792, NA_BIAS = 33792 + 36864;
__device__ __forceinline__ void na_unit(KP p, int l, int b, int gr, bool isctx, LAS unsigned char* lds) {
    const int tid = tid_now(), lane = tid & 63, wid = __builtin_amdgcn_readfirstlane(tid >> 6), q32 = lane & 31, hi = lane >> 5;
    const int h = wid >> 1, qt = wid & 1;
    unsigned char* ws = p->ws;
    const h16* qa = (const h16*)(ws + WS_QA); const h16* Ka = (const h16*)(ws + WS_KA); const h16* VaT = (const h16*)(ws + WS_VAT);
    h16* mix = (h16*)(ws + WS_MIX);
    const int qrow = isctx ? (NLAT + b * CTX + gr * 64 + qt * 32 + q32) : (b * SEQ + gr * 64 + qt * 32 + q32);
    h16x8 qf[4];
#pragma unroll
    for (int ks = 0; ks < 4; ++ks) qf[ks] = *(const h16x8*)(qa + (size_t)qrow * 256 + h * 64 + ks * 16 + hi * 8);
    const int nloc = isctx ? 0 : 8, ntile = nloc + 4;
    int kr0 = gr - 4; kr0 = kr0 < 0 ? 0 : (kr0 > 120 ? 120 : kr0);
    LAS float* bias = (LAS float*)(lds + NA_BIAS);
    __syncthreads();
    if (!isctx) { const float* rp = p->in[I_RPB] + (size_t)l * 4 * 15 * 31; for (int i = tid; i < 4 * 15 * 31; i += NTHREADS) bias[i] = rp[i] * LOG2E; }
    const int koff = NA_K + pi32(q32) * 528 + h * 128 + hi * 16;
    const int voff = NA_V + (h * 64 + q32) * 144 + hi * 16;
    const int cq = qt * 32 + q32; int cs = cq - 8; cs = cs < 0 ? 0 : (cs > 48 ? 48 : cs);
    float m = 0.f, ls = 0.f; f32x16 o0 = {}, o1 = {};
    u32x4 kpre[4], vpre[4];
#define NA_LOAD(t_) do { const int key0_ = ((t_) < nloc) ? (kr0 + (t_)) * 64 : SEQ + ((t_) - nloc) * 64; \
        _Pragma("unroll") for (int i = 0; i < 4; ++i) { const int id = tid + 512 * i; \
            kpre[i] = *(const u32x4*)(Ka + ((size_t)(b * KEYS + key0_ + (id >> 5))) * 256 + (id & 31) * 8); \
            vpre[i] = *(const u32x4*)(VaT + ((size_t)(b * 256 + (id >> 3))) * KEYS + key0_ + (id & 7) * 8); } } while (0)
    NA_LOAD(0);
    for (int t = 0; t < ntile; ++t) {
        __syncthreads();
#pragma unroll
        for (int i = 0; i < 4; ++i) { const int id = tid + 512 * i;
            *(LAS u32x4*)(lds + NA_K + (id >> 5) * 528 + (id & 31) * 16) = kpre[i];
            *(LAS u32x4*)(lds + NA_V + (id >> 3) * 144 + (id & 7) * 16) = vpre[i]; }
        __syncthreads();
        if (t + 1 < ntile) NA_LOAD(t + 1);
#pragma unroll
        for (int th = 0; th < 2; ++th) {
            f32x16 s = {};
#pragma unroll
            for (int ks = 0; ks < 4; ++ks) { const h16x8 kf = *(const LAS h16x8*)(lds + koff + th * 32 * 528 + ks * 32); s = __builtin_amdgcn_mfma_f32_32x32x16_f16(kf, qf[ks], s, 0, 0, 0); }
            if (t < nloc) {
                const int dr = kr0 + t - gr;
                const LAS float* browl = bias + (h * 15 + dr + 7) * 31 + 15 - cq + 8 * hi; const int dwin = 8 * hi - cs;
#pragma unroll
                for (int r = 0; r < 16; ++r) { const int cr_ = 32 * th + 16 * (r >> 3) + (r & 7);
                    float bv_ = browl[cr_]; asm volatile("" : "+v"(bv_));
                    s[r] = ((unsigned)(cr_ + dwin) < 16u) ? s[r] + bv_ : -INFINITY; }
            }
            h16x8 pa, pb;
            SOFTMAX_TILE(s, m, ls, o0, o1, pa, pb);
            const h16x8 v00 = *(const LAS h16x8*)(lds + voff + th * 64), v10 = *(const LAS h16x8*)(lds + voff + 32 * 144 + th * 64);
            const h16x8 v01 = *(const LAS h16x8*)(lds + voff + th * 64 + 32), v11 = *(const LAS h16x8*)(lds + voff + 32 * 144 + th * 64 + 32);
            o0 = __builtin_amdgcn_mfma_f32_32x32x16_f16(v00, pa, o0, 0, 0, 0); o1 = __builtin_amdgcn_mfma_f32_32x32x16_f16(v10, pa, o1, 0, 0, 0);
            o0 = __builtin_amdgcn_mfma_f32_32x32x16_f16(v01, pb, o0, 0, 0, 0); o1 = __builtin_amdgcn_mfma_f32_32x32x16_f16(v11, pb, o1, 0, 0, 0);
        }
    }
    const float rl = 1.f / xhalf_sum(ls);
    h16* dst = mix + (size_t)qrow * D + h * 64;
#pragma unroll
    for (int r4 = 0; r4 < 4; ++r4) {
        const int e0 = 8 * r4 + 4 * hi; u32x2 w0, w1;
        w0.x = pkh(o0[4 * r4] * rl, o0[4 * r4 + 1] * rl); w0.y = pkh(o0[4 * r4 + 2] * rl, o0[4 * r4 + 3] * rl);
        w1.x = pkh(o1[4 * r4] * rl, o1[4 * r4 + 1] * rl); w1.y = pkh(o1[4 * r4 + 2] * rl, o1[4 * r4 + 3] * rl);
        *(u32x2*)(dst + e0) = w0; *(u32x2*)(dst + 32 + e0) = w1;
    }
}

constexpr int RG_X32 = 0, RG_X16 = 16384, RG_W = 25600, RG_AB = 62464, RG_SEG = 128000;
__device__ __forceinline__ void rg_load_x(h16x8 (&xv)[4], const h16* xr, int q, int tid, bool valid) {
    const int RT = q >> 3, nb = q & 7;
    const int r = tid >> 3, ch = nb * 64 + (tid & 7) * 8;
    const bool isctx = RT >= 256; const int j = isctx ? ((RT - 256) & 3) : (RT & 127); const int seqlen = isctx ? CTX : SEQ;
#pragma unroll
    for (int tap = 0; tap < 4; ++tap) {
        const int t = j * 64 + r + tap - 2;
        if (valid && t >= 0 && t < seqlen) xv[tap] = *(const h16x8*)(xr + (size_t)(RT * 64 + r + tap - 2) * 512 + ch);
        else xv[tap] = (h16x8){0, 0, 0, 0, 0, 0, 0, 0};
    }
}
__device__ __forceinline__ void rg_gate_block(KP p, int l, int q0, int qstride, int qend, LAS unsigned char* lds, const int mode, unsigned* dyn_ctr = nullptr) {
    const int tid = tid_now(), lane = tid & 63, wid = __builtin_amdgcn_readfirstlane(tid >> 6), q32 = lane & 31, hi = lane >> 5;
    unsigned char* ws = p->ws;
    const h16* xr = (const h16*)(ws + WS_XR);
    float* agg = (float*)(ws + WS_AGG);
    const h16* gg = (const h16*)(ws + WS_GG); h16* mix = (h16*)(ws + WS_MIX);
    LAS h16* x16 = (LAS h16*)(lds + RG_X16); LAS h16* Wl = (LAS h16*)(lds + RG_W); LAS float* ab = (LAS float*)(lds + RG_AB); LAS float* seg = (LAS float*)(lds + RG_SEG);
    LAS float* carryL = (LAS float*)(lds + RG_SEG + 4096);
    if (q0 >= qend) return;
    const int nb0 = q0 & 7;
    const bool skip_ctx_out = (l == DEPTH - 1);
    const bool dyn = (mode == 0) && (dyn_ctr != nullptr);
    LAS int* tkt = (LAS int*)carryL;
    if (dyn) {
        if (tid == 0) { const unsigned t0 = __hip_atomic_fetch_add(dyn_ctr, 1u, __ATOMIC_RELAXED, __HIP_MEMORY_SCOPE_AGENT), t1 = __hip_atomic_fetch_add(dyn_ctr, 1u, __ATOMIC_RELAXED, __HIP_MEMORY_SCOPE_AGENT); tkt[0] = (int)t0; tkt[1] = (int)t1; }
        __syncthreads();
        q0 = __builtin_amdgcn_readfirstlane(tkt[0]) * 8 + nb0;
        if (q0 >= qend) return;
    }
    h16x8 xv[4];
    rg_load_x(xv, xr, q0, tid, true);
    if (mode == 1 && tid < 256) {
        const int dir = tid >> 7, b = (tid >> 6) & 1, chl = tid & 63;
        const float* ag = agg + ((((size_t)dir * 2 + b) * 132) * 512 + nb0 * 64 + chl) * 2;
        float h = 0.f;
#pragma unroll 1
        for (int c0 = 0; c0 < 132; c0 += 33) {
            f32x2 v[33];
#pragma unroll
            for (int i = 0; i < 33; ++i) v[i] = *(const f32x2*)(ag + (size_t)(c0 + i) * 1024);
#pragma unroll
            for (int i = 0; i < 33; ++i) {
                const int c = c0 + i;
                int RT; if (dir == 0) RT = (c < 4) ? 256 + 4 * b + c : 128 * b + (c - 4); else RT = (c < 4) ? 256 + 4 * b + (3 - c) : 128 * b + 127 - (c - 4);
                const int dq = RT * 8 + nb0 - q0;
                if (dq >= 0 && (dq % qstride) == 0 && dq / qstride < 12) carryL[((dq / qstride) * 2 + dir) * 64 + chl] = h;
                h = v[i].x * h + v[i].y;
            }
        }
    }
    int cur_nb = -1;
    float cwr[4][8], cbr[8]; float g_br, g_bi, g_sp;
#define RG_LOAD_CONSTS(nb_) do { \
        const int ch_ = (nb_) * 64 + (tid & 7) * 8; const float* cw_ = p->in[I_CONVW] + (size_t)l * 4 * 512 + ch_; const float* cb_ = p->in[I_CONVB] + l * 512 + ch_; \
        _Pragma("unroll") for (int e = 0; e < 8; ++e) { cbr[e] = cb_[e]; _Pragma("unroll") for (int tap = 0; tap < 4; ++tap) cwr[tap][e] = cw_[tap * 512 + e]; } \
        const int dir_ = wid >> 2, chg_ = (nb_) * 64 + ((wid >> 1) & 1) * 32 + q32; \
        g_br = p->in[I_RGBR][(l * 2 + dir_) * 512 + chg_]; g_bi = p->in[I_RGBI][(l * 2 + dir_) * 512 + chg_]; \
        const float lamv_ = p->in[I_RGLAM][(l * 2 + dir_) * 512 + chg_]; const float ex_ = __expf(-lamv_); g_sp = (lamv_ > 8.f) ? ex_ * (1.f - 0.5f * ex_) : __logf(1.f + ex_); } while (0)
    RG_LOAD_CONSTS(nb0);
    int const_nb = nb0;
    __syncthreads();
    int kt = 0;
    for (int q = q0; q < qend; ++kt) {
        unsigned tnew = 0u;
        if (dyn && tid == 0) tnew = __hip_atomic_fetch_add(dyn_ctr, 1u, __ATOMIC_RELAXED, __HIP_MEMORY_SCOPE_AGENT);
        const int RT = q >> 3, nb = q & 7;
        const int row0 = RT * 64;
        const bool isctx = RT >= 256; int b, j;
        if (isctx) { const int qq = RT - 256; b = qq >> 2; j = qq & 3; } else { b = RT >> 7; j = RT & 127; }
        h16x8 ggv;
        {
            const int r = tid >> 3, c8 = (tid & 7) * 8, ch = nb * 64 + c8;
            ggv = *(const h16x8*)(gg + (size_t)(row0 + r) * 512 + ch);
            if (nb != const_nb) { RG_LOAD_CONSTS(nb); const_nb = nb; }
            float accv[8];
#pragma unroll
            for (int e = 0; e < 8; ++e) accv[e] = cbr[e];
#pragma unroll
            for (int tap = 0; tap < 4; ++tap)
#pragma unroll
                for (int e = 0; e < 8; ++e) accv[e] += (float)xv[tap][e] * cwr[tap][e];
            { u32x4 w; w.x = pkh(accv[0], accv[1]); w.y = pkh(accv[2], accv[3]); w.z = pkh(accv[4], accv[5]); w.w = pkh(accv[6], accv[7]); *(LAS u32x4*)(x16 + r * 72 + c8) = w; }
            if (nb != cur_nb) {
                const h16* wsrc = (const h16*)(ws + WS_RGW);
#pragma unroll
                for (int i = 0; i < 4; ++i) { const int id = tid + 512 * i; const int n = id >> 3, kc = id & 7; const int dg = n >> 6, nn = n & 63;
                    *(LAS u32x4*)(Wl + n * 72 + kc * 8) = *(const u32x4*)(wsrc + (((size_t)(l * 4 + dg) * 8 + nb) * 64 + nn) * 64 + kc * 8); }
                cur_nb = nb;
            }
        }
        lds_barrier();
        const int qn = dyn ? __builtin_amdgcn_readfirstlane(tkt[1]) * 8 + nb0 : q + qstride;
        rg_load_x(xv, xr, qn, tid, qn < qend);
        {
            const int mt = wid & 1, g = wid >> 1, dir = g >> 1, ch2 = g & 1;
            f32x16 cr = {}, ci = {};
#pragma unroll
            for (int ks = 0; ks < 4; ++ks) {
                const h16x8 af = *(const LAS h16x8*)(x16 + (mt * 32 + q32) * 72 + ks * 16 + hi * 8);
                const h16x8 br = *(const LAS h16x8*)(Wl + (dir * 128 + ch2 * 32 + q32) * 72 + ks * 16 + hi * 8);
                const h16x8 bi = *(const LAS h16x8*)(Wl + (dir * 128 + 64 + ch2 * 32 + q32) * 72 + ks * 16 + hi * 8);
                cr = __builtin_amdgcn_mfma_f32_32x32x16_f16(af, br, cr, 0, 0, 0);
                ci = __builtin_amdgcn_mfma_f32_32x32x16_f16(af, bi, ci, 0, 0, 0);
            }
            const int chl = ch2 * 32 + q32;
            const float nbr = -g_br * LOG2E, nbi = -g_bi * LOG2E, c8 = -8.f * g_sp * LOG2E;
#pragma unroll
            for (int r = 0; r < 16; ++r) {
                const int tr = mt * 32 + crow(r, hi);
                const float rg = frcp_(1.f + __builtin_amdgcn_exp2f(__builtin_fmaf(cr[r], -LOG2E, nbr)));
                const float ig = frcp_(1.f + __builtin_amdgcn_exp2f(__builtin_fmaf(ci[r], -LOG2E, nbi)));
                const float a = __builtin_amdgcn_exp2f(rg * c8);
                const float om = __builtin_fmaf(-a, a, 1.f);
                const float bx = __builtin_amdgcn_sqrtf(om) * ig * (float)x16[tr * 72 + chl];
                ab[((dir * 2 + 0) * 64 + tr) * 64 + chl] = a; ab[((dir * 2 + 1) * 64 + tr) * 64 + chl] = bx;
            }
        }
        lds_barrier();
        if (mode == 0) {
            {
                const int sg = tid >> 7, dir = (tid >> 6) & 1, chl = tid & 63; float A = 1.f, H = 0.f;
                LAS float* pa = ab + (dir * 2 + 0) * 4096 + sg * 16 * 64 + chl; LAS float* pb = ab + (dir * 2 + 1) * 4096 + sg * 16 * 64 + chl;
                float av[16], bv[16];
#pragma unroll
                for (int i = 0; i < 16; ++i) { av[i] = pa[i * 64]; bv[i] = pb[i * 64]; }
                if (dir == 0) {
#pragma unroll
                    for (int i = 0; i < 16; ++i) { H = av[i] * H + bv[i]; A *= av[i]; bv[i] = H; av[i] = A; }
                } else {
#pragma unroll
                    for (int i = 15; i >= 0; --i) { H = av[i] * H + bv[i]; A *= av[i]; bv[i] = H; av[i] = A; }
                }
#pragma unroll
                for (int i = 0; i < 16; ++i) { pa[i * 64] = av[i]; pb[i * 64] = bv[i]; }
                seg[((dir * 4 + sg) * 64 + chl) * 2] = A; seg[((dir * 4 + sg) * 64 + chl) * 2 + 1] = H;
            }
            lds_barrier();
            if (tid < 128) {
                const int dir = tid >> 6, chl = tid & 63; float Pp = 1.f, Hc = 0.f; asm volatile("" : "+v"(Pp), "+v"(Hc));
#pragma unroll
                for (int i = 0; i < 4; ++i) { const int sg = dir ? 3 - i : i; LAS float* sp = seg + ((dir * 4 + sg) * 64 + chl) * 2; const float a = sp[0], hh = sp[1]; sp[0] = Pp; sp[1] = Hc; Hc = a * Hc + hh; Pp *= a; }
                int c;
                if (dir == 0) c = isctx ? j : 4 + j; else c = isctx ? 3 - j : 4 + 127 - j;
                float* dst = agg + ((((size_t)dir * 2 + b) * 132 + c) * 512 + nb * 64 + chl) * 2;
                dst[0] = Pp; dst[1] = Hc;
            }
            lds_barrier();
            {
                const int r = tid >> 3, c8 = (tid & 7) * 8, sgr = r >> 4;
                h16* hp = (h16*)(ws + WS_HP) + (size_t)q * 12288 + r * 64 + c8;
                float Ssum[8];
#pragma unroll
                for (int dir = 0; dir < 2; ++dir) {
                    const LAS float* fx = seg + ((dir * 4 + sgr) * 64 + c8) * 2;
                    const LAS float* sa = ab + (dir * 2 + 0) * 4096 + r * 64 + c8; const LAS float* sb = ab + (dir * 2 + 1) * 4096 + r * 64 + c8;
                    const f32x4 a0 = *(const LAS f32x4*)sa, a1 = *(const LAS f32x4*)(sa + 4), b0 = *(const LAS f32x4*)sb, b1 = *(const LAS f32x4*)(sb + 4);
                    float P[8];
#pragma unroll
                    for (int i = 0; i < 8; ++i) { const f32x2 f = *(const LAS f32x2*)(fx + i * 2); const float ps = (i < 4) ? a0[i & 3] : a1[i & 3], hs = (i < 4) ? b0[i & 3] : b1[i & 3];
                        P[i] = ps * f.x * (float)ggv[i]; const float hh = __builtin_fmaf(ps, f.y, hs); Ssum[i] = dir ? Ssum[i] + hh : hh; }
                    u32x4 w; w.x = pkh(P[0], P[1]); w.y = pkh(P[2], P[3]); w.z = pkh(P[4], P[5]); w.w = pkh(P[6], P[7]);
                    *(u32x4*)(hp + (1 + dir) * 4096) = w;
                }
                u32x4 w; w.x = pkh(Ssum[0] * (float)ggv[0], Ssum[1] * (float)ggv[1]); w.y = pkh(Ssum[2] * (float)ggv[2], Ssum[3] * (float)ggv[3]);
                w.z = pkh(Ssum[4] * (float)ggv[4], Ssum[5] * (float)ggv[5]); w.w = pkh(Ssum[6] * (float)ggv[6], Ssum[7] * (float)ggv[7]);
                *(u32x4*)hp = w;
            }
        } else {
            if (tid < 128) {
                const int dir = tid >> 6, chl = tid & 63;
                float h = carryL[(kt * 2 + dir) * 64 + chl];
                LAS float* pa = ab + (dir * 2 + 0) * 4096 + chl; LAS float* pb = ab + (dir * 2 + 1) * 4096 + chl;
#pragma unroll 1
                for (int g0 = 0; g0 < 64; g0 += 16) {
                    const int r0 = dir ? 48 - g0 : g0;
                    float av[16], bv[16];
#pragma unroll
                    for (int i = 0; i < 16; ++i) { av[i] = pa[(r0 + i) * 64]; bv[i] = pb[(r0 + i) * 64]; }
                    if (dir == 0) {
#pragma unroll
                        for (int i = 0; i < 16; ++i) { h = av[i] * h + bv[i]; bv[i] = h; }
                    } else {
#pragma unroll
                        for (int i = 15; i >= 0; --i) { h = av[i] * h + bv[i]; bv[i] = h; }
                    }
#pragma unroll
                    for (int i = 0; i < 16; ++i) pb[(r0 + i) * 64] = bv[i];
                }
            }
            lds_barrier();
            if (!(isctx && skip_ctx_out)) {
                const int r = tid >> 3, c8 = (tid & 7) * 8;
                const LAS float* hf = ab + (0 * 2 + 1) * 4096 + r * 64 + c8; const LAS float* hb = ab + (1 * 2 + 1) * 4096 + r * 64 + c8;
                u32x4 w;
                w.x = pkh((hf[0] + hb[0]) * (float)ggv[0], (hf[1] + hb[1]) * (float)ggv[1]); w.y = pkh((hf[2] + hb[2]) * (float)ggv[2], (hf[3] + hb[3]) * (float)ggv[3]);
                w.z = pkh((hf[4] + hb[4]) * (float)ggv[4], (hf[5] + hb[5]) * (float)ggv[5]); w.w = pkh((hf[6] + hb[6]) * (float)ggv[6], (hf[7] + hb[7]) * (float)ggv[7]);
                *(u32x4*)(mix + (size_t)(row0 + r) * D + 256 + nb * 64 + c8) = w;
            }
        }
        if (dyn && tid == 0) tkt[1] = (int)tnew;
        q = qn;
    }
}

__device__ __forceinline__ void phase_mix(KP p, int l, LAS unsigned char* lds, int vcu, int G) {
    const bool last = (l == DEPTH - 1);
    const unsigned* s2c = (const unsigned*)(p->ws + WS_CTL) + CW_S2 + l * 64;
    unit_wait(s2c, 396u);
    try_convert(p, l, lds, CV_LIMIT);
    for (int u = blockIdx.x; u < 256; u += G) { const int bh = u >> 5, qb = u & 31; REP(30) diff_unit(p, l, bh >> 2, bh & 3, (bh >> 2) * SEQ + qb * 256, 0, 132, lds); }
    try_convert(p, l, lds, CV_LIMIT);
    for (int q = blockIdx.x; q < 256; q += G) { REP(31) na_unit(p, l, q >> 7, q & 127, false, lds); }
    while (try_convert(p, l, lds, CV_LIMIT)) {}
    if (!last) for (int e = G - 1 - (int)blockIdx.x; e < 16; e += G) {
        if (e < 8) na_unit(p, l, e >> 2, e & 3, true, lds);
        else { const int bh = e - 8; diff_unit(p, l, bh >> 2, bh & 3, NLAT + (bh >> 2) * CTX, 128, 4, lds); }
    }
    unit_wait(s2c + 32, 264u);
    unsigned* gctr = (G % 8 == 0) ? (unsigned*)(p->ws + WS_CTL) + CW_GT + l * 8 + (blockIdx.x & 7) : nullptr;
    REP(32) rg_gate_block(p, l, (G % 8 == 0) ? (int)(blockIdx.x & 7) : (int)blockIdx.x, G, 264 * 8, lds, 0, gctr);
    try_convert(p, l, lds, -1);
}

__device__ __forceinline__ void phase_scan(KP p, int l, LAS unsigned char* lds, int G) {
    const bool last = (l == DEPTH - 1);
    const int tid = tid_now();
    unsigned char* ws = p->ws;
    const int U3 = 256 + (last ? 0 : 8) + 256 + (last ? 0 : 8);
    int u = blockIdx.x; while (u < U3) u += G;
    const int q0 = u - U3, qstride = G, qend = 264 * 8;
    if (q0 >= qend) return;
    const float* agg = (const float*)(ws + WS_AGG);
    const h16* gg = (const h16*)(ws + WS_GG); h16* mix = (h16*)(ws + WS_MIX); const h16* hpb = (const h16*)(ws + WS_HP);
    LAS float* carryL = (LAS float*)(lds + RG_SEG + 4096);
    const int nb0 = q0 & 7;
    const int r = tid >> 3, c8 = (tid & 7) * 8;
    h16x8 hv[3];
#define S4_LOAD(q_) do { const h16* hp_ = hpb + (size_t)(q_) * 12288 + r * 64 + c8; \
        _Pragma("unroll") for (int pl = 0; pl < 3; ++pl) hv[pl] = *(const h16x8*)(hp_ + pl * 4096); } while (0)
    S4_LOAD(q0);
    {
        const int half = tid >> 8, dir = (tid >> 7) & 1, b = (tid >> 6) & 1, chl = tid & 63;
        const float* ag = agg + ((((size_t)dir * 2 + b) * 132 + half * 66) * 512 + nb0 * 64 + chl) * 2;
        LAS float* relL = (LAS float*)(lds + 65536);
        LAS float* endL = (LAS float*)(lds + 65536 + 12288);
        float h = 0.f, P = 1.f;
#pragma unroll 1
        for (int c0 = 0; c0 < 66; c0 += 33) {
            f32x2 v[33];
#pragma unroll
            for (int i = 0; i < 33; ++i) v[i] = *(const f32x2*)(ag + (size_t)(c0 + i) * 1024);
#pragma unroll
            for (int i = 0; i < 33; ++i) {
                const int c = half * 66 + c0 + i;
                int RT; if (dir == 0) RT = (c < 4) ? 256 + 4 * b + c : 128 * b + (c - 4); else RT = (c < 4) ? 256 + 4 * b + (3 - c) : 128 * b + 127 - (c - 4);
                const int dq = RT * 8 + nb0 - q0;
                if (dq >= 0 && (dq % qstride) == 0 && dq / qstride < 12) { LAS float* e = relL + (((dq / qstride) * 2 + dir) * 64 + chl) * 2; e[0] = half ? P : 0.f; e[1] = h; }
                h = v[i].x * h + v[i].y; P *= v[i].x;
            }
        }
        if (half == 0) endL[(dir * 2 + b) * 64 + chl] = h;
    }
    __syncthreads();
    for (int e = tid; e < 12 * 128; e += NTHREADS) {
        const int tl = e >> 7, dir = (e >> 6) & 1, chl = e & 63; const int qq = q0 + tl * qstride;
        if (qq < qend) { const int RT = qq >> 3; const int b = (RT >= 256) ? ((RT - 256) >> 2) : (RT >> 7);
            const LAS float* relL = (const LAS float*)(lds + 65536); const LAS float* endL = (const LAS float*)(lds + 65536 + 12288);
            carryL[e] = __builtin_fmaf(relL[e * 2], endL[(dir * 2 + b) * 64 + chl], relL[e * 2 + 1]); }
    }
    __syncthreads();
    int kt = 0;
    for (int q = q0; q < qend; q += qstride, ++kt) {
        const int RT = q >> 3, nb = q & 7;
        const bool isctx = RT >= 256;
        h16x8 ch[3];
#pragma unroll
        for (int pl = 0; pl < 3; ++pl) ch[pl] = hv[pl];
        if (q + qstride < qend) S4_LOAD(q + qstride);
        const LAS float* cf = carryL + (kt * 2 + 0) * 64 + c8; const LAS float* cb = carryL + (kt * 2 + 1) * 64 + c8;
        const f32x4 cf0 = *(const LAS f32x4*)cf, cf1 = *(const LAS f32x4*)(cf + 4), cb0 = *(const LAS f32x4*)cb, cb1 = *(const LAS f32x4*)(cb + 4);
        float y[8];
#pragma unroll
        for (int i = 0; i < 8; ++i) {
            const float cfi = (i < 4) ? cf0[i & 3] : cf1[i & 3], cbi = (i < 4) ? cb0[i & 3] : cb1[i & 3];
            y[i] = __builtin_fmaf((float)ch[2][i], cbi, __builtin_fmaf((float)ch[1][i], cfi, (float)ch[0][i]));
        }
        if (!(isctx && last)) {
            u32x4 w; w.x = pkh(y[0], y[1]); w.y = pkh(y[2], y[3]); w.z = pkh(y[4], y[5]); w.w = pkh(y[6], y[7]);
            *(u32x4*)(mix + (size_t)(RT * 64 + r) * D + 256 + nb * 64 + c8) = w;
        }
    }
#undef S4_LOAD
}

__device__ __forceinline__ void phase_route(KP p, int l, LAS unsigned char* lds, int vcu, int G, bool dummy) {
    const int tid = tid_now(), lane = tid & 63, wave = __builtin_amdgcn_readfirstlane(tid >> 6);
    unsigned char* ws = p->ws;
    const h16* xl = (const h16*)(ws + WS_XL); h16* xg = (h16*)(ws + (dummy ? WS_YB : WS_XG));
    const float* mod = (const float*)(ws + WS_MOD);
    int* asg = (int*)(ws + (dummy ? 7 * MiB : WS_ASG)); float* ew = (float*)(ws + (dummy ? 7 * MiB + 512 * 1024 : WS_EW));
    unsigned* cnt = (unsigned*)(ws + WS_CTL) + CW_CNT + l * 32 + (dummy ? 512 : 0);
    unsigned* pool = (unsigned*)(ws + WS_CTL) + CW_POOL + l + (dummy ? 8 : 0); unsigned* tmap = (unsigned*)(ws + WS_CTL) + (dummy ? 32768 : CW_TMAP) + l * 32 * 72; unsigned* owner = (unsigned*)(ws + WS_CTL) + (dummy ? 45000 : CW_OWNER) + l * 192;
    const int nrows = (l == DEPTH - 1) ? NLAT : NROW;
    LAS h16* xh = (LAS h16*)lds; LAS h16* xlo = (LAS h16*)(lds + 33024); LAS float* part = (LAS float*)(lds + 66048); LAS float* logit = (LAS float*)(lds + 90624);
    const float* wg = p->in[I_RWG] + (size_t)l * D * 4; const float* we = p->in[I_RWE] + (size_t)l * D * 32;
    const float* g = p->in[I_GFFN] + l * D;
    const int c16 = lane & 15, kq = lane >> 4;
    h16x8 bh[4][3], bl[4][3];
#pragma unroll
    for (int ks = 0; ks < 4; ++ks)
#pragma unroll
        for (int nt = 0; nt < 3; ++nt) {
            const int n = nt * 16 + c16;
#pragma unroll
            for (int j = 0; j < 8; ++j) {
                const int k = wave * 128 + ks * 32 + kq * 8 + j;
                float w = (n < 32) ? we[(size_t)k * 32 + n] : ((n < 36) ? wg[(size_t)k * 4 + (n - 32)] : 0.f);
                w *= 64.f; const h16 hh = (h16)w; bh[ks][nt][j] = hh; bl[ks][nt][j] = (h16)(w - (float)hh);
            }
        }
    LAS int* r_e = (LAS int*)(lds + 93184);
    LAS int* r_rk = r_e + 80;
    LAS float* r_w = (LAS float*)(r_rk + 80);
    LAS int* hist = (LAS int*)(r_w + 160);
    LAS int* baseL = hist + 32;
    LAS int* slotL = baseL + 32;
    h16* hl = (h16*)(ws + WS_HL);
    int* rlist = (int*)((unsigned*)(ws + WS_CTL) + CW_RLIST + l * (MAXTILES * 256));
    if (tid < 32) hist[tid] = 0;
    const int ngroups = nrows / 16;
    int nloc = 0;
    const unsigned* done5 = (const unsigned*)(ws + WS_CTL) + CW_D5 + l * 128;
    const int nX = (l == DEPTH - 1 || G < 128) ? 0 : 32;
    int g0, gs, ng;
    if (nX > 0 && (int)blockIdx.x >= G - nX) { g0 = (int)blockIdx.x - (G - nX); gs = nX; ng = 2; }
    else { g0 = (nX > 0 ? 2 * nX : 0) + (int)blockIdx.x; gs = G - nX; ng = (g0 < ngroups) ? (ngroups - g0 + gs - 1) / gs : 0; }
    if (tid < 64) {
        for (int k = 0; k < ng; ++k) {
            const int grp = g0 + k * gs; if ((grp >> 4) >= NLAT / 256) continue;
            unsigned spins = 0;
            while ((unsigned)__builtin_amdgcn_readfirstlane(__hip_atomic_load(done5 + (grp >> 4), __ATOMIC_RELAXED, __HIP_MEMORY_SCOPE_AGENT)) < 4u) { __builtin_amdgcn_s_sleep(2); if (++spins > (1u << 24)) break; }
        }
        __builtin_amdgcn_fence(__ATOMIC_ACQUIRE, "agent");
        asm volatile("s_waitcnt vmcnt(0)" ::: "memory");
    }
    __syncthreads();
    h16x4 xr[2][4];
#define R6_LOAD(grp_) do { _Pragma("unroll") for (int rr = 0; rr < 2; ++rr) { const int row_ = (grp_) * 16 + wave * 2 + rr; \
            _Pragma("unroll") for (int j = 0; j < 4; ++j) xr[rr][j] = *(const h16x4*)(xl + (size_t)row_ * D + 4 * lane + 256 * j); } } while (0)
    if (ng > 0) R6_LOAD(g0);
    float rbias[2];
#pragma unroll
    for (int it = 0; it < 2; ++it) { const int i = tid + it * NTHREADS; const int o = i % 36; rbias[it] = (i < 16 * 36) ? ((o < 4) ? p->in[I_RBG][l * 4 + o] : p->in[I_RBE][l * 32 + o - 4]) : 0.f; }
    int curv = -1; f32x4 gmv[4], shv[4];
#pragma unroll
    for (int j = 0; j < 4; ++j) { gmv[j] = (f32x4){0.f, 0.f, 0.f, 0.f}; shv[j] = gmv[j]; }
    for (int kk = 0; kk < ng; ++kk) {
        const int grp = g0 + kk * gs;
        if ((grp >> 4) >= NLAT / 256) unit_wait(done5 + (grp >> 4), 16u);
        {
            const int vg = (grp * 16 < NLAT) ? ((grp * 16) >> 13) : 2;
            if (vg != curv) { curv = vg; const float* sh = mod + ((size_t)l * 3 + vg) * 6144 + 3 * 1024; const float* scl = sh + 1024;
#pragma unroll
                for (int j = 0; j < 4; ++j) { const int c = 4 * lane + 256 * j; gmv[j] = *(const f32x4*)(g + c) * (1.f + *(const f32x4*)(scl + c)); shv[j] = *(const f32x4*)(sh + c); } }
        }
        lds_barrier();
#pragma unroll
        for (int rr = 0; rr < 2; ++rr) {
            const int lr = wave * 2 + rr, row = grp * 16 + lr; const int v = (row < NLAT) ? (row >> 13) : 2;
            f32x4 x[4]; float ss = 0.f;
#pragma unroll
            for (int j = 0; j < 4; ++j) x[j] = (f32x4){(float)xr[rr][j][0], (float)xr[rr][j][1], (float)xr[rr][j][2], (float)xr[rr][j][3]};
            if (row >= NLAT && l != DEPTH - 1) {
                const float* pp = (const float*)(ws + WS_RGA) + (size_t)(row - NLAT) * D;
#pragma unroll
                for (int kq = 0; kq < 4; ++kq)
#pragma unroll
                    for (int j = 0; j < 4; ++j) x[j] += *(const f32x4*)(pp + (size_t)kq * NCTX * D + 4 * lane + 256 * j);
#pragma unroll
                for (int j = 0; j < 4; ++j) { u32x2 w; w.x = pkh(x[j][0], x[j][1]); w.y = pkh(x[j][2], x[j][3]); *(u32x2*)((h16*)(ws + WS_XL) + (size_t)row * D + 4 * lane + 256 * j) = w; }
            }
#pragma unroll
            for (int j = 0; j < 4; ++j) ss += x[j][0] * x[j][0] + x[j][1] * x[j][1] + x[j][2] * x[j][2] + x[j][3] * x[j][3];
            const float rstd = rsqrtf(wave_sum(ss) * (1.f / D) + EPS);
            h16* o = hl + (size_t)row * D;
#pragma unroll
            for (int j = 0; j < 4; ++j) { const int c = 4 * lane + 256 * j;
                const f32x4 y = x[j] * rstd * gmv[j] + shv[j];
                h16x4 yh, yl;
#pragma unroll
                for (int e = 0; e < 4; ++e) { yh[e] = (h16)y[e]; yl[e] = (h16)(y[e] - (float)yh[e]); }
                *(LAS h16x4*)(xh + lr * 1032 + c) = yh; *(LAS h16x4*)(xlo + lr * 1032 + c) = yl; *(h16x4*)(o + c) = yh; }
        }
        if (kk + 1 < ng) R6_LOAD(grp + gs);
        lds_barrier();
        {
            f32x4 acc[3] = {{0.f, 0.f, 0.f, 0.f}, {0.f, 0.f, 0.f, 0.f}, {0.f, 0.f, 0.f, 0.f}};
#pragma unroll
            for (int ks = 0; ks < 4; ++ks) {
                const int ko = c16 * 1032 + wave * 128 + ks * 32 + kq * 8;
                const h16x8 ah = *(const LAS h16x8*)(xh + ko), al = *(const LAS h16x8*)(xlo + ko);
#pragma unroll
                for (int nt = 0; nt < 3; ++nt) {
                    acc[nt] = __builtin_amdgcn_mfma_f32_16x16x32_f16(ah, bh[ks][nt], acc[nt], 0, 0, 0);
                    acc[nt] = __builtin_amdgcn_mfma_f32_16x16x32_f16(ah, bl[ks][nt], acc[nt], 0, 0, 0);
                    acc[nt] = __builtin_amdgcn_mfma_f32_16x16x32_f16(al, bh[ks][nt], acc[nt], 0, 0, 0);
                }
            }
#pragma unroll
            for (int nt = 0; nt < 3; ++nt)
#pragma unroll
                for (int r = 0; r < 4; ++r) part[(wave * 16 + kq * 4 + r) * 48 + nt * 16 + c16] = acc[nt][r];
        }
        lds_barrier();
#pragma unroll
        for (int it = 0; it < 2; ++it) { const int i = tid + it * NTHREADS; if (i < 16 * 36) { const int r = i / 36, o = i % 36; const int n = (o < 4) ? 32 + o : o - 4;
            float sacc = 0.f;
#pragma unroll
            for (int w = 0; w < 8; ++w) sacc += part[(w * 16 + r) * 48 + n];
            logit[i] = sacc * (1.f / 64.f) + rbias[it]; } }
        lds_barrier();
        if (tid < 16) {
            const LAS float* lg = logit + tid * 36;
            int gi = 0; float gm = lg[0];
#pragma unroll
            for (int i = 1; i < 4; ++i) if (lg[i] > gm) { gm = lg[i]; gi = i; }
            float gs = 0.f;
#pragma unroll
            for (int i = 0; i < 4; ++i) gs += __expf(lg[i] - gm);
            const float gtop = 1.f / gs;
            const LAS float* el = lg + 4 + gi * 8;
            int i1 = 0; float m1 = el[0];
#pragma unroll
            for (int i = 1; i < 8; ++i) if (el[i] > m1) { m1 = el[i]; i1 = i; }
            int i2 = -1; float m2 = -INFINITY;
#pragma unroll
            for (int i = 0; i < 8; ++i) if (i != i1 && el[i] > m2) { m2 = el[i]; i2 = i; }
            const float e2 = __expf(m2 - m1); const float inv = 1.f / (1.f + e2);
            const int ea = gi * 8 + i1, eb = gi * 8 + i2;
            const int ra = atomicAdd((int*)(hist + ea), 1), rb = atomicAdd((int*)(hist + eb), 1);
            const int lr = kk * 16 + tid;
            r_e[lr] = ea | (eb << 8); r_rk[lr] = ra | (rb << 16); r_w[lr * 2] = gtop * inv; r_w[lr * 2 + 1] = gtop * e2 * inv;
        }
        nloc = kk * 16 + 16;
    }
    __syncthreads();
    if (tid < 32) {
        const int n = hist[tid]; int base = 0;
        if (n > 0) {
            base = (int)atomicAdd(&cnt[tid], (unsigned)n);
            const int j0 = base >> 8, j1 = (base + n - 1) >> 8;
            if ((base & 255) == 0) { const unsigned t = atomicAdd(pool, 1u); __hip_atomic_store(owner + t, (unsigned)tid, __ATOMIC_RELAXED, __HIP_MEMORY_SCOPE_AGENT); __hip_atomic_store(tmap + tid * 72 + j0, t + 1u, __ATOMIC_RELAXED, __HIP_MEMORY_SCOPE_AGENT); }
            if (j1 != j0) { const unsigned t = atomicAdd(pool, 1u); __hip_atomic_store(owner + t, (unsigned)tid, __ATOMIC_RELAXED, __HIP_MEMORY_SCOPE_AGENT); __hip_atomic_store(tmap + tid * 72 + j1, t + 1u, __ATOMIC_RELAXED, __HIP_MEMORY_SCOPE_AGENT); }
        }
        baseL[tid] = base;
    }
    __syncthreads();
    if (tid < nloc) {
        const int lr = tid, grp = g0 + (lr >> 4) * gs, row = grp * 16 + (lr & 15);
        const int ee = r_e[lr], rk = r_rk[lr]; const int ea = ee & 255, eb = ee >> 8;
        const unsigned pa = (unsigned)(baseL[ea] + (rk & 0xffff)), pb = (unsigned)(baseL[eb] + (rk >> 16));
        unsigned* tma = tmap + ea * 72 + (pa >> 8); unsigned* tmb = tmap + eb * 72 + (pb >> 8);
        unsigned ta = 0u, tb = 0u, spin = 0u;
        while (ta == 0u || tb == 0u) {
            if (ta == 0u) ta = __hip_atomic_load(tma, __ATOMIC_RELAXED, __HIP_MEMORY_SCOPE_AGENT);
            if (tb == 0u) tb = __hip_atomic_load(tmb, __ATOMIC_RELAXED, __HIP_MEMORY_SCOPE_AGENT);
            if (++spin > (1u << 22)) break;
        }
        const int sa_ = (int)((ta - 1u) * 256u + (pa & 255u)), sb_ = (int)((tb - 1u) * 256u + (pb & 255u));
        asg[row * 2] = sa_; asg[row * 2 + 1] = sb_;
        ew[row * 2] = r_w[lr * 2]; ew[row * 2 + 1] = r_w[lr * 2 + 1];
        rlist[sa_] = row; rlist[sb_] = row;
    }
}

__device__ __forceinline__ void moe_table(KP p, int l, volatile LAS int* tab) {
    __syncthreads();
    if (tid_now() == 0) {
        const unsigned* cnt = (const unsigned*)(p->ws + WS_CTL) + CW_CNT + l * 32; int s = 0;
        for (int e = 0; e < NEXP; ++e) { tab[e] = s; s += (int)((__hip_atomic_load(cnt + e, __ATOMIC_RELAXED, __HIP_MEMORY_SCOPE_AGENT) + 255u) >> 8); }
        tab[NEXP] = s;
    }
    __syncthreads();
}

__global__ void __launch_bounds__(NTHREADS, 2) fwd_kernel(Params p_) {
    KP p = (KP)__builtin_amdgcn_kernarg_segment_ptr();
#define RELOAD_P() asm volatile("" : "+s"(p))
    extern __shared__ __attribute__((aligned(16))) unsigned char lds_raw[];
    LAS unsigned char* lds = (LAS unsigned char*)lds_raw;
    volatile LAS unsigned* MISC = (volatile LAS unsigned*)(lds + MISC_OFF);
    volatile LAS int* tab = (volatile LAS int*)(lds + MISC_OFF + 64);
    const int tid = threadIdx.x;
    const int G = gridDim.x; const int bx = blockIdx.x; const int vcu = (G % 8 == 0) ? (bx % 8) * (G / 8) + bx / 8 : bx;
    unsigned char* ws = p->ws;
    for (int u = tid; u < 256; u += NTHREADS) MISC[u] = 0u;
    __syncthreads();
    {
        XcdBarrier b0 = xcd_barrier_post((unsigned*)(ws + WS_CTL) + CW_BAR, MISC);
        cg::this_grid().sync();
        if (tid == 0) { unsigned nloc, nx; xcd_barrier_complete(b0.bar, b0.x, nloc, nx); MISC[0] = nloc; MISC[1] = nx; }
        __syncthreads();
    }
#define GRID_BAR() do { GRID_BAR1(); if (PROBE_REPEAT == 99) GRID_BAR1(); if (PROBE_STAMP >= 0 && blockIdx.x == 0 && tid == 0) { ((unsigned long long*)(ws + WS_LAM + 1024))[nstamp] = __builtin_amdgcn_s_memrealtime(); } ++nstamp; } while (0)
#define GRID_BAR1() do { RELOAD_P(); { unsigned char* w_ = p->ws; XcdBarrier b_; b_.bar = (unsigned*)(w_ + WS_CTL) + CW_BAR; b_.x = xb_xcc_id(); b_.st = MISC; xcd_barrier(b_); } \
    RELOAD_P(); ws = p->ws; } while (0)
#ifdef ONLY_PHASE
#define PH(n) (ONLY_PHASE == (n))
#else
#define PH(n) 1
#endif

    int nstamp = 0;
    if (PROBE_STAMP >= 0 && blockIdx.x == 0 && tid == 0) ((unsigned long long*)(ws + WS_LAM + 1024))[63] = __builtin_amdgcn_s_memrealtime();
    REP(0) if (PH(0)) phase_p0(p, lds, vcu, G);
    GRID_BAR();
#pragma unroll 1
    for (int l = 0; l < DEPTH; ++l) {
        const bool last = (l == DEPTH - 1);
        REP(1) if (PH(1)) phase_norm1(p, l, l == 0 ? 0 : 1, tab, vcu, G, DUMMY(1));
        GRID_BAR();
        REP(2) if (PH(2)) {
            pg8::InProjSched S; S.init(ws + WS_HL, ws + WS_WIN + (size_t)l * INC * D * 2, D, G, bx, (unsigned*)(ws + WS_CTL) + CW_S2 + l * 64, (unsigned*)(ws + WS_CTL) + CW_S2 + l * 64 + 32);
            EpiInProj E{(h16*)(ws + WS_QA), (h16*)(ws + WS_KA), (h16*)(ws + WS_VAT), (h16*)(ws + WS_XR), (h16*)(ws + WS_GG), (h16*)(ws + WS_QD), (h16*)(ws + WS_KD), (h16*)(ws + WS_VDT), (const f32x2*)(ws + WS_ROPE), (unsigned*)(ws + WS_CTL) + CW_KMAX + l * 16, lds + 131072};
            pg8::gemm_phase<EpiInProj, pg8::InProjSched>(lds, D, S, E);
        }
        RELOAD_P(); ws = p->ws; asm volatile("" ::: "memory"); __builtin_amdgcn_sched_barrier(0);
        if (PH(3)) phase_mix(p, l, lds, vcu, G);
        GRID_BAR();
        REP(4) if (PH(4)) phase_scan(p, l, lds, G);
        GRID_BAR();
        REP(5) if (PH(5)) {
            pg8::DenseSched S; S.init(ws + WS_MIX, ws + WS_WOUT + (size_t)l * D * D * 2, NLAT, D, D, G, bx, (unsigned*)(ws + WS_CTL) + CW_D5 + l * 128);
            EpiOutProj E{(h16*)(ws + WS_XL), (const float*)(ws + WS_MOD) + (size_t)l * 3 * 6144, (h16*)(ws + WS_XL)};
            pg8::gemm_phase<EpiOutProj, pg8::DenseSched>(lds, D, S, E);
        }
        if (PH(5) && !last) {
            RELOAD_P(); ws = p->ws;
            CtxSplitSched S2{(const char*)(ws + WS_MIX), (const char*)(ws + WS_WOUT + (size_t)l * D * D * 2), (int)blockIdx.x - (G - 32), (unsigned*)(ws + WS_CTL) + CW_D5 + l * 128};
            EpiOutPart E2{(float*)(ws + WS_RGA), (const float*)(ws + WS_MOD) + (size_t)l * 3 * 6144};
            int klen = 256; asm volatile("" : "+s"(klen));
            pg8::gemm_phase<EpiOutPart, CtxSplitSched>(lds, klen, S2, E2, nullptr, D);
        }
        REP(6) if (PH(6)) phase_route(p, l, lds, vcu, G, DUMMY(6));
        GRID_BAR();
        moe_table(p, l, tab);
        REP(8) if (PH(8)) {
            MoeSched1 S{(const char*)((const unsigned*)(ws + WS_CTL) + CW_RLIST + l * (MAXTILES * 256)), (const char*)(ws + WS_W1 + (size_t)l * NEXP * DEXP * D * 2), (const char*)(ws + WS_W3 + (size_t)l * NEXP * DEXP * D * 2), (const unsigned*)(ws + WS_CTL) + CW_TMAP + l * 32 * 72, tab, tab[NEXP], G, vcu, (unsigned*)(ws + WS_CTL) + CW_D7 + l * 192};
            EpiMoe1 E{(h16*)(ws + WS_ACT)};
            pg8::gemm_phase<EpiMoe1, MoeSched1, true>(lds, D, S, E, (const char*)(ws + WS_HL));
        }
        REP(9) if (PH(9)) {
            MoeSched2 S{(const char*)(ws + WS_ACT), (const char*)(ws + WS_W2 + (size_t)l * NEXP * DEXP * D * 2), (const unsigned*)(ws + WS_CTL) + CW_TMAP + l * 32 * 72, tab, tab[NEXP], G, vcu, (const unsigned*)(ws + WS_CTL) + CW_D7 + l * 192, 0, 0, 0};
            S.plan();
            EpiMoe2 E{(h16*)(ws + WS_YB)};
            pg8::gemm_phase<EpiMoe2, MoeSched2>(lds, DEXP, S, E);
        }
        GRID_BAR();
    }
    if (PH(10)) phase_norm1(p, DEPTH, 2, tab, vcu, G, false);
    if (PROBE_STAMP >= 0 && blockIdx.x == 0 && tid == 0) {
        const unsigned long long* st = (const unsigned long long*)(ws + WS_LAM + 1024);
        unsigned long long tot = 0;
        if (PROBE_STAMP == 7) tot = __builtin_amdgcn_s_memrealtime() - st[63];
        else if (PROBE_STAMP == 0) tot = st[0] - st[63];
        else for (int l = 0; l < DEPTH; ++l) { const int e = PROBE_STAMP + 6 * l; tot += st[e] - st[e - 1]; }
        asm volatile("s_waitcnt vmcnt(0)" ::: "memory");
        p->out[0] = (float)tot * (0.01f / ((PROBE_STAMP == 3 || PROBE_STAMP == 7) ? 100.f : 10.f));
    }
}

extern "C" void kernel_launch(void* const* d_in, const int* in_sizes, int n_in, void* d_out, int out_size, void* d_ws, size_t ws_size, hipStream_t stream) {
    static int grid = 0;
    if (grid == 0) {
        if (n_in != 28 || out_size != NLAT * D || ws_size < WS_END) { fprintf(stderr, "kernel_launch: unexpected shapes (n_in %d out %d ws %zu)\n", n_in, out_size, ws_size); grid = -1; return; }
        int dev = 0, cus = 0, per_cu = 0;
        if (hipGetDevice(&dev) != hipSuccess || hipDeviceGetAttribute(&cus, hipDeviceAttributeMultiprocessorCount, dev) != hipSuccess) { grid = -1; return; }
        if (hipFuncSetAttribute((const void*)fwd_kernel, hipFuncAttributeMaxDynamicSharedMemorySize, LDS_BYTES) != hipSuccess) { fprintf(stderr, "kernel_launch: hipFuncSetAttribute failed\n"); grid = -1; return; }
        if (hipOccupancyMaxActiveBlocksPerMultiprocessor(&per_cu, (const void*)fwd_kernel, NTHREADS, LDS_BYTES) != hipSuccess || per_cu < 1) { fprintf(stderr, "kernel_launch: occupancy query says %d blocks per CU\n", per_cu); (void)hipGetLastError(); grid = -1; return; }
        grid = cus;
    }
    if (grid < 0) return;
    (void)hipMemsetAsync((char*)d_ws + WS_CTL, 0, CTL_ZERO_BYTES, stream);
    Params p{};
    for (int i = 0; i < 28; ++i) p.in[i] = (const float*)d_in[i];
    p.out = (float*)d_out; p.ws = (unsigned char*)d_ws;
    void* args[] = {&p};
    hipError_t e = hipLaunchCooperativeKernel((const void*)fwd_kernel, dim3(grid), dim3(NTHREADS), args, LDS_BYTES, stream);
    if (e != hipSuccess) fprintf(stderr, "kernel_launch: cooperative launch failed: %s (grid %d)\n", hipGetErrorString(e), grid);
}
```
